# Optimizing an MI355X kernel written in HIP

```python
import jax, jax.numpy as jnp
from jax import lax
import numpy as np

D_MODEL = 1024
BATCH = 16
SEQ = 2048
DEPTH = 1

HEAD_DIM = 64
ATTN_PAIRS = ((128, 1), (512, 4), (2048, 16))
ATTN_GROUPS = 3
ATTN_HEADS_PER_GROUP = 8
ATTN_BLOCK = 64
ROPE_THETA = 10000.0
RET_HEADS = 8
RET_QK_DIM = 64
RET_V_DIM = 128
RET_CHUNK = 128
MOE_GROUPS = 8
MOE_EXPERTS_PER_GROUP = 8
MOE_N_EXPERTS = MOE_GROUPS * MOE_EXPERTS_PER_GROUP
MOE_TOP_K = 2
MOE_HIDDEN = 512
MOE_BLOCK = 128
NORM_EPS = 1e-6

ATTN_W = ATTN_GROUPS * ATTN_HEADS_PER_GROUP * HEAD_DIM
ATTN_OUT_W = ATTN_HEADS_PER_GROUP * HEAD_DIM
RET_QK_W = RET_HEADS * RET_QK_DIM
RET_V_W = RET_HEADS * RET_V_DIM
IN_SPLIT_POINTS = (ATTN_W, 2 * ATTN_W, 3 * ATTN_W,
                   3 * ATTN_W + RET_QK_W, 3 * ATTN_W + 2 * RET_QK_W,
                   3 * ATTN_W + 2 * RET_QK_W + RET_V_W,
                   3 * ATTN_W + 2 * RET_QK_W + 2 * RET_V_W)
IN_W = IN_SPLIT_POINTS[-1] + 2 * D_MODEL

kernel_name = 'gated_hybrid_dilated_attn_retention_hmoe'


def rms_norm(x, w):
    xf = x.astype(jnp.float32)
    y = xf * lax.rsqrt(jnp.mean(xf * xf, axis=-1, keepdims=True) + NORM_EPS)
    return (y * w.astype(jnp.float32)).astype(x.dtype)


def rotary_tables(seq_len):
    inv_freq = 1.0 / (ROPE_THETA ** (jnp.arange(0, HEAD_DIM, 2, dtype=jnp.float32) / HEAD_DIM))
    ang = jnp.arange(seq_len, dtype=jnp.float32)[:, None] * inv_freq[None, :]
    return jnp.cos(ang), jnp.sin(ang)


def apply_rotary(t, cos, sin):
    t1, t2 = jnp.split(t.astype(jnp.float32), 2, axis=-1)
    c = cos[None, :, None, :]
    s = sin[None, :, None, :]
    return jnp.concatenate([t1 * c - t2 * s, t1 * s + t2 * c], axis=-1)


def dilated_window_attention(q, k, v, dilation, half):
    B, S, H, Dh = q.shape
    L = S // dilation
    nb = -(-L // ATTN_BLOCK)
    Lp = nb * ATTN_BLOCK
    N = B * dilation

    def strided(t):
        t = t.reshape(B, L, dilation, H, Dh).transpose(0, 2, 3, 1, 4)
        return t.reshape(N, H, L, Dh)

    qb = jnp.pad(strided(q), ((0, 0), (0, 0), (0, Lp - L), (0, 0))).reshape(N, H, nb, ATTN_BLOCK, Dh)

    def band(t):
        tp = jnp.pad(strided(t), ((0, 0), (0, 0), (ATTN_BLOCK, Lp - L + ATTN_BLOCK), (0, 0)))
        tb = tp.reshape(N, H, nb + 2, ATTN_BLOCK, Dh)
        return jnp.concatenate([tb[:, :, :-2], tb[:, :, 1:-1], tb[:, :, 2:]], axis=3)

    kw = band(k)
    vw = band(v)
    scores = jnp.einsum('nhbqd,nhbkd->nhbqk', qb, kw) * (Dh ** -0.5)
    blk = jnp.arange(nb)[:, None] * ATTN_BLOCK
    q_pos = blk + jnp.arange(ATTN_BLOCK)[None, :]
    k_pos = blk - ATTN_BLOCK + jnp.arange(3 * ATTN_BLOCK)[None, :]
    rel = k_pos[:, None, :] - q_pos[:, :, None]
    in_range = (k_pos[:, None, :] >= 0) & (k_pos[:, None, :] < L)
    valid = (jnp.abs(rel) <= half) & (in_range | (rel == 0))
    scores = jnp.where(valid[None, None], scores, -jnp.inf)
    m = jnp.max(scores, axis=-1, keepdims=True)
    p = jnp.exp(scores - m)
    denom = jnp.sum(p, axis=-1, keepdims=True)
    out = jnp.einsum('nhbqk,nhbkd->nhbqd', p, vw) / denom
    lse = (m + jnp.log(denom))[..., 0]
    out = out.reshape(N, H, Lp, Dh)[:, :, :L].reshape(B, dilation, H, L, Dh)
    out = out.transpose(0, 3, 1, 2, 4).reshape(B, S, H, Dh)
    lse = lse.reshape(N, H, Lp)[:, :, :L].reshape(B, dilation, H, L)
    lse = lse.transpose(0, 3, 1, 2).reshape(B, S, H)
    return out, lse


def retention_chunkwise(q, k, v, log_g):
    B, H, S, Dk = q.shape
    Dv = v.shape[-1]
    C = RET_CHUNK
    nc = S // C
    qc = q.reshape(B, H, nc, C, Dk)
    kc = k.reshape(B, H, nc, C, Dk)
    vc = v.reshape(B, H, nc, C, Dv)
    idx = jnp.arange(C, dtype=jnp.float32)
    rel = idx[:, None] - idx[None, :]
    decay = jnp.where(rel[None] >= 0, jnp.exp(jnp.maximum(rel[None], 0.0) * log_g[:, None, None]), 0.0)
    scores = jnp.einsum('bhnqd,bhnkd->bhnqk', qc, kc) * decay[None, :, None]
    inner = jnp.einsum('bhnqk,bhnkv->bhnqv', scores, vc)
    zeta = jnp.exp((C - 1 - idx)[None, :] * log_g[:, None])
    kv = jnp.einsum('bhnkd,bhnkv->nbhdv', kc * zeta[None, :, None, :, None], vc)
    chunk_decay = jnp.exp(C * log_g)[None, :, None, None]

    def step(state, kv_chunk):
        return chunk_decay * state + kv_chunk, state

    _, prev_states = lax.scan(step, jnp.zeros((B, H, Dk, Dv), jnp.float32), kv)
    xi = jnp.exp((idx + 1.0)[None, :] * log_g[:, None])
    cross = jnp.einsum('bhnqd,nbhdv->bhnqv', qc * xi[None, :, None, :, None], prev_states)
    return (inner + cross).reshape(B, H, S, Dv)


def hybrid_mixer(xn, w_in, b_branch_gate, ret_decay_fwd, ret_decay_bwd, ret_gn_w,
                 w_attn_branch, w_ret_branch, w_out, cos, sin):
    B, S, _ = xn.shape
    proj = jnp.einsum('bsd,de->bse', xn, w_in)
    q_a, k_a, v_a, q_r, k_r, v_r, g_r, gate_logits = jnp.split(proj, IN_SPLIT_POINTS, axis=-1)

    n_a = ATTN_GROUPS * ATTN_HEADS_PER_GROUP
    q_a = apply_rotary(q_a.reshape(B, S, n_a, HEAD_DIM), cos, sin).reshape(B, S, ATTN_GROUPS, ATTN_HEADS_PER_GROUP, HEAD_DIM)
    k_a = apply_rotary(k_a.reshape(B, S, n_a, HEAD_DIM), cos, sin).reshape(B, S, ATTN_GROUPS, ATTN_HEADS_PER_GROUP, HEAD_DIM)
    v_a = v_a.astype(jnp.float32).reshape(B, S, ATTN_GROUPS, ATTN_HEADS_PER_GROUP, HEAD_DIM)
    outs = []
    lses = []
    for g, (window, dilation) in enumerate(ATTN_PAIRS):
        o, l = dilated_window_attention(q_a[:, :, g], k_a[:, :, g], v_a[:, :, g], dilation, window // (2 * dilation))
        outs.append(o)
        lses.append(l)
    mix_w = jax.nn.softmax(jnp.stack(lses, axis=0), axis=0)
    y_att = jnp.einsum('gbsh,gbshd->bshd', mix_w, jnp.stack(outs, axis=0)).reshape(B, S, ATTN_OUT_W)

    q_r = apply_rotary(q_r.reshape(B, S, RET_HEADS, RET_QK_DIM), cos, sin).transpose(0, 2, 1, 3)
    k_r = (apply_rotary(k_r.reshape(B, S, RET_HEADS, RET_QK_DIM), cos, sin) * (RET_QK_DIM ** -0.5)).transpose(0, 2, 1, 3)
    v_r = v_r.astype(jnp.float32).reshape(B, S, RET_HEADS, RET_V_DIM).transpose(0, 2, 1, 3)
    log_g_fwd = jax.nn.log_sigmoid(ret_decay_fwd.astype(jnp.float32))
    log_g_bwd = jax.nn.log_sigmoid(ret_decay_bwd.astype(jnp.float32))
    ret_f = retention_chunkwise(q_r, k_r, v_r, log_g_fwd)
    ret_b = jnp.flip(retention_chunkwise(jnp.flip(q_r, 2), jnp.flip(k_r, 2), jnp.flip(v_r, 2), log_g_bwd), 2)
    ret = ret_f + ret_b
    mu = jnp.mean(ret, axis=-1, keepdims=True)
    var = jnp.mean(jnp.square(ret - mu), axis=-1, keepdims=True)
    ret = (ret - mu) * lax.rsqrt(var + NORM_EPS)
    ret = ret.transpose(0, 2, 1, 3).reshape(B, S, RET_V_W) * ret_gn_w.astype(jnp.float32)
    y_ret = jax.nn.silu(g_r.astype(jnp.float32)) * ret

    gates = jax.nn.sigmoid((gate_logits + b_branch_gate).astype(jnp.float32))
    g_att, g_ret = jnp.split(gates, 2, axis=-1)
    merged = (g_att * jnp.einsum('bse,ed->bsd', y_att, w_attn_branch.astype(jnp.float32))
              + g_ret * jnp.einsum('bse,ed->bsd', y_ret, w_ret_branch.astype(jnp.float32)))
    return jnp.einsum('bsd,de->bse', merged.astype(xn.dtype), w_out)


def hierarchical_moe(x2, w_group, b_group, w_expert, b_expert, w1, w3, w2):
    T, D = x2.shape
    xf = x2.astype(jnp.float32)
    group_p = jax.nn.softmax(xf @ w_group.astype(jnp.float32) + b_group.astype(jnp.float32), axis=-1)
    g_w, g_idx = lax.top_k(group_p, 1)
    exp_logits = (xf @ w_expert.astype(jnp.float32) + b_expert.astype(jnp.float32)).reshape(T, MOE_GROUPS, MOE_EXPERTS_PER_GROUP)
    sel_logits = jnp.take_along_axis(exp_logits, g_idx[:, :, None], axis=1)[:, 0]
    e_w, e_idx = lax.top_k(jax.nn.softmax(sel_logits, axis=-1), MOE_TOP_K)
    e_w = e_w / jnp.sum(e_w, axis=-1, keepdims=True)
    gate = (g_w * e_w).reshape(-1)
    eid = (g_idx * MOE_EXPERTS_PER_GROUP + e_idx).reshape(-1).astype(jnp.int32)
    tok = jnp.repeat(jnp.arange(T, dtype=jnp.int32), MOE_TOP_K)
    A = T * MOE_TOP_K

    order = jnp.argsort(eid)
    s_eid = eid[order]
    s_tok = tok[order]
    s_gate = gate[order]
    counts = jnp.bincount(eid, length=MOE_N_EXPERTS)
    starts = jnp.cumsum(counts) - counts
    padded = (counts + MOE_BLOCK - 1) // MOE_BLOCK * MOE_BLOCK
    p_ends = jnp.cumsum(padded)
    p_starts = p_ends - padded
    dest = p_starts[s_eid] + (jnp.arange(A, dtype=jnp.int32) - starts[s_eid])
    n_blocks = -(-A // MOE_BLOCK) + MOE_N_EXPERTS
    slot_tok = jnp.full((n_blocks * MOE_BLOCK,), T, jnp.int32).at[dest].set(s_tok)
    blk_eid = jnp.clip(jnp.searchsorted(p_ends, jnp.arange(n_blocks) * MOE_BLOCK, side='right'), 0, MOE_N_EXPERTS - 1)
    x_pad = jnp.concatenate([x2, jnp.zeros((1, D), x2.dtype)], axis=0)
    x_slots = x_pad[slot_tok].reshape(n_blocks, MOE_BLOCK, D)

    def expert_block(args):
        xb, e = args
        hid = jax.nn.silu(xb @ w1[e]) * (xb @ w3[e])
        return hid @ w2[e]

    y_slots = lax.map(expert_block, (x_slots, blk_eid)).reshape(n_blocks * MOE_BLOCK, D)
    y_assign = y_slots[dest].astype(jnp.float32) * s_gate[:, None]
    return jax.ops.segment_sum(y_assign, s_tok, num_segments=T).astype(x2.dtype)


def setup_inputs(seed: int = 0) -> dict:
    key = jax.random.key(seed)
    ks = jax.random.split(key, 20)
    L = DEPTH
    f32 = jnp.float32

    def nrm(k, shape, scale):
        return jax.random.normal(k, shape, f32) * scale

    heads = jnp.arange(RET_HEADS, dtype=f32)
    decay_logit = jnp.log(2.0 ** (5.0 + heads) - 1.0)
    return {
        'x': nrm(ks[0], (BATCH, SEQ, D_MODEL), 1.0),
        'norm_mix_w': 1.0 + nrm(ks[1], (L, D_MODEL), 0.02),
        'w_in': nrm(ks[2], (L, D_MODEL, IN_W), D_MODEL ** -0.5),
        'b_branch_gate': nrm(ks[3], (L, 2 * D_MODEL), 0.02),
        'ret_decay_fwd': decay_logit[None] + nrm(ks[4], (L, RET_HEADS), 0.05),
        'ret_decay_bwd': decay_logit[None] + nrm(ks[5], (L, RET_HEADS), 0.05),
        'ret_gn_w': 1.0 + nrm(ks[6], (L, RET_V_W), 0.02),
        'w_attn_branch': nrm(ks[7], (L, ATTN_OUT_W, D_MODEL), ATTN_OUT_W ** -0.5),
        'w_ret_branch': nrm(ks[8], (L, RET_V_W, D_MODEL), RET_V_W ** -0.5),
        'w_out': nrm(ks[9], (L, D_MODEL, D_MODEL), D_MODEL ** -0.5),
        'norm_moe_w': 1.0 + nrm(ks[10], (L, D_MODEL), 0.02),
        'moe_w_group': nrm(ks[11], (L, D_MODEL, MOE_GROUPS), D_MODEL ** -0.5),
        'moe_b_group': nrm(ks[12], (L, MOE_GROUPS), 0.01),
        'moe_w_expert': nrm(ks[13], (L, D_MODEL, MOE_N_EXPERTS), D_MODEL ** -0.5),
        'moe_b_expert': nrm(ks[14], (L, MOE_N_EXPERTS), 0.01),
        'moe_w1': nrm(ks[15], (L, MOE_N_EXPERTS, D_MODEL, MOE_HIDDEN), D_MODEL ** -0.5),
        'moe_w3': nrm(ks[16], (L, MOE_N_EXPERTS, D_MODEL, MOE_HIDDEN), D_MODEL ** -0.5),
        'moe_w2': nrm(ks[17], (L, MOE_N_EXPERTS, MOE_HIDDEN, D_MODEL), MOE_HIDDEN ** -0.5),
        'norm_final_w': 1.0 + nrm(ks[18], (D_MODEL,), 0.02),
    }


def reference(x, norm_mix_w, w_in, b_branch_gate, ret_decay_fwd, ret_decay_bwd, ret_gn_w,
              w_attn_branch, w_ret_branch, w_out, norm_moe_w, moe_w_group, moe_b_group,
              moe_w_expert, moe_b_expert, moe_w1, moe_w3, moe_w2, norm_final_w):
    B, S, D = x.shape
    cos, sin = rotary_tables(S)
    h = x
    for l in range(DEPTH):
        xn = rms_norm(h, norm_mix_w[l])
        mix = hybrid_mixer(xn, w_in[l], b_branch_gate[l], ret_decay_fwd[l], ret_decay_bwd[l], ret_gn_w[l],
                           w_attn_branch[l], w_ret_branch[l], w_out[l], cos, sin)
        h = h + mix.astype(h.dtype)
        hn = rms_norm(h, norm_moe_w[l])
        ffn = hierarchical_moe(hn.reshape(B * S, D), moe_w_group[l], moe_b_group[l], moe_w_expert[l],
                               moe_b_expert[l], moe_w1[l], moe_w3[l], moe_w2[l])
        h = h + ffn.reshape(B, S, D).astype(h.dtype)
    return rms_norm(h, norm_final_w)
```

```cpp
#include <hip/hip_runtime.h>
#include <hip/hip_cooperative_groups.h>
#include <cstdio>
#include <cstdint>
namespace cg = cooperative_groups;

#ifndef EN_ATT
#define EN_ATT 1
#endif
#ifndef EN_RET
#define EN_RET 1
#endif
#ifndef EN_MOE
#define EN_MOE 1
#endif

#define LAS __attribute__((address_space(3)))
#define GAS __attribute__((address_space(1)))
typedef unsigned short bf16_t;
typedef short bf16x8 __attribute__((ext_vector_type(8)));
typedef short s16x4 __attribute__((ext_vector_type(4)));
typedef float f32x4 __attribute__((ext_vector_type(4)));
typedef float f32x2 __attribute__((ext_vector_type(2)));
typedef unsigned u32x4 __attribute__((ext_vector_type(4)));
typedef unsigned u32x2 __attribute__((ext_vector_type(2)));

constexpr int NTOK = 32768, DM = 1024, SEQ = 2048, NBATCH = 16;
constexpr int IN_W = 9728;
constexpr int NEXP = 64;
constexpr float NORM_EPS = 1e-6f;
constexpr float LOG2E = 1.4426950408889634f, LN2 = 0.6931471805599453f;
constexpr float QA_SCALE = 0.125f * LOG2E;
constexpr int NWAVES = 8, NTHREADS = 512;

constexpr size_t MiB = (size_t)1 << 20;
constexpr size_t WS_CTL = 0, CTL_ZERO_BYTES = 65536;
constexpr size_t WS_COS = 1 * MiB, WS_SIN = WS_COS + 262144, WS_WR = WS_COS + 524288;
constexpr size_t WS_ASG = 2 * MiB;
constexpr size_t WS_LSE = 3 * MiB;
constexpr size_t WS_WIN = 6 * MiB;
constexpr size_t WS_WA = 25 * MiB;
constexpr size_t WS_WB = 26 * MiB;
constexpr size_t WS_WO = 28 * MiB;
constexpr size_t WS_XN = 30 * MiB;
constexpr size_t WS_MERGED = 30 * MiB;
constexpr size_t WS_QA = 94 * MiB, WS_KA = 190 * MiB, WS_VA = 286 * MiB;
constexpr size_t WS_OUTG = 382 * MiB;
constexpr size_t WS_YATT = 478 * MiB;
constexpr size_t WS_QR = 94 * MiB, WS_KR = 126 * MiB;
constexpr size_t WS_VR = 158 * MiB, WS_GR = 222 * MiB;
constexpr size_t WS_SST = 286 * MiB;
constexpr size_t WS_YRET = 350 * MiB;
constexpr size_t WS_TMP = 94 * MiB;
constexpr size_t WS_H = 417 * MiB;
constexpr size_t WS_W2 = 30 * MiB;
constexpr size_t WS_W13 = 94 * MiB;
constexpr size_t WS_HN = 224 * MiB;
constexpr size_t WS_XS = 288 * MiB;
constexpr size_t WS_HID = 223 * MiB;
constexpr size_t WS_Y = 94 * MiB;
constexpr size_t WS_END = 545 * MiB;
constexpr int CW_CNT = 64;

constexpr int RING_BYTES = 131072;
constexpr int MISC_OFF = RING_BYTES;
constexpr int LDS_BYTES = 147456;

__device__ __forceinline__ unsigned cvt_pk_bf16(float lo, float hi) { unsigned r; asm volatile("v_cvt_pk_bf16_f32 %0, %1, %2" : "=v"(r) : "v"(lo), "v"(hi)); return r; }
__device__ __forceinline__ float bf_lo(unsigned w) { return __uint_as_float(w << 16); }
__device__ __forceinline__ float bf_hi(unsigned w) { return __uint_as_float(w & 0xffff0000u); }
__device__ __forceinline__ float fast_exp2(float x) { return __builtin_amdgcn_exp2f(x); }
__device__ __forceinline__ float fast_rcp(float x) { return __builtin_amdgcn_rcpf(x); }
__device__ __forceinline__ float sigmoidf_(float x) { return fast_rcp(1.f + fast_exp2(-x * LOG2E)); }
__device__ __forceinline__ float wave_sum(float v) {
#pragma unroll
    for (int o = 1; o < 64; o <<= 1) v += __shfl_xor(v, o);
    return v;
}
__device__ __forceinline__ s16x4 tr_read(const LAS char* p) {
    typedef short v4i16_t __attribute__((ext_vector_type(4)));
    return __builtin_bit_cast(s16x4, __builtin_amdgcn_ds_read_tr16_b64_v4i16((LAS v4i16_t*)p));
}
__device__ __forceinline__ bf16x8 cat4(s16x4 a, s16x4 b) { return (bf16x8){a[0], a[1], a[2], a[3], b[0], b[1], b[2], b[3]}; }
#define LDS_WAIT() asm volatile("s_waitcnt lgkmcnt(0)" ::: "memory")
#define VM_WAIT() asm volatile("s_waitcnt vmcnt(0)" ::: "memory")

namespace pg8 {
constexpr int BM = 256, BK = 64, HALF = 128, HTB = HALF * BK * 2, STAGE_BYTES = 8 * HTB, NXCD = 8, WGM = 8;
__host__ __device__ __forceinline__ int lds_byte(int r, int c) { const int st = (r >> 4) * 2 + (c >> 5), rr = r & 15, cc = c & 31, ob = rr * 64 + cc * 2; return st * 1024 + (ob ^ (((ob >> 9) & 1) << 5)); }
__host__ __device__ __forceinline__ void stage_rc(int b, int& R, int& C) { const int st = b / 1024, sb = b % 1024, swz = sb ^ (((sb >> 9) & 1) << 5); R = (st >> 1) * 16 + swz / 64; C = (st & 1) * 32 + (swz % 64) / 2; }
__host__ __device__ __forceinline__ int perm32(int rho) { const int n = rho >> 4, i = rho & 15; return 8 * (i >> 2) + 4 * n + (i & 3); }

struct Unit { int pm, pn; const char* a; const char* b; int e, row0, nrows; };

struct StaticOrder {
    const char* A; const char* Bt; int K;
    int nM, nN, nwg, G, c;
    __device__ void init(const void* A_, const void* Bt_, int M, int N, int K_, int G_, int c_) { A = (const char*)A_; Bt = (const char*)Bt_; K = K_; nM = M / BM; nN = N / BM; nwg = nM * nN; G = G_; c = c_; }
    __device__ bool next(int i, Unit& u) const {
        const long L = (long)i * G + c; if (L >= nwg) return false;
        int wgid = (int)L; { const int q = nwg / NXCD, r = nwg % NXCD, xcd = wgid % NXCD, off = wgid / NXCD; wgid = (xcd < r ? xcd * (q + 1) : r * (q + 1) + (xcd - r) * q) + off; }
        const int nig = WGM * nN, gid = wgid / nig, fm = gid * WGM, gsz = (nM - fm) < WGM ? (nM - fm) : WGM;
        u.pm = fm + ((wgid % nig) % gsz); u.pn = (wgid % nig) / gsz;
        u.a = A + (size_t)u.pm * BM * K * 2; u.b = Bt + (size_t)u.pn * BM * K * 2; u.e = 0; u.row0 = u.pm * BM; u.nrows = BM; return true;
    }
};
struct GroupedOrder {
    const char* A; const char* Bt; int K; int G, c;
    const LAS int* cnt; const LAS int* tstart; const LAS int* sstart;
    __device__ bool next(int i, Unit& u) const {
        const int total = tstart[NEXP] * 4; const long L = (long)i * G + c; if (L >= total) return false;
        int wg = (int)L; { const int q = total / NXCD, r = total % NXCD, xcd = wg % NXCD, off = wg / NXCD; wg = (xcd < r ? xcd * (q + 1) : r * (q + 1) + (xcd - r) * q) + off; }
        const int mtg = wg >> 2; u.pn = wg & 3;
        int e = 0; while (e < NEXP - 1 && tstart[e + 1] <= mtg) ++e;
        u.e = e; u.pm = mtg - tstart[e]; u.row0 = sstart[e] + u.pm * BM; int nr = cnt[e] - u.pm * BM; u.nrows = nr < BM ? nr : BM;
        u.a = A + (size_t)u.row0 * K * 2; u.b = Bt + ((size_t)e * 1024 + (size_t)u.pn * BM) * K * 2; return true;
    }
};

template <class Epi, class Sched, bool ALIGN_EPI, bool SP2>
__device__ __forceinline__ void gemm_phase(LAS unsigned char* lds, const int K, const Sched& S, const Epi& E) {
    const int tid = threadIdx.x, wid = __builtin_amdgcn_readfirstlane(tid >> 6), lane = tid & 63, wr = wid >> 2, wc = wid & 3, fr = lane & 15, fq = lane >> 4;
    const int nt = K / BK;
    unsigned voffA[2], voffB[2];
#pragma unroll
    for (int i = 0; i < 2; ++i) { int R, C; stage_rc(tid * 16 + i * 8192, R, C); const int Rb = Epi::PERM ? ((R & ~31) + perm32(R & 31)) : R;
        voffA[i] = (unsigned)(R * K + C) * 2u; voffB[i] = (unsigned)(Rb * K + C) * 2u; }
    const size_t kstep = (size_t)(BK * 2);
    const size_t hstep = (size_t)HALF * K * 2;
    const unsigned ldsw = (unsigned)wid * 1024u;
    const int aoff = lds_byte(wr * 64 + fr, fq * 8), boff = lds_byte(wc * 32 + fr, fq * 8);
#define PG8_SA(b, h) (((b) * 2 + (h)) * HTB)
#define PG8_SB(b, h) ((4 + (b) * 2 + (h)) * HTB)
#define PG8_STAGE(bufoff, gbase, voff) do { _Pragma("unroll") for (int _i = 0; _i < 2; ++_i) \
        __builtin_amdgcn_global_load_lds((const unsigned*)((const char*)(gbase) + (voff)[_i]), (LAS unsigned*)(lds + (bufoff) + ldsw + _i * 8192), 16, 0, 0); } while (0)
#define PG8_LDA(dst, b, h) do { _Pragma("unroll") for (int m = 0; m < 4; ++m) _Pragma("unroll") for (int k = 0; k < 2; ++k) dst[m][k] = *(const LAS bf16x8*)(lds + PG8_SA(b, h) + aoff + m * 2048 + k * 1024); } while (0)
#define PG8_LDB(dst, b, h) do { _Pragma("unroll") for (int n = 0; n < 2; ++n) _Pragma("unroll") for (int k = 0; k < 2; ++k) dst[n][k] = *(const LAS bf16x8*)(lds + PG8_SB(b, h) + boff + n * 2048 + k * 1024); } while (0)
#define PG8_MMA(ai, bj, At, Bt) do { __builtin_amdgcn_s_setprio(1); _Pragma("unroll") for (int m = 0; m < 4; ++m) _Pragma("unroll") for (int n = 0; n < 2; ++n) _Pragma("unroll") for (int k = 0; k < 2; ++k) \
        acc[ai][bj][m][n] = __builtin_amdgcn_mfma_f32_16x16x32_bf16(Bt[n][k], At[m][k], acc[ai][bj][m][n], 0, 0, 0); __builtin_amdgcn_s_setprio(0); } while (0)
#define PG8_WAIT_V(n) asm volatile("s_waitcnt vmcnt(" #n ")" ::: "memory")
#define PG8_WAIT_L(n) asm volatile("s_waitcnt lgkmcnt(" #n ")" ::: "memory")
#define PG8_BAR __builtin_amdgcn_s_barrier()
#define PG8_SCHED __builtin_amdgcn_sched_barrier(0)
    Unit cur, nxt; int ui = 0;
    if (!S.next(0, cur)) return;
    f32x4 acc[2][2][4][2];
#pragma unroll
    for (int a = 0; a < 2; ++a)
#pragma unroll
        for (int b = 0; b < 2; ++b)
#pragma unroll
            for (int m = 0; m < 4; ++m)
#pragma unroll
                for (int n = 0; n < 2; ++n) acc[a][b][m][n] = (f32x4){0.f, 0.f, 0.f, 0.f};
    bf16x8 At[4][2], B0[2][2], B1[2][2];
    const char* cA = cur.a; const char* cB = cur.b;
    if constexpr (SP2) {
        PG8_STAGE(PG8_SB(0, 0), cB, voffB); PG8_STAGE(PG8_SB(0, 1), cB + hstep, voffB); PG8_STAGE(PG8_SA(0, 0), cA, voffA); PG8_STAGE(PG8_SA(0, 1), cA + hstep, voffA);
        if (wr == 1) PG8_BAR;
        PG8_WAIT_V(2); PG8_BAR;
        PG8_STAGE(PG8_SB(1, 0), cB + kstep, voffB); PG8_STAGE(PG8_SA(1, 0), cA + kstep, voffA); PG8_STAGE(PG8_SB(1, 1), cB + hstep + kstep, voffB);
        PG8_WAIT_V(6); PG8_BAR;
    } else {
        PG8_STAGE(PG8_SB(0, 0), cB, voffB); PG8_STAGE(PG8_SA(0, 0), cA, voffA); PG8_STAGE(PG8_SB(0, 1), cB + hstep, voffB); PG8_STAGE(PG8_SA(0, 1), cA + hstep, voffA);
        if (wr == 1) PG8_BAR;
        PG8_WAIT_V(4); PG8_BAR;
        PG8_STAGE(PG8_SB(1, 0), cB + kstep, voffB); PG8_STAGE(PG8_SA(1, 0), cA + kstep, voffA); PG8_STAGE(PG8_SB(1, 1), cB + hstep + kstep, voffB);
        PG8_WAIT_V(6); PG8_BAR;
    }
    for (;;) {
        const bool has_next = S.next(ui + 1, nxt);
        const char* nA = has_next ? nxt.a : cA; const char* nB = has_next ? nxt.b : cB;
        for (int t = 0; t < nt; t += 2) {
            const bool last = (t == nt - 2);
            const char* a1 = cA + (size_t)(t + 1) * kstep;
            const char* a2 = last ? nA : cA + (size_t)(t + 2) * kstep; const char* b2 = last ? nB : cB + (size_t)(t + 2) * kstep;
            const char* a3 = a2 + kstep; const char* b3 = b2 + kstep;
            if constexpr (SP2) {
            PG8_LDB(B0, 0, 0); PG8_LDB(B1, 0, 1); PG8_SCHED; PG8_LDA(At, 0, 0); PG8_STAGE(PG8_SA(1, 1), a1 + hstep, voffA);
            PG8_WAIT_V(8); PG8_WAIT_L(0); PG8_BAR; PG8_MMA(0, 0, At, B0); PG8_MMA(0, 1, At, B1); PG8_BAR; PG8_SCHED;
            PG8_LDA(At, 0, 1); PG8_STAGE(PG8_SB(0, 0), b2, voffB); PG8_STAGE(PG8_SB(0, 1), b2 + hstep, voffB); PG8_STAGE(PG8_SA(0, 0), a2, voffA);
            PG8_WAIT_V(8); PG8_WAIT_L(0); PG8_BAR; PG8_MMA(1, 0, At, B0); PG8_MMA(1, 1, At, B1); PG8_BAR; PG8_SCHED;
            PG8_LDB(B0, 1, 0); PG8_LDB(B1, 1, 1); PG8_SCHED; PG8_LDA(At, 1, 0); PG8_STAGE(PG8_SA(0, 1), a2 + hstep, voffA);
            PG8_WAIT_V(8); PG8_WAIT_L(0); PG8_BAR; PG8_MMA(0, 0, At, B0); PG8_MMA(0, 1, At, B1); PG8_BAR; PG8_SCHED;
            PG8_LDA(At, 1, 1); PG8_STAGE(PG8_SB(1, 0), b3, voffB); PG8_STAGE(PG8_SB(1, 1), b3 + hstep, voffB); PG8_STAGE(PG8_SA(1, 0), a3, voffA);
            PG8_WAIT_V(8); PG8_WAIT_L(0); PG8_BAR; PG8_MMA(1, 0, At, B0); PG8_MMA(1, 1, At, B1); PG8_BAR; PG8_SCHED;
            } else {
            PG8_LDB(B0, 0, 0); PG8_SCHED; PG8_LDA(At, 0, 0); PG8_STAGE(PG8_SA(1, 1), a1 + hstep, voffA);
            PG8_WAIT_L(8); PG8_BAR; PG8_WAIT_L(0); PG8_MMA(0, 0, At, B0); PG8_BAR; PG8_SCHED;
            PG8_LDB(B1, 0, 1); PG8_STAGE(PG8_SB(0, 0), b2, voffB);
            PG8_BAR; PG8_WAIT_L(0); PG8_MMA(0, 1, At, B1); PG8_BAR;
            PG8_LDA(At, 0, 1); PG8_STAGE(PG8_SA(0, 0), a2, voffA);
            PG8_BAR; PG8_WAIT_L(0); PG8_MMA(1, 0, At, B0); PG8_BAR; PG8_SCHED;
            PG8_STAGE(PG8_SB(0, 1), b2 + hstep, voffB);
            PG8_WAIT_V(6); PG8_BAR; PG8_MMA(1, 1, At, B1); PG8_BAR;
            PG8_LDB(B0, 1, 0); PG8_SCHED; PG8_LDA(At, 1, 0); PG8_STAGE(PG8_SA(0, 1), a2 + hstep, voffA);
            PG8_WAIT_L(8); PG8_BAR; PG8_WAIT_L(0); PG8_MMA(0, 0, At, B0); PG8_BAR; PG8_SCHED;
            PG8_LDB(B1, 1, 1); PG8_STAGE(PG8_SB(1, 0), b3, voffB);
            PG8_BAR; PG8_WAIT_L(0); PG8_MMA(0, 1, At, B1); PG8_BAR;
            PG8_LDA(At, 1, 1); PG8_STAGE(PG8_SA(1, 0), a3, voffA);
            PG8_BAR; PG8_WAIT_L(0); PG8_MMA(1, 0, At, B0); PG8_BAR; PG8_SCHED;
            PG8_STAGE(PG8_SB(1, 1), b3 + hstep, voffB);
            PG8_WAIT_V(6); PG8_BAR; PG8_MMA(1, 1, At, B1); PG8_BAR;
            }
        }
        if constexpr (ALIGN_EPI) { if (wr == 0) PG8_BAR; }
        E(acc, cur, wr, wc, fr, fq);
        if (!has_next) break;
#pragma unroll
        for (int a = 0; a < 2; ++a)
#pragma unroll
            for (int b = 0; b < 2; ++b)
#pragma unroll
                for (int m = 0; m < 4; ++m)
#pragma unroll
                    for (int n = 0; n < 2; ++n) acc[a][b][m][n] = (f32x4){0.f, 0.f, 0.f, 0.f};
        cur = nxt; cA = nA; cB = nB; ++ui;
        if constexpr (ALIGN_EPI) { if (wr == 1) PG8_BAR; }
    }
    PG8_WAIT_V(0);
    if constexpr (!ALIGN_EPI) { if (wr == 0) PG8_BAR; }
    PG8_BAR;
#undef PG8_SA
#undef PG8_SB
#undef PG8_STAGE
#undef PG8_LDA
#undef PG8_LDB
#undef PG8_MMA
#undef PG8_WAIT_V
#undef PG8_WAIT_L
#undef PG8_BAR
#undef PG8_SCHED
}
}

typedef f32x4 acc_t[2][2][4][2];

struct EpiProj {
    static constexpr bool PERM = true;
    unsigned char* ws; bf16_t* gate; const float* bias; int pn_off;
    __device__ __forceinline__ void operator()(const acc_t& acc, const pg8::Unit& u, int wr, int wc, int fr, int fq) const {
        const int pn = u.pn + pn_off;
        const int row0 = u.pm * 256 + wr * 64 + fr;
        int mode, ld, colt; bf16_t* base; float sc = 1.f;
        if (pn < 6) { mode = 0; base = (bf16_t*)(ws + WS_QA); ld = 1536; colt = pn * 256; sc = QA_SCALE; }
        else if (pn < 12) { mode = 0; base = (bf16_t*)(ws + WS_KA); ld = 1536; colt = (pn - 6) * 256; }
        else if (pn < 18) { mode = 1; base = (bf16_t*)(ws + WS_VA); ld = 1536; colt = (pn - 12) * 256; }
        else if (pn < 20) { mode = 0; base = (bf16_t*)(ws + WS_QR); ld = 512; colt = (pn - 18) * 256; }
        else if (pn < 22) { mode = 0; base = (bf16_t*)(ws + WS_KR); ld = 512; colt = (pn - 20) * 256; sc = 0.125f; }
        else if (pn < 26) { mode = 1; base = (bf16_t*)(ws + WS_VR); ld = 1024; colt = (pn - 22) * 256; }
        else if (pn < 30) { mode = 2; base = (bf16_t*)(ws + WS_GR); ld = 1024; colt = (pn - 26) * 256; }
        else { mode = 3; base = gate; ld = 2048; colt = (pn - 30) * 256; }
        if (mode == 0) {
            const float* cosT = (const float*)(ws + WS_COS); const float* sinT = (const float*)(ws + WS_SIN);
            const int q = 4 * (wc & 1) + fq;
#pragma unroll
            for (int ai = 0; ai < 2; ++ai)
#pragma unroll
                for (int m = 0; m < 4; ++m) {
                    const int row = row0 + ai * 128 + m * 16; const int pos = row & (SEQ - 1);
                    const f32x4 c4 = *(const f32x4*)(cosT + pos * 32 + 4 * q), s4 = *(const f32x4*)(sinT + pos * 32 + 4 * q);
#pragma unroll
                    for (int bj = 0; bj < 2; ++bj) {
                        const f32x4 t1 = acc[ai][bj][m][0], t2 = acc[ai][bj][m][1];
                        const f32x4 o1 = (t1 * c4 - t2 * s4) * sc, o2 = (t1 * s4 + t2 * c4) * sc;
                        bf16_t* p = base + (size_t)row * ld + colt + 128 * bj + 64 * (wc >> 1) + 4 * q;
                        u32x2 w1, w2; w1.x = cvt_pk_bf16(o1[0], o1[1]); w1.y = cvt_pk_bf16(o1[2], o1[3]); w2.x = cvt_pk_bf16(o2[0], o2[1]); w2.y = cvt_pk_bf16(o2[2], o2[3]);
                        *(u32x2*)p = w1; *(u32x2*)(p + 32) = w2;
                    }
                }
        } else {
            const int col0 = colt + wc * 32 + 8 * fq;
            f32x4 bv[2][2];
#pragma unroll
            for (int bj = 0; bj < 2; ++bj)
#pragma unroll
                for (int n = 0; n < 2; ++n) bv[bj][n] = (mode == 3) ? *(const f32x4*)(bias + col0 + bj * 128 + 4 * n) : (f32x4){0.f, 0.f, 0.f, 0.f};
#pragma unroll
            for (int ai = 0; ai < 2; ++ai)
#pragma unroll
                for (int m = 0; m < 4; ++m) {
                    bf16_t* rowp = base + (size_t)(row0 + ai * 128 + m * 16) * ld + col0;
#pragma unroll
                    for (int bj = 0; bj < 2; ++bj) {
                        f32x4 v0 = acc[ai][bj][m][0] + bv[bj][0], v1 = acc[ai][bj][m][1] + bv[bj][1];
                        if (mode >= 2) {
#pragma unroll
                            for (int i = 0; i < 4; ++i) { const float s0 = sigmoidf_(v0[i]), s1 = sigmoidf_(v1[i]); v0[i] = (mode == 2) ? v0[i] * s0 : s0; v1[i] = (mode == 2) ? v1[i] * s1 : s1; }
                        }
                        u32x4 w; w.x = cvt_pk_bf16(v0[0], v0[1]); w.y = cvt_pk_bf16(v0[2], v0[3]); w.z = cvt_pk_bf16(v1[0], v1[1]); w.w = cvt_pk_bf16(v1[2], v1[3]);
                        *(u32x4*)(rowp + bj * 128) = w;
                    }
                }
        }
    }
};

template <int MODE> struct EpiGate {
    static constexpr bool PERM = true;
    bf16_t* out; const bf16_t* prev; const bf16_t* gate; int goff;
    __device__ __forceinline__ void operator()(const acc_t& acc, const pg8::Unit& u, int wr, int wc, int fr, int fq) const {
        const int row0 = u.pm * 256 + wr * 64 + fr, col0 = u.pn * 256 + wc * 32 + 8 * fq;
#pragma unroll
        for (int ai = 0; ai < 2; ++ai)
#pragma unroll
            for (int m = 0; m < 4; ++m) {
                const size_t row = (size_t)(row0 + ai * 128 + m * 16);
#pragma unroll
                for (int bj = 0; bj < 2; ++bj) {
                    const u32x4 g = *(const u32x4*)(gate + row * 2048 + goff + col0 + bj * 128);
                    f32x4 v0 = acc[ai][bj][m][0], v1 = acc[ai][bj][m][1];
                    v0[0] *= bf_lo(g.x); v0[1] *= bf_hi(g.x); v0[2] *= bf_lo(g.y); v0[3] *= bf_hi(g.y);
                    v1[0] *= bf_lo(g.z); v1[1] *= bf_hi(g.z); v1[2] *= bf_lo(g.w); v1[3] *= bf_hi(g.w);
                    if (MODE == 1) { const u32x4 p = *(const u32x4*)(prev + row * 1024 + col0 + bj * 128);
                        v0[0] += bf_lo(p.x); v0[1] += bf_hi(p.x); v0[2] += bf_lo(p.y); v0[3] += bf_hi(p.y);
                        v1[0] += bf_lo(p.z); v1[1] += bf_hi(p.z); v1[2] += bf_lo(p.w); v1[3] += bf_hi(p.w); }
                    u32x4 w; w.x = cvt_pk_bf16(v0[0], v0[1]); w.y = cvt_pk_bf16(v0[2], v0[3]); w.z = cvt_pk_bf16(v1[0], v1[1]); w.w = cvt_pk_bf16(v1[2], v1[3]);
                    *(u32x4*)(out + row * 1024 + col0 + bj * 128) = w;
                }
            }
    }
};
struct EpiResid {
    static constexpr bool PERM = false;
    const float* x; float* H;
    __device__ __forceinline__ void operator()(const acc_t& acc, const pg8::Unit& u, int wr, int wc, int fr, int fq) const {
        const int row0 = u.pm * 256 + wr * 64 + fr, col0 = u.pn * 256 + wc * 32 + 4 * fq;
#pragma unroll
        for (int ai = 0; ai < 2; ++ai)
#pragma unroll
            for (int m = 0; m < 4; ++m) {
                const size_t off = (size_t)(row0 + ai * 128 + m * 16) * 1024 + col0;
#pragma unroll
                for (int bj = 0; bj < 2; ++bj)
#pragma unroll
                    for (int n = 0; n < 2; ++n) *(f32x4*)(H + off + bj * 128 + n * 16) = *(const f32x4*)(x + off + bj * 128 + n * 16) + acc[ai][bj][m][n];
            }
    }
};
struct EpiSwiglu {
    static constexpr bool PERM = true;
    bf16_t* hid;
    __device__ __forceinline__ void operator()(const acc_t& acc, const pg8::Unit& u, int wr, int wc, int fr, int fq) const {
        const int col0 = u.pn * 128 + wc * 32 + 8 * fq;
#pragma unroll
        for (int ai = 0; ai < 2; ++ai)
#pragma unroll
            for (int m = 0; m < 4; ++m) {
                const int rl = ai * 128 + wr * 64 + m * 16 + fr;
                f32x4 v0, v1;
#pragma unroll
                for (int i = 0; i < 4; ++i) { const float a0 = acc[ai][0][m][0][i], a1 = acc[ai][0][m][1][i];
                    v0[i] = a0 * sigmoidf_(a0) * acc[ai][1][m][0][i]; v1[i] = a1 * sigmoidf_(a1) * acc[ai][1][m][1][i]; }
                u32x4 w; w.x = cvt_pk_bf16(v0[0], v0[1]); w.y = cvt_pk_bf16(v0[2], v0[3]); w.z = cvt_pk_bf16(v1[0], v1[1]); w.w = cvt_pk_bf16(v1[2], v1[3]);
                if (rl < u.nrows) *(u32x4*)(hid + (size_t)(u.row0 + rl) * 512 + col0) = w;
            }
    }
};
struct EpiDown {
    static constexpr bool PERM = true;
    bf16_t* Y;
    __device__ __forceinline__ void operator()(const acc_t& acc, const pg8::Unit& u, int wr, int wc, int fr, int fq) const {
        const int col0 = u.pn * 256 + wc * 32 + 8 * fq;
#pragma unroll
        for (int ai = 0; ai < 2; ++ai)
#pragma unroll
            for (int m = 0; m < 4; ++m) {
                const int rl = ai * 128 + wr * 64 + m * 16 + fr;
#pragma unroll
                for (int bj = 0; bj < 2; ++bj) {
                    const f32x4 v0 = acc[ai][bj][m][0], v1 = acc[ai][bj][m][1];
                    u32x4 w; w.x = cvt_pk_bf16(v0[0], v0[1]); w.y = cvt_pk_bf16(v0[2], v0[3]); w.z = cvt_pk_bf16(v1[0], v1[1]); w.w = cvt_pk_bf16(v1[2], v1[3]);
                    if (rl < u.nrows) *(u32x4*)(Y + (size_t)(u.row0 + rl) * 1024 + col0 + bj * 128) = w;
                }
            }
    }
};

struct Args {
    const float* x; const float* norm_mix_w; const float* w_in; const float* b_gate; const float* dec_f; const float* dec_b; const float* gn_w;
    const float* w_a; const float* w_b; const float* w_o; const float* norm_moe_w; const float* wg; const float* bg; const float* we; const float* be;
    const float* w1; const float* w3; const float* w2; const float* norm_final_w;
    float* out; unsigned char* ws;
};

template <int MAP>
__device__ __forceinline__ void transpose_item(const float* W, int K, int N, bf16_t* WT, int row_off, LAS float* scr, int item, int lane, const float* kscale) {
    const int nblk = N / 32, kb = item / nblk, nb = item % nblk, k0 = 64 * kb, n0 = 32 * nb;
#pragma unroll 8
    for (int i = 0; i < 32; ++i) { const int kk = 2 * i + (lane >> 5); float v = W[(size_t)(k0 + kk) * N + n0 + (lane & 31)]; if (kscale) v *= kscale[k0 + kk]; scr[kk * 33 + (lane & 31)] = v; }
    LDS_WAIT(); asm volatile("" ::: "memory");
    const int c = lane & 7;
#pragma unroll
    for (int j = 0; j < 4; ++j) { const int n = (lane >> 3) + 8 * j; const LAS float* s = scr + (8 * c) * 33 + n;
        u32x4 o; o.x = cvt_pk_bf16(s[0 * 33], s[1 * 33]); o.y = cvt_pk_bf16(s[2 * 33], s[3 * 33]); o.z = cvt_pk_bf16(s[4 * 33], s[5 * 33]); o.w = cvt_pk_bf16(s[6 * 33], s[7 * 33]);
        const int lc = n0 + n; int dr;
        if (MAP == 0) dr = row_off + lc;
        else if (MAP == 1) dr = row_off + (lc & ~63) + 8 * ((lc & 31) >> 2) + 4 * ((lc >> 5) & 1) + (lc & 3);
        else dr = (lc >> 7) * 256 + row_off + (lc & 127);
        *(u32x4*)(WT + (size_t)dr * K + k0 + 8 * c) = o; }
    LDS_WAIT(); asm volatile("" ::: "memory");
}

__device__ __forceinline__ void rms_row_to_bf16(const float* xrow, const float* w, bf16_t* orow, int lane) {
    const f32x4* xr = (const f32x4*)xrow + lane; const f32x4* wr_ = (const f32x4*)w + lane;
    f32x4 v[4]; float s = 0.f;
#pragma unroll
    for (int j = 0; j < 4; ++j) { v[j] = xr[64 * j]; s += (v[j].x * v[j].x + v[j].y * v[j].y) + (v[j].z * v[j].z + v[j].w * v[j].w); }
    const float rstd = 1.f / sqrtf(wave_sum(s) * (1.f / DM) + NORM_EPS);
    u32x2* o8 = (u32x2*)orow + lane;
#pragma unroll
    for (int j = 0; j < 4; ++j) { const f32x4 ww = wr_[64 * j]; u32x2 o; o.x = cvt_pk_bf16(v[j].x * rstd * ww.x, v[j].y * rstd * ww.y); o.y = cvt_pk_bf16(v[j].z * rstd * ww.z, v[j].w * rstd * ww.w); o8[64 * j] = o; }
}

__device__ __forceinline__ float log_sigmoid(float x) { return x >= 0.f ? -log1pf(expf(-x)) : x - log1pf(expf(x)); }

__global__ void __launch_bounds__(NTHREADS, 2) mega_fwd(Args A) {
    extern __shared__ __attribute__((aligned(16))) unsigned char lds_raw[];
    LAS unsigned char* lds = (LAS unsigned char*)lds_raw;
    cg::grid_group grid = cg::this_grid();
    const int tid = threadIdx.x, lane = tid & 63, wave = __builtin_amdgcn_readfirstlane(tid >> 6);
    const int G = gridDim.x; const int bx = blockIdx.x;
    const int vcu = (G % 8 == 0) ? (bx % 8) * (G / 8) + bx / 8 : bx;
    const int gw = vcu * NWAVES + wave, NGW = G * NWAVES;
    unsigned char* ws = A.ws;
    unsigned* ctl = (unsigned*)(ws + WS_CTL);
    LAS int* MISC = (LAS int*)(lds + MISC_OFF);
    LAS int* l_cnt = MISC; LAS int* l_tstart = MISC + 64; LAS int* l_sstart = MISC + 192;

    {
        LAS float* scr = (LAS float*)(lds + wave * 16384);
        for (int i = gw * 64 + lane; i < SEQ * 32; i += NGW * 64) {
            const int pos = i >> 5, j = i & 31;
            const float inv_freq = 1.0f / powf(10000.0f, (float)(2 * j) / 64.0f);
            const float ang = (float)pos * inv_freq;
            ((float*)(ws + WS_COS))[i] = cosf(ang); ((float*)(ws + WS_SIN))[i] = sinf(ang);
        }
        for (int i = gw * 64 + lane; i < 80 * 1024; i += NGW * 64) {
            const int r = i >> 10, k = i & 1023; float v = 0.f;
            if (r < 8) v = A.wg[k * 8 + r]; else if (r >= 16) v = A.we[k * 64 + (r - 16)];
            ((float*)(ws + WS_WR))[i] = v * A.norm_moe_w[k];
        }
        constexpr int I_IN = (DM / 64) * (IN_W / 32), I_A = (512 / 64) * (DM / 32), I_B = (DM / 64) * (DM / 32), I_O = I_B;
        for (int it = gw; it < I_IN + I_A + I_B + I_O; it += NGW) {
            int r = it;
            if (r < I_IN) {
                const int nb = r % (IN_W / 32); const int n0 = nb * 32;
                const bool rot = (n0 < 3072) || (n0 >= 4608 && n0 < 5632);
                if (rot) transpose_item<1>(A.w_in, DM, IN_W, (bf16_t*)(ws + WS_WIN), 0, scr, r, lane, nullptr);
                else transpose_item<0>(A.w_in, DM, IN_W, (bf16_t*)(ws + WS_WIN), 0, scr, r, lane, nullptr);
                continue; } r -= I_IN;
            if (r < I_A) { transpose_item<0>(A.w_a, 512, DM, (bf16_t*)(ws + WS_WA), 0, scr, r, lane, nullptr); continue; } r -= I_A;
            if (r < I_B) { transpose_item<0>(A.w_b, DM, DM, (bf16_t*)(ws + WS_WB), 0, scr, r, lane, nullptr); continue; } r -= I_B;
            transpose_item<0>(A.w_o, DM, DM, (bf16_t*)(ws + WS_WO), 0, scr, r, lane, nullptr);
        }
        for (int m = gw; m < NTOK; m += NGW) rms_row_to_bf16(A.x + (size_t)m * DM, A.norm_mix_w, (bf16_t*)(ws + WS_XN) + (size_t)m * DM, lane);
    }
    grid.sync();

    {
        pg8::StaticOrder S; S.init(ws + WS_XN, ws + WS_WIN, NTOK, 4608, DM, G, bx);
        EpiProj E{ws, (bf16_t*)A.out, A.b_gate, 0};
        pg8::gemm_phase<EpiProj, pg8::StaticOrder, true, true>(lds, DM, S, E);
    }
    grid.sync();

#if EN_ATT
    {
        const bf16_t* QA = (const bf16_t*)(ws + WS_QA); const bf16_t* KA = (const bf16_t*)(ws + WS_KA); const bf16_t* VA = (const bf16_t*)(ws + WS_VA);
        bf16_t* OUTG = (bf16_t*)(ws + WS_OUTG); float* LSE = (float*)(ws + WS_LSE); bf16_t* YATT = (bf16_t*)(ws + WS_YATT);
        constexpr int RS = 160, TILE = 192 * RS;
        const int qi = lane & 15, g4 = lane >> 4;
        for (int unit = vcu; unit < 256; unit += G) {
            const int b = unit >> 4, h = (unit >> 1) & 7, half = unit & 1;
            for (int pair = 0; pair < 24; ++pair) {
#pragma unroll 4
                for (int it = 0; it < 12; ++it) {
                    const int p = tid + NTHREADS * it;
                    const int bs = p / 3072, rem = p % 3072, tens = rem / 1536, rem2 = rem % 1536, row = rem2 >> 3, ch = rem2 & 7;
                    const int blk = 2 * pair + bs, grp = blk >> 4, j = blk & 15;
                    const int dil = (grp == 0) ? 1 : (grp == 1 ? 4 : 16), L = SEQ / dil;
                    const int r = (grp == 0) ? 0 : (grp == 1 ? (j >> 2) : j);
                    const int mb = (grp == 0) ? (16 * half + j) : (grp == 1 ? (4 * half + (j & 3)) : half);
                    const int kidx = (mb - 1) * 64 + row;
                    u32x4 v = (u32x4){0u, 0u, 0u, 0u};
                    if (kidx >= 0 && kidx < L) {
                        const size_t tok = (size_t)b * SEQ + (size_t)kidx * dil + r;
                        const bf16_t* src = (tens ? VA : KA) + tok * 1536 + grp * 512 + h * 64 + ch * 8;
                        v = *(const u32x4*)src;
                    }
                    *(LAS u32x4*)(lds + (bs * 2 + tens) * TILE + row * RS + ch * 16) = v;
                }
                __syncthreads();
                {
                    const int bs = wave >> 2, wv = wave & 3;
                    const int blk = 2 * pair + bs, grp = blk >> 4, j = blk & 15;
                    const int dil = (grp == 0) ? 1 : (grp == 1 ? 4 : 16), L = SEQ / dil;
                    const int r = (grp == 0) ? 0 : (grp == 1 ? (j >> 2) : j);
                    const int mb = (grp == 0) ? (16 * half + j) : (grp == 1 ? (4 * half + (j & 3)) : half);
                    const int m0 = mb * 64 + 16 * wv;
                    const size_t tokq = (size_t)b * SEQ + (size_t)(m0 + qi) * dil + r;
                    const bf16_t* qp = QA + tokq * 1536 + grp * 512 + h * 64 + 8 * g4;
                    const bf16x8 qf0 = *(const bf16x8*)qp, qf1 = *(const bf16x8*)(qp + 32);
                    const LAS unsigned char* Kt = lds + (bs * 2 + 0) * TILE; const LAS unsigned char* Vt = lds + (bs * 2 + 1) * TILE;
                    f32x4 sc[9]; float mx = -INFINITY;
#pragma unroll
                    for (int kt = 0; kt < 9; ++kt) {
                        const int wrow = 16 * wv + 16 * kt;
                        const LAS unsigned char* kp = Kt + (wrow + qi) * RS + g4 * 16;
                        const bf16x8 k0 = *(const LAS bf16x8*)kp, k1 = *(const LAS bf16x8*)(kp + 64);
                        f32x4 s = (f32x4){0.f, 0.f, 0.f, 0.f};
                        s = __builtin_amdgcn_mfma_f32_16x16x32_bf16(k0, qf0, s, 0, 0, 0);
                        s = __builtin_amdgcn_mfma_f32_16x16x32_bf16(k1, qf1, s, 0, 0, 0);
                        const int kidx0 = (mb - 1) * 64 + wrow; const bool inr = (kidx0 >= 0) && (kidx0 < L);
#pragma unroll
                        for (int i = 0; i < 4; ++i) { const int kr = 4 * g4 + i; bool ok = inr; if (kt == 0) ok = ok && (kr >= qi); if (kt == 8) ok = ok && (kr <= qi);
                            s[i] = ok ? s[i] : -INFINITY; mx = fmaxf(mx, s[i]); }
                        sc[kt] = s;
                    }
                    mx = fmaxf(mx, __shfl_xor(mx, 16)); mx = fmaxf(mx, __shfl_xor(mx, 32));
                    float lsum = 0.f;
#pragma unroll
                    for (int kt = 0; kt < 9; ++kt)
#pragma unroll
                        for (int i = 0; i < 4; ++i) { const float p = fast_exp2(sc[kt][i] - mx); sc[kt][i] = p; lsum += p; }
                    lsum += __shfl_xor(lsum, 16); lsum += __shfl_xor(lsum, 32);
                    f32x4 o[4];
#pragma unroll
                    for (int dt = 0; dt < 4; ++dt) o[dt] = (f32x4){0.f, 0.f, 0.f, 0.f};
#pragma unroll
                    for (int kk = 0; kk < 5; ++kk) {
                        const int t0 = 2 * kk, t1 = (kk == 4) ? 8 : 2 * kk + 1;
                        u32x4 pw; pw.x = cvt_pk_bf16(sc[t0][0], sc[t0][1]); pw.y = cvt_pk_bf16(sc[t0][2], sc[t0][3]);
                        if (kk == 4) { pw.z = 0u; pw.w = 0u; } else { pw.z = cvt_pk_bf16(sc[t1][0], sc[t1][1]); pw.w = cvt_pk_bf16(sc[t1][2], sc[t1][3]); }
                        const bf16x8 pf = __builtin_bit_cast(bf16x8, pw);
                        const LAS unsigned char* v0p = Vt + (16 * wv + 16 * t0 + 4 * g4 + (qi >> 2)) * RS + (qi & 3) * 8;
                        const LAS unsigned char* v1p = Vt + (16 * wv + 16 * t1 + 4 * g4 + (qi >> 2)) * RS + (qi & 3) * 8;
#pragma unroll
                        for (int dt = 0; dt < 4; ++dt) {
                            const bf16x8 vf = cat4(tr_read((const LAS char*)(v0p + dt * 32)), tr_read((const LAS char*)(v1p + dt * 32)));
                            o[dt] = __builtin_amdgcn_mfma_f32_16x16x32_bf16(vf, pf, o[dt], 0, 0, 0);
                        }
                    }
                    const float rl = 1.f / lsum;
                    bf16_t* op = OUTG + ((size_t)grp * NTOK + tokq) * 512 + h * 64 + 4 * g4;
#pragma unroll
                    for (int dt = 0; dt < 4; ++dt) { u32x2 w; w.x = cvt_pk_bf16(o[dt][0] * rl, o[dt][1] * rl); w.y = cvt_pk_bf16(o[dt][2] * rl, o[dt][3] * rl); *(u32x2*)(op + 16 * dt) = w; }
                    if (g4 == 0) LSE[((size_t)grp * NTOK + tokq) * 8 + h] = (mx + log2f(lsum)) * LN2;
                }
                __syncthreads();
            }
            VM_WAIT(); __syncthreads();
            for (int it = 0; it < 16; ++it) {
                const int item = tid + NTHREADS * it; const int tl = item >> 3, ch = item & 7;
                const size_t tok = (size_t)b * SEQ + half * 1024 + tl;
                const float l0 = LSE[(0 * (size_t)NTOK + tok) * 8 + h], l1 = LSE[(1 * (size_t)NTOK + tok) * 8 + h], l2 = LSE[(2 * (size_t)NTOK + tok) * 8 + h];
                const float lm = fmaxf(l0, fmaxf(l1, l2));
                float w0 = expf(l0 - lm), w1 = expf(l1 - lm), w2 = expf(l2 - lm); const float wi = 1.f / (w0 + w1 + w2); w0 *= wi; w1 *= wi; w2 *= wi;
                const u32x4 a0 = *(const u32x4*)(OUTG + (0 * (size_t)NTOK + tok) * 512 + h * 64 + ch * 8);
                const u32x4 a1 = *(const u32x4*)(OUTG + (1 * (size_t)NTOK + tok) * 512 + h * 64 + ch * 8);
                const u32x4 a2 = *(const u32x4*)(OUTG + (2 * (size_t)NTOK + tok) * 512 + h * 64 + ch * 8);
                u32x4 y;
                y.x = cvt_pk_bf16(w0 * bf_lo(a0.x) + w1 * bf_lo(a1.x) + w2 * bf_lo(a2.x), w0 * bf_hi(a0.x) + w1 * bf_hi(a1.x) + w2 * bf_hi(a2.x));
                y.y = cvt_pk_bf16(w0 * bf_lo(a0.y) + w1 * bf_lo(a1.y) + w2 * bf_lo(a2.y), w0 * bf_hi(a0.y) + w1 * bf_hi(a1.y) + w2 * bf_hi(a2.y));
                y.z = cvt_pk_bf16(w0 * bf_lo(a0.z) + w1 * bf_lo(a1.z) + w2 * bf_lo(a2.z), w0 * bf_hi(a0.z) + w1 * bf_hi(a1.z) + w2 * bf_hi(a2.z));
                y.w = cvt_pk_bf16(w0 * bf_lo(a0.w) + w1 * bf_lo(a1.w) + w2 * bf_lo(a2.w), w0 * bf_hi(a0.w) + w1 * bf_hi(a1.w) + w2 * bf_hi(a2.w));
                *(u32x4*)(YATT + tok * 512 + h * 64 + ch * 8) = y;
            }
            __syncthreads();
        }
    }
#else
    { u32x4* p = (u32x4*)(ws + WS_YATT); for (size_t i = (size_t)bx * NTHREADS + tid; i < (size_t)NTOK * 512 * 2 / 16; i += (size_t)G * NTHREADS) p[i] = (u32x4){0u, 0u, 0u, 0u}; }
#endif
    grid.sync();

    {
        pg8::StaticOrder S; S.init(ws + WS_XN, ws + WS_WIN + (size_t)4608 * DM * 2, NTOK, 5120, DM, G, bx);
        EpiProj E{ws, (bf16_t*)A.out, A.b_gate, 18};
        pg8::gemm_phase<EpiProj, pg8::StaticOrder, true, true>(lds, DM, S, E);
    }
    grid.sync();

#if EN_RET
    {
        const bf16_t* KR = (const bf16_t*)(ws + WS_KR); const bf16_t* VR = (const bf16_t*)(ws + WS_VR); bf16_t* SST = (bf16_t*)(ws + WS_SST);
        constexpr int RSK = 160, RSV = 288; constexpr int KT_OFF = 0, VT_OFF = 128 * RSK;
        const int dcol = lane & 15, g4 = lane >> 4;
        for (int unit = vcu; unit < 256; unit += G) {
            const int b = unit >> 4, h = (unit >> 1) & 7, dir = unit & 1;
            const float lg = log_sigmoid(dir ? A.dec_b[h] : A.dec_f[h]); const float lg2 = lg * LOG2E; const float cd = exp2f(128.f * lg2);
            f32x4 st[4];
#pragma unroll
            for (int dt = 0; dt < 4; ++dt) st[dt] = (f32x4){0.f, 0.f, 0.f, 0.f};
            for (int step = 0; step < 16; ++step) {
                const int n = dir ? 15 - step : step;
                bf16_t* sp = SST + ((size_t)((b * 8 + h) * 2 + dir) * 16 + n) * 8192;
#pragma unroll
                for (int dt = 0; dt < 4; ++dt) { u32x2 w; w.x = cvt_pk_bf16(st[dt][0], st[dt][1]); w.y = cvt_pk_bf16(st[dt][2], st[dt][3]); *(u32x2*)(sp + (16 * dt + dcol) * 128 + 16 * wave + 4 * g4) = w; }
                const size_t tok0 = (size_t)b * SEQ + n * 128;
#pragma unroll
                for (int it = 0; it < 2; ++it) { const int p = tid + NTHREADS * it, row = p >> 3, ch = p & 7;
                    const u32x4 v = *(const u32x4*)(KR + (tok0 + row) * 512 + h * 64 + ch * 8);
                    const float z = exp2f(lg2 * (float)(dir ? row : 127 - row));
                    u32x4 o; o.x = cvt_pk_bf16(bf_lo(v.x) * z, bf_hi(v.x) * z); o.y = cvt_pk_bf16(bf_lo(v.y) * z, bf_hi(v.y) * z); o.z = cvt_pk_bf16(bf_lo(v.z) * z, bf_hi(v.z) * z); o.w = cvt_pk_bf16(bf_lo(v.w) * z, bf_hi(v.w) * z);
                    *(LAS u32x4*)(lds + KT_OFF + row * RSK + ch * 16) = o; }
#pragma unroll
                for (int it = 0; it < 4; ++it) { const int p = tid + NTHREADS * it, row = p >> 4, ch = p & 15;
                    *(LAS u32x4*)(lds + VT_OFF + row * RSV + ch * 16) = *(const u32x4*)(VR + (tok0 + row) * 1024 + h * 128 + ch * 8); }
                __syncthreads();
#pragma unroll
                for (int dt = 0; dt < 4; ++dt) st[dt] = st[dt] * cd;
#pragma unroll
                for (int kk = 0; kk < 4; ++kk) {
                    const int r0 = 32 * kk + 4 * g4 + (dcol >> 2), r1 = r0 + 16;
                    const LAS unsigned char* vb = lds + VT_OFF + (16 * wave + 4 * (dcol & 3)) * 2;
                    const bf16x8 af = cat4(tr_read((const LAS char*)(vb + r0 * RSV)), tr_read((const LAS char*)(vb + r1 * RSV)));
#pragma unroll
                    for (int dt = 0; dt < 4; ++dt) {
                        const LAS unsigned char* kb = lds + KT_OFF + (16 * dt + 4 * (dcol & 3)) * 2;
                        const bf16x8 bfr = cat4(tr_read((const LAS char*)(kb + r0 * RSK)), tr_read((const LAS char*)(kb + r1 * RSK)));
                        st[dt] = __builtin_amdgcn_mfma_f32_16x16x32_bf16(af, bfr, st[dt], 0, 0, 0);
                    }
                }
                __syncthreads();
            }
        }
    }
    grid.sync();
    {
        const bf16_t* QR = (const bf16_t*)(ws + WS_QR); const bf16_t* KR = (const bf16_t*)(ws + WS_KR); const bf16_t* VR = (const bf16_t*)(ws + WS_VR);
        const bf16_t* GR = (const bf16_t*)(ws + WS_GR); const bf16_t* SST = (const bf16_t*)(ws + WS_SST); bf16_t* YRET = (bf16_t*)(ws + WS_YRET);
        constexpr int RSK = 160, RSV = 288; constexpr int QT = 0, KT = 20480, VT = 40960, SF = 77824, SB = 96256;
        const int qi = lane & 15, g4 = lane >> 4;
        for (int unit = vcu; unit < 2048; unit += G) {
            const int bh = unit >> 4, n = unit & 15, b = bh >> 3, h = bh & 7;
            const float lgf2 = log_sigmoid(A.dec_f[h]) * LOG2E, lgb2 = log_sigmoid(A.dec_b[h]) * LOG2E;
            const size_t tok0 = (size_t)b * SEQ + n * 128;
#pragma unroll
            for (int it = 0; it < 2; ++it) { const int p = tid + NTHREADS * it, row = p >> 3, ch = p & 7;
                *(LAS u32x4*)(lds + QT + row * RSK + ch * 16) = *(const u32x4*)(QR + (tok0 + row) * 512 + h * 64 + ch * 8);
                *(LAS u32x4*)(lds + KT + row * RSK + ch * 16) = *(const u32x4*)(KR + (tok0 + row) * 512 + h * 64 + ch * 8); }
#pragma unroll
            for (int it = 0; it < 4; ++it) { const int p = tid + NTHREADS * it, row = p >> 4, ch = p & 15;
                *(LAS u32x4*)(lds + VT + row * RSV + ch * 16) = *(const u32x4*)(VR + (tok0 + row) * 1024 + h * 128 + ch * 8); }
#pragma unroll
            for (int it = 0; it < 2; ++it) { const int p = tid + NTHREADS * it, row = p >> 4, ch = p & 15;
                *(LAS u32x4*)(lds + SF + row * RSV + ch * 16) = *(const u32x4*)(SST + ((size_t)(bh * 2 + 0) * 16 + n) * 8192 + row * 128 + ch * 8);
                *(LAS u32x4*)(lds + SB + row * RSV + ch * 16) = *(const u32x4*)(SST + ((size_t)(bh * 2 + 1) * 16 + n) * 8192 + row * 128 + ch * 8); }
            __syncthreads();
            {
                const int qa = 16 * wave + qi;
                const LAS unsigned char* qrow = lds + QT + qa * RSK;
                const bf16x8 qf0 = *(const LAS bf16x8*)(qrow + g4 * 16), qf1 = *(const LAS bf16x8*)(qrow + 64 + g4 * 16);
                bf16x8 pf[4];
#pragma unroll
                for (int kk = 0; kk < 4; ++kk) {
                    u32x4 pw;
#pragma unroll
                    for (int tt = 0; tt < 2; ++tt) {
                        const int kt = 2 * kk + tt;
                        const LAS unsigned char* kp = lds + KT + (16 * kt + qi) * RSK + g4 * 16;
                        const bf16x8 k0 = *(const LAS bf16x8*)kp, k1 = *(const LAS bf16x8*)(kp + 64);
                        f32x4 s = (f32x4){0.f, 0.f, 0.f, 0.f};
                        s = __builtin_amdgcn_mfma_f32_16x16x32_bf16(k0, qf0, s, 0, 0, 0);
                        s = __builtin_amdgcn_mfma_f32_16x16x32_bf16(k1, qf1, s, 0, 0, 0);
#pragma unroll
                        for (int i = 0; i < 4; ++i) { const int kb_ = 16 * kt + 4 * g4 + i; const int dl = qa - kb_;
                            const float w = dl > 0 ? fast_exp2(lgf2 * (float)dl) : (dl < 0 ? fast_exp2(lgb2 * (float)(-dl)) : 2.f); s[i] *= w; }
                        if (tt == 0) { pw.x = cvt_pk_bf16(s[0], s[1]); pw.y = cvt_pk_bf16(s[2], s[3]); } else { pw.z = cvt_pk_bf16(s[0], s[1]); pw.w = cvt_pk_bf16(s[2], s[3]); }
                    }
                    pf[kk] = __builtin_bit_cast(bf16x8, pw);
                }
                const float xif = fast_exp2(lgf2 * (float)(qa + 1)), xib = fast_exp2(lgb2 * (float)(128 - qa));
                bf16x8 qxf[2], qxb[2];
#pragma unroll
                for (int kk = 0; kk < 2; ++kk) {
                    const u32x2 a = *(const LAS u32x2*)(qrow + (32 * kk + 4 * g4) * 2), c = *(const LAS u32x2*)(qrow + (32 * kk + 16 + 4 * g4) * 2);
                    u32x4 f, bq;
                    f.x = cvt_pk_bf16(bf_lo(a.x) * xif, bf_hi(a.x) * xif); f.y = cvt_pk_bf16(bf_lo(a.y) * xif, bf_hi(a.y) * xif); f.z = cvt_pk_bf16(bf_lo(c.x) * xif, bf_hi(c.x) * xif); f.w = cvt_pk_bf16(bf_lo(c.y) * xif, bf_hi(c.y) * xif);
                    bq.x = cvt_pk_bf16(bf_lo(a.x) * xib, bf_hi(a.x) * xib); bq.y = cvt_pk_bf16(bf_lo(a.y) * xib, bf_hi(a.y) * xib); bq.z = cvt_pk_bf16(bf_lo(c.x) * xib, bf_hi(c.x) * xib); bq.w = cvt_pk_bf16(bf_lo(c.y) * xib, bf_hi(c.y) * xib);
                    qxf[kk] = __builtin_bit_cast(bf16x8, f); qxb[kk] = __builtin_bit_cast(bf16x8, bq);
                }
                f32x4 o[8];
                const int trow = 4 * g4 + (qi >> 2), tcol = (qi & 3) * 8;
#pragma unroll
                for (int vt = 0; vt < 8; ++vt) {
                    f32x4 acc = (f32x4){0.f, 0.f, 0.f, 0.f};
#pragma unroll
                    for (int kk = 0; kk < 4; ++kk) {
                        const LAS unsigned char* vb = lds + VT + (32 * kk + trow) * RSV + vt * 32 + tcol;
                        const bf16x8 af = cat4(tr_read((const LAS char*)vb), tr_read((const LAS char*)(vb + 16 * RSV)));
                        acc = __builtin_amdgcn_mfma_f32_16x16x32_bf16(af, pf[kk], acc, 0, 0, 0);
                    }
#pragma unroll
                    for (int kk = 0; kk < 2; ++kk) {
                        const LAS unsigned char* sfp = lds + SF + (32 * kk + trow) * RSV + vt * 32 + tcol;
                        const bf16x8 af = cat4(tr_read((const LAS char*)sfp), tr_read((const LAS char*)(sfp + 16 * RSV)));
                        acc = __builtin_amdgcn_mfma_f32_16x16x32_bf16(af, qxf[kk], acc, 0, 0, 0);
                        const LAS unsigned char* sbp = lds + SB + (32 * kk + trow) * RSV + vt * 32 + tcol;
                        const bf16x8 ab = cat4(tr_read((const LAS char*)sbp), tr_read((const LAS char*)(sbp + 16 * RSV)));
                        acc = __builtin_amdgcn_mfma_f32_16x16x32_bf16(ab, qxb[kk], acc, 0, 0, 0);
                    }
                    o[vt] = acc;
                }
                float s = 0.f;
#pragma unroll
                for (int vt = 0; vt < 8; ++vt) s += (o[vt][0] + o[vt][1]) + (o[vt][2] + o[vt][3]);
                s += __shfl_xor(s, 16); s += __shfl_xor(s, 32);
                const float mu = s * (1.f / 128.f); float q2 = 0.f;
#pragma unroll
                for (int vt = 0; vt < 8; ++vt) { const f32x4 d = o[vt] - mu; q2 += (d[0] * d[0] + d[1] * d[1]) + (d[2] * d[2] + d[3] * d[3]); }
                q2 += __shfl_xor(q2, 16); q2 += __shfl_xor(q2, 32);
                const float rstd = 1.f / sqrtf(q2 * (1.f / 128.f) + NORM_EPS);
                const size_t tok = tok0 + qa;
#pragma unroll
                for (int vt = 0; vt < 8; ++vt) {
                    const int col = h * 128 + 16 * vt + 4 * g4;
                    const f32x4 gw4 = *(const f32x4*)(A.gn_w + col); const u32x2 sg = *(const u32x2*)(GR + tok * 1024 + col);
                    const f32x4 d = (o[vt] - mu) * rstd;
                    u32x2 w; w.x = cvt_pk_bf16(d[0] * gw4[0] * bf_lo(sg.x), d[1] * gw4[1] * bf_hi(sg.x)); w.y = cvt_pk_bf16(d[2] * gw4[2] * bf_lo(sg.y), d[3] * gw4[3] * bf_hi(sg.y));
                    *(u32x2*)(YRET + tok * 1024 + col) = w;
                }
            }
            __syncthreads();
        }
    }
#else
    { u32x4* p = (u32x4*)(ws + WS_YRET); for (size_t i = (size_t)bx * NTHREADS + tid; i < (size_t)NTOK * 1024 * 2 / 16; i += (size_t)G * NTHREADS) p[i] = (u32x4){0u, 0u, 0u, 0u}; }
#endif
    grid.sync();

    {
        pg8::StaticOrder S; S.init(ws + WS_YATT, ws + WS_WA, NTOK, DM, 512, G, bx);
        EpiGate<0> E{(bf16_t*)(ws + WS_TMP), nullptr, (const bf16_t*)A.out, 0};
        pg8::gemm_phase<EpiGate<0>, pg8::StaticOrder, true, true>(lds, 512, S, E);
    }
    {
        pg8::StaticOrder S; S.init(ws + WS_YRET, ws + WS_WB, NTOK, DM, DM, G, bx);
        EpiGate<1> E{(bf16_t*)(ws + WS_MERGED), (const bf16_t*)(ws + WS_TMP), (const bf16_t*)A.out, 1024};
        pg8::gemm_phase<EpiGate<1>, pg8::StaticOrder, true, true>(lds, DM, S, E);
    }
    grid.sync();

    {
        pg8::StaticOrder S; S.init(ws + WS_MERGED, ws + WS_WO, NTOK, DM, DM, G, bx);
        EpiResid E{A.x, (float*)(ws + WS_H)};
        pg8::gemm_phase<EpiResid, pg8::StaticOrder, true, true>(lds, DM, S, E);
    }
    grid.sync();

#if EN_MOE
    {
        const float* H = (const float*)(ws + WS_H); const float* WR = (const float*)(ws + WS_WR); bf16_t* HN = (bf16_t*)(ws + WS_HN);
        unsigned* ASG = (unsigned*)(ws + WS_ASG);
        LAS float* LG = (LAS float*)(lds + wave * 8192);
        const int tk = lane & 15, kq = lane >> 4;
        for (int tile = gw; tile < NTOK / 16; tile += NGW) {
            const int t0 = tile * 16;
            f32x4 acc[5];
#pragma unroll
            for (int nt = 0; nt < 5; ++nt) acc[nt] = (f32x4){0.f, 0.f, 0.f, 0.f};
            float ss = 0.f;
            const float* hp = H + (size_t)(t0 + tk) * DM + 4 * kq;
            const float* wp = WR + (size_t)tk * DM + 4 * kq;
#pragma unroll 2
            for (int s = 0; s < 64; ++s) {
                const f32x4 a4 = *(const f32x4*)(hp + 16 * s);
                ss += (a4[0] * a4[0] + a4[1] * a4[1]) + (a4[2] * a4[2] + a4[3] * a4[3]);
#pragma unroll
                for (int nt = 0; nt < 5; ++nt) {
                    const f32x4 b4 = *(const f32x4*)(wp + (size_t)nt * 16 * DM + 16 * s);
#pragma unroll
                    for (int j = 0; j < 4; ++j) acc[nt] = __builtin_amdgcn_mfma_f32_16x16x4f32(a4[j], b4[j], acc[nt], 0, 0, 0);
                }
            }
            ss += __shfl_xor(ss, 16); ss += __shfl_xor(ss, 32);
            const float rstd = 1.f / sqrtf(ss * (1.f / DM) + NORM_EPS);
#pragma unroll
            for (int nt = 0; nt < 5; ++nt)
#pragma unroll
                for (int i = 0; i < 4; ++i) LG[(4 * kq + i) * 81 + 16 * nt + tk] = acc[nt][i];
            LDS_WAIT(); asm volatile("" ::: "memory");
            if (lane < 16) {
                const LAS float* lr = LG + lane * 81;
                float gl[8]; float gmax = -INFINITY; int gi = 0;
#pragma unroll
                for (int j = 0; j < 8; ++j) { gl[j] = lr[j] * rstd + A.bg[j]; if (gl[j] > gmax) { gmax = gl[j]; gi = j; } }
                float gs = 0.f;
#pragma unroll
                for (int j = 0; j < 8; ++j) gs += expf(gl[j] - gmax);
                const float g_w = 1.f / gs;
                float l1 = -INFINITY, l2 = -INFINITY; int i1 = 0, i2 = 0;
#pragma unroll
                for (int j = 0; j < 8; ++j) { const float v = lr[16 + 8 * gi + j] * rstd + A.be[8 * gi + j];
                    if (v > l1) { l2 = l1; i2 = i1; l1 = v; i1 = j; } else if (v > l2) { l2 = v; i2 = j; } }
                const float e1 = 1.f / (1.f + expf(l2 - l1)), e2 = 1.f - e1;
                const int eid1 = gi * 8 + i1, eid2 = gi * 8 + i2;
                const unsigned p1 = atomicAdd(ctl + CW_CNT + eid1, 1u), p2 = atomicAdd(ctl + CW_CNT + eid2, 1u);
                u32x4 r0, r1; r0.x = (unsigned)eid1; r0.y = p1; r0.z = __float_as_uint(g_w * e1); r0.w = (unsigned)eid2; r1.x = p2; r1.y = __float_as_uint(g_w * e2); r1.z = 0u; r1.w = 0u;
                *(u32x4*)(ASG + (size_t)(t0 + lane) * 8) = r0; *(u32x4*)(ASG + (size_t)(t0 + lane) * 8 + 4) = r1;
            }
            for (int r = 0; r < 16; ++r) {
                const float rs = __shfl(rstd, r);
                const f32x4* xr = (const f32x4*)(H + (size_t)(t0 + r) * DM) + lane; const f32x4* wn = (const f32x4*)A.norm_moe_w + lane;
                u32x2* o8 = (u32x2*)(HN + (size_t)(t0 + r) * DM) + lane;
#pragma unroll
                for (int j = 0; j < 4; ++j) { const f32x4 v = xr[64 * j], ww = wn[64 * j]; u32x2 o; o.x = cvt_pk_bf16(v.x * rs * ww.x, v.y * rs * ww.y); o.y = cvt_pk_bf16(v.z * rs * ww.z, v.w * rs * ww.w); o8[64 * j] = o; }
            }
            LDS_WAIT(); asm volatile("" ::: "memory");
        }
        __syncthreads();
        {
            LAS float* scr = (LAS float*)(lds + wave * 16384);
            for (int it = gw; it < NEXP * 768; it += NGW) {
                const int e = it / 768, r = it % 768;
                if (r < 256) transpose_item<2>(A.w1 + (size_t)e * 1024 * 512, 1024, 512, (bf16_t*)(ws + WS_W13) + (size_t)e * 1024 * 1024, 0, scr, r, lane, nullptr);
                else if (r < 512) transpose_item<2>(A.w3 + (size_t)e * 1024 * 512, 1024, 512, (bf16_t*)(ws + WS_W13) + (size_t)e * 1024 * 1024, 128, scr, r - 256, lane, nullptr);
                else transpose_item<0>(A.w2 + (size_t)e * 512 * 1024, 512, 1024, (bf16_t*)(ws + WS_W2) + (size_t)e * 1024 * 512, 0, scr, r - 512, lane, nullptr);
            }
        }
    }
    grid.sync();
    {
        if (tid < 64) l_cnt[tid] = (int)__hip_atomic_load(ctl + CW_CNT + tid, __ATOMIC_RELAXED, __HIP_MEMORY_SCOPE_AGENT);
        __syncthreads();
        if (tid == 0) { int ts = 0, ss = 0; for (int e = 0; e < NEXP; ++e) { l_tstart[e] = ts; l_sstart[e] = ss; ts += (l_cnt[e] + 255) >> 8; ss += l_cnt[e]; } l_tstart[NEXP] = ts; l_sstart[NEXP] = ss; }
        __syncthreads();
        unsigned* ASG = (unsigned*)(ws + WS_ASG); const bf16_t* HN = (const bf16_t*)(ws + WS_HN); bf16_t* XS = (bf16_t*)(ws + WS_XS);
        for (int a = gw; a < NTOK * 2; a += NGW) {
            const int tok = a >> 1, k = a & 1;
            const unsigned eid = ASG[(size_t)tok * 8 + (k ? 3 : 0)], pos = ASG[(size_t)tok * 8 + (k ? 4 : 1)];
            const int slot = l_sstart[eid] + (int)pos;
            const u32x4* src = (const u32x4*)(HN + (size_t)tok * DM) + lane; u32x4* dst = (u32x4*)(XS + (size_t)slot * DM) + lane;
            dst[0] = src[0]; dst[64] = src[64];
            if (lane == 0) ASG[(size_t)tok * 8 + 6 + k] = (unsigned)slot;
        }
    }
    grid.sync();
    {
        pg8::GroupedOrder S{(const char*)(ws + WS_XS), (const char*)(ws + WS_W13), DM, G, bx, l_cnt, l_tstart, l_sstart};
        EpiSwiglu E{(bf16_t*)(ws + WS_HID)};
        pg8::gemm_phase<EpiSwiglu, pg8::GroupedOrder, true, true>(lds, DM, S, E);
    }
    grid.sync();
    {
        pg8::GroupedOrder S{(const char*)(ws + WS_HID), (const char*)(ws + WS_W2), 512, G, bx, l_cnt, l_tstart, l_sstart};
        EpiDown E{(bf16_t*)(ws + WS_Y)};
        pg8::gemm_phase<EpiDown, pg8::GroupedOrder, true, true>(lds, 512, S, E);
    }
    grid.sync();
#endif
    {
        const float* H = (const float*)(ws + WS_H); const unsigned* ASG = (const unsigned*)(ws + WS_ASG); const bf16_t* Y = (const bf16_t*)(ws + WS_Y);
        for (int m = gw; m < NTOK; m += NGW) {
            const f32x4* xr = (const f32x4*)(H + (size_t)m * DM) + lane;
            f32x4 v[4];
#pragma unroll
            for (int j = 0; j < 4; ++j) v[j] = xr[64 * j];
#if EN_MOE
            const float g1 = __uint_as_float(ASG[(size_t)m * 8 + 2]), g2 = __uint_as_float(ASG[(size_t)m * 8 + 5]);
            const unsigned s1 = ASG[(size_t)m * 8 + 6], s2 = ASG[(size_t)m * 8 + 7];
            const u32x2* y1 = (const u32x2*)(Y + (size_t)s1 * DM) + lane; const u32x2* y2 = (const u32x2*)(Y + (size_t)s2 * DM) + lane;
#pragma unroll
            for (int j = 0; j < 4; ++j) { const u32x2 a = y1[64 * j], c = y2[64 * j];
                v[j].x += g1 * bf_lo(a.x) + g2 * bf_lo(c.x); v[j].y += g1 * bf_hi(a.x) + g2 * bf_hi(c.x); v[j].z += g1 * bf_lo(a.y) + g2 * bf_lo(c.y); v[j].w += g1 * bf_hi(a.y) + g2 * bf_hi(c.y); }
#endif
            float s = 0.f;
#pragma unroll
            for (int j = 0; j < 4; ++j) s += (v[j].x * v[j].x + v[j].y * v[j].y) + (v[j].z * v[j].z + v[j].w * v[j].w);
            const float rstd = 1.f / sqrtf(wave_sum(s) * (1.f / DM) + NORM_EPS);
            const f32x4* wf = (const f32x4*)A.norm_final_w + lane; f32x4* o = (f32x4*)(A.out + (size_t)m * DM) + lane;
#pragma unroll
            for (int j = 0; j < 4; ++j) o[64 * j] = v[j] * rstd * wf[64 * j];
        }
    }
}

extern "C" void kernel_launch(void* const* d_in, const int* in_sizes, int n_in, void* d_out, int out_size, void* d_ws, size_t ws_size, hipStream_t stream) {
    static int grid = 0;
    if (grid == 0) {
        if (n_in != 19 || in_sizes[0] != NTOK * DM || out_size != NTOK * DM || ws_size < WS_END) { fprintf(stderr, "kernel_launch: unexpected problem (n_in %d, ws %zu)\n", n_in, ws_size); grid = -1; return; }
        int dev = 0, cus = 0, per_cu = 0;
        (void)hipGetDevice(&dev); (void)hipDeviceGetAttribute(&cus, hipDeviceAttributeMultiprocessorCount, dev);
        (void)hipFuncSetAttribute((const void*)mega_fwd, hipFuncAttributeMaxDynamicSharedMemorySize, LDS_BYTES);
        (void)hipOccupancyMaxActiveBlocksPerMultiprocessor(&per_cu, (const void*)mega_fwd, NTHREADS, LDS_BYTES);
        (void)hipGetLastError();
        if (per_cu < 1) { fprintf(stderr, "kernel_launch: occupancy query says %d blocks per CU\n", per_cu); per_cu = 1; }
        grid = cus;
    }
    if (grid < 0) return;
    (void)hipMemsetAsync((char*)d_ws + WS_CTL, 0, CTL_ZERO_BYTES, stream);
    Args a{};
    a.x = (const float*)d_in[0]; a.norm_mix_w = (const float*)d_in[1]; a.w_in = (const float*)d_in[2]; a.b_gate = (const float*)d_in[3]; a.dec_f = (const float*)d_in[4]; a.dec_b = (const float*)d_in[5];
    a.gn_w = (const float*)d_in[6]; a.w_a = (const float*)d_in[7]; a.w_b = (const float*)d_in[8]; a.w_o = (const float*)d_in[9]; a.norm_moe_w = (const float*)d_in[10]; a.wg = (const float*)d_in[11];
    a.bg = (const float*)d_in[12]; a.we = (const float*)d_in[13]; a.be = (const float*)d_in[14]; a.w1 = (const float*)d_in[15]; a.w3 = (const float*)d_in[16]; a.w2 = (const float*)d_in[17];
    a.norm_final_w = (const float*)d_in[18]; a.out = (float*)d_out; a.ws = (unsigned char*)d_ws;
    void* args[] = {&a};
    hipError_t e = hipLaunchCooperativeKernel((const void*)mega_fwd, dim3(grid), dim3(NTHREADS), args, LDS_BYTES, stream);
    if (e != hipSuccess) fprintf(stderr, "cooperative launch failed: %s (grid %d)\n", hipGetErrorString(e), grid);
}
```

```cpp
#include <hip/hip_runtime.h>
#include <hip/hip_cooperative_groups.h>
#include <cstdio>
#include <cstdint>
namespace cg = cooperative_groups;

#ifndef EN_ATT
#define EN_ATT 1
#endif
#ifndef EN_RET
#define EN_RET 1
#endif
#ifndef EN_MOE
#define EN_MOE 1
#endif

#define LAS __attribute__((address_space(3)))
#define GAS __attribute__((address_space(1)))
typedef unsigned short bf16_t;
typedef short bf16x8 __attribute__((ext_vector_type(8)));
typedef short s16x4 __attribute__((ext_vector_type(4)));
typedef float f32x4 __attribute__((ext_vector_type(4)));
typedef float f32x2 __attribute__((ext_vector_type(2)));
typedef unsigned u32x4 __attribute__((ext_vector_type(4)));
typedef unsigned u32x2 __attribute__((ext_vector_type(2)));

constexpr int NTOK = 32768, DM = 1024, SEQ = 2048, NBATCH = 16;
constexpr int IN_W = 9728;
constexpr int NEXP = 64;
constexpr float NORM_EPS = 1e-6f;
constexpr float LOG2E = 1.4426950408889634f, LN2 = 0.6931471805599453f;
constexpr float W8_SCALE = 32.f, W8_DESCALE = 1.f / 32.f;
constexpr float QA_SCALE = 0.125f * LOG2E;
constexpr int NWAVES = 8, NTHREADS = 512;

constexpr size_t MiB = (size_t)1 << 20;
constexpr size_t WS_CTL = 0, CTL_ZERO_BYTES = 65536;
constexpr size_t WS_COS = 1 * MiB, WS_SIN = WS_COS + 262144, WS_WR = WS_COS + 524288;
constexpr size_t WS_ASG = 2 * MiB;
constexpr size_t WS_LSE = 3 * MiB;
constexpr size_t WS_RSTD = 3 * MiB;
constexpr size_t WS_SRSTD = 3 * MiB + 262144;
constexpr size_t WS_TOKL = 4 * MiB;
constexpr size_t WS_CNTT = 5 * MiB;
constexpr size_t WS_WIN = 6 * MiB;
constexpr size_t WS_WA = 25 * MiB;
constexpr size_t WS_WB = 26 * MiB;
constexpr size_t WS_WO = 28 * MiB;
constexpr size_t WS_XN = 30 * MiB;
constexpr size_t WS_MERGED = 30 * MiB;
constexpr size_t WS_QA = 94 * MiB, WS_KA = 190 * MiB, WS_VA = 286 * MiB;
constexpr size_t WS_OUTG = 382 * MiB;
constexpr size_t WS_GATE = 350 * MiB;
constexpr size_t WS_QR = 94 * MiB, WS_KR = 126 * MiB;
constexpr size_t WS_VR = 158 * MiB, WS_GR = 222 * MiB;
constexpr size_t WS_SST = 286 * MiB;
constexpr size_t WS_MIX = 417 * MiB;
constexpr size_t WS_W2 = 30 * MiB;
constexpr size_t WS_W13 = 94 * MiB;
constexpr size_t WS_HN = 224 * MiB;
constexpr size_t WS_XS = 288 * MiB;
constexpr size_t WS_HID = 288 * MiB;
constexpr size_t WS_Y = 94 * MiB;
constexpr size_t WS_XN8 = 510 * MiB;
constexpr size_t WS_WIN8 = 542 * MiB;
constexpr size_t WS_END = 547 * MiB;

constexpr int RING_BYTES = 131072;
constexpr int MISC_OFF = RING_BYTES;
constexpr int ROFF_OFF = MISC_OFF + 2048;
constexpr int ROFF_UNITS = 15;
constexpr int RSC_OFF = ROFF_OFF + ROFF_UNITS * 256 * 4;
constexpr int LDS_BYTES = 163840;

__device__ __forceinline__ unsigned cvt_pk_bf16(float lo, float hi) { unsigned r; asm volatile("v_cvt_pk_bf16_f32 %0, %1, %2" : "=v"(r) : "v"(lo), "v"(hi)); return r; }
__device__ __forceinline__ unsigned pk_fp8x4(float a, float b, float c, float d) { int w = 0; w = __builtin_amdgcn_cvt_pk_fp8_f32(a, b, w, false); w = __builtin_amdgcn_cvt_pk_fp8_f32(c, d, w, true); return (unsigned)w; }
__device__ __forceinline__ float bf_lo(unsigned w) { return __uint_as_float(w << 16); }
__device__ __forceinline__ float bf_hi(unsigned w) { return __uint_as_float(w & 0xffff0000u); }
__device__ __forceinline__ float fast_exp2(float x) { return __builtin_amdgcn_exp2f(x); }
__device__ __forceinline__ float fast_rcp(float x) { return __builtin_amdgcn_rcpf(x); }
__device__ __forceinline__ float sigmoidf_(float x) { return fast_rcp(1.f + fast_exp2(-x * LOG2E)); }
__device__ __forceinline__ float wave_sum(float v) {
#pragma unroll
    for (int o = 1; o < 64; o <<= 1) v += __shfl_xor(v, o);
    return v;
}
__device__ __forceinline__ s16x4 tr_read(const LAS char* p) {
    typedef short v4i16_t __attribute__((ext_vector_type(4)));
    return __builtin_bit_cast(s16x4, __builtin_amdgcn_ds_read_tr16_b64_v4i16((LAS v4i16_t*)p));
}
__device__ __forceinline__ bf16x8 cat4(s16x4 a, s16x4 b) { return (bf16x8){a[0], a[1], a[2], a[3], b[0], b[1], b[2], b[3]}; }
__device__ __forceinline__ int opaque_tid() { int t = threadIdx.x; asm volatile("" : "+v"(t)); return t; }
#define PHASE_IDS const int tid = opaque_tid(), lane = tid & 63, wave = __builtin_amdgcn_readfirstlane(tid >> 6); const int gw = vcu * NWAVES + wave; (void)gw; (void)lane
__device__ __forceinline__ void glds16(const void* gsrc, unsigned lds_dst) { unsigned keep;
    asm volatile("s_mov_b32 %0, m0\n\ts_mov_b32 m0, %2\n\ts_nop 0\n\tglobal_load_lds_dwordx4 %1, off\n\ts_mov_b32 m0, %0" : "=&s"(keep) : "v"(gsrc), "s"(lds_dst) : "memory"); }
#define LDS_WAIT() asm volatile("s_waitcnt lgkmcnt(0)" ::: "memory")
#define VM_WAIT() asm volatile("s_waitcnt vmcnt(0)" ::: "memory")

namespace pg8 {
constexpr int BM = 256, BK = 64, HALF = 128, HTB = HALF * BK * 2, STAGE_BYTES = 8 * HTB, NXCD = 8, WGM = 8;
__host__ __device__ __forceinline__ int lds_byte(int r, int c) { const int st = (r >> 4) * 2 + (c >> 5), rr = r & 15, cc = c & 31, ob = rr * 64 + cc * 2; return st * 1024 + (ob ^ (((ob >> 9) & 1) << 5)); }
__host__ __device__ __forceinline__ void stage_rc(int b, int& R, int& C) { const int st = b / 1024, sb = b % 1024, swz = sb ^ (((sb >> 9) & 1) << 5); R = (st >> 1) * 16 + swz / 64; C = (st & 1) * 32 + (swz % 64) / 2; }
__host__ __device__ __forceinline__ int g8(int r) { return ((r >> 1) & 1) | (((r >> 3) & 1) << 2); }
__host__ __device__ __forceinline__ int g16(int r) { return (r >> 1) & 7; }
__host__ __device__ __forceinline__ int perm32(int rho) { const int n = rho >> 4, i = rho & 15; return 8 * (i >> 2) + 4 * n + (i & 3); }

struct Unit { int pm, pn; const char* a; const char* b; int e, row0, nrows; };

struct StaticOrder {
    const char* A; const char* Bt; int K;
    int nM, nN, nwg, G, c;
    __device__ void init(const void* A_, const void* Bt_, int M, int N, int K_, int G_, int c_) { A = (const char*)A_; Bt = (const char*)Bt_; K = K_; nM = M / BM; nN = N / BM; nwg = nM * nN; G = G_; c = c_; }
    __device__ bool next(int i, Unit& u) const {
        const long L = (long)i * G + c; if (L >= nwg) return false;
        int wgid = (int)L; { const int q = nwg / NXCD, r = nwg % NXCD, xcd = wgid % NXCD, off = wgid / NXCD; wgid = (xcd < r ? xcd * (q + 1) : r * (q + 1) + (xcd - r) * q) + off; }
        const int nig = WGM * nN, gid = wgid / nig, fm = gid * WGM, gsz = (nM - fm) < WGM ? (nM - fm) : WGM;
        u.pm = fm + ((wgid % nig) % gsz); u.pn = (wgid % nig) / gsz;
        u.a = A + (size_t)u.pm * BM * K * 2; u.b = Bt + (size_t)u.pn * BM * K * 2; u.e = 0; u.row0 = u.pm * BM; u.nrows = BM; return true;
    }
};
struct GroupedOrder {
    const char* A; const char* Bt; int K; int G, c;
    const LAS int* cnt; const LAS int* tstart; const LAS int* sstart;
    __device__ bool next(int i, Unit& u) const {
        const int total = tstart[NEXP] * 4; const long L = (long)i * G + c; if (L >= total) return false;
        int wg = (int)L; { const int q = total / NXCD, r = total % NXCD, xcd = wg % NXCD, off = wg / NXCD; wg = (xcd < r ? xcd * (q + 1) : r * (q + 1) + (xcd - r) * q) + off; }
        const int mtg = wg >> 2; u.pn = wg & 3;
        int e = 0; while (e < NEXP - 1 && tstart[e + 1] <= mtg) ++e;
        u.e = e; u.pm = mtg - tstart[e]; u.row0 = sstart[e] + u.pm * BM; int nr = cnt[e] - u.pm * BM; u.nrows = nr < BM ? nr : BM;
        u.a = A + (size_t)u.row0 * K * 2; u.b = Bt + ((size_t)e * 1024 + (size_t)u.pn * BM) * K * 2; return true;
    }
};

struct ExpertOrder {
    const char* A; const char* Bt; int K; int e, pn, cnt, sstart, u0, nb;
    __device__ bool next(int i, Unit& u) const {
        if (i >= nb) return false;
        const int m = u0 + i;
        u.pm = m; u.pn = pn; u.e = e; u.row0 = sstart + m * BM; const int nr = cnt - m * BM; u.nrows = nr < BM ? nr : BM;
        u.a = A + (size_t)u.row0 * K * 2; u.b = Bt + ((size_t)e * 1024 + (size_t)pn * BM) * K * 2; return true;
    }
};

template <class Epi, class Sched, bool ALIGN_EPI, bool SP2, bool GATHER = false, bool FP8 = false>
__device__ __forceinline__ void gemm_phase(LAS unsigned char* lds, const int K, const Sched& S, const Epi& E, const LAS int* roff = nullptr, const char* gA = nullptr) {
    const int tid = opaque_tid(), wid = __builtin_amdgcn_readfirstlane(tid >> 6), lane = tid & 63, wr = wid >> 2, wc = wid & 3, fr = lane & 15, fq = lane >> 4;
    const int nt = K / BK;
    unsigned voffA[2], voffB[2];
#pragma unroll
    for (int i = 0; i < 2; ++i) { const int R = (tid >> 3) + 64 * i, C = 8 * ((tid & 7) ^ (FP8 ? g8(R) : g16(R)));
        const int Rb = Epi::PERM ? ((R & ~31) + perm32(R & 31)) : R;
        voffA[i] = (unsigned)(R * K + C) * 2u; voffB[i] = (unsigned)(Rb * K + C) * 2u; }
    const size_t kstep = (size_t)(BK * 2);
    const size_t hstep = (size_t)HALF * K * 2;
    unsigned vC[2][2], vN[2][2];
#define PG8_GLOAD(dst, ui_) do { _Pragma("unroll") for (int h_ = 0; h_ < 2; ++h_) _Pragma("unroll") for (int i_ = 0; i_ < 2; ++i_) { const int R_ = (tid >> 3) + 64 * i_, C_ = 8 * ((tid & 7) ^ (FP8 ? g8(R_) : g16(R_))); \
        dst[h_][i_] = (unsigned)roff[(ui_) * BM + h_ * HALF + R_] + (unsigned)(C_ * 2); } } while (0)
    const unsigned ldsw = (unsigned)wid * 1024u;
    const int aoff = (wr * 64 + fr) * 128 + (FP8 ? (((2 * fq) ^ g8(fr)) << 4) : ((fq ^ g16(fr)) << 4));
    const int boff = (wc * 32 + fr) * 128 + (FP8 ? (((2 * fq) ^ g8(fr)) << 4) : ((fq ^ g16(fr)) << 4));
    const int aoff2 = aoff ^ (FP8 ? 16 : 64), boff2 = boff ^ (FP8 ? 16 : 64);
    typedef int v8i_ __attribute__((ext_vector_type(8))); typedef int v4i_ __attribute__((ext_vector_type(4)));
#define PG8_SA(b, h) (((b) * 2 + (h)) * HTB)
#define PG8_SB(b, h) ((4 + (b) * 2 + (h)) * HTB)
#define PG8_STAGE(bufoff, gbase, voff) do { _Pragma("unroll") for (int _i = 0; _i < 2; ++_i) \
        __builtin_amdgcn_global_load_lds((const unsigned*)((const char*)(gbase) + (voff)[_i]), (LAS unsigned*)(lds + (bufoff) + ldsw + _i * 8192), 16, 0, 0); } while (0)
#define PG8_LD8_(p_, q_) __builtin_shufflevector(*(const LAS v4i_*)(p_), *(const LAS v4i_*)(q_), 0, 1, 2, 3, 4, 5, 6, 7)
#define PG8_LDA(dst, b, h) do { if constexpr (FP8) { _Pragma("unroll") for (int m = 0; m < 4; ++m) dst##8[m] = PG8_LD8_(lds + PG8_SA(b, h) + aoff + m * 2048, lds + PG8_SA(b, h) + aoff2 + m * 2048); } \
        else { _Pragma("unroll") for (int m = 0; m < 4; ++m) _Pragma("unroll") for (int k = 0; k < 2; ++k) dst[m][k] = *(const LAS bf16x8*)(lds + PG8_SA(b, h) + (k ? aoff2 : aoff) + m * 2048); } } while (0)
#define PG8_LDB(dst, b, h) do { if constexpr (FP8) { _Pragma("unroll") for (int n = 0; n < 2; ++n) dst##8[n] = PG8_LD8_(lds + PG8_SB(b, h) + boff + n * 2048, lds + PG8_SB(b, h) + boff2 + n * 2048); } \
        else { _Pragma("unroll") for (int n = 0; n < 2; ++n) _Pragma("unroll") for (int k = 0; k < 2; ++k) dst[n][k] = *(const LAS bf16x8*)(lds + PG8_SB(b, h) + (k ? boff2 : boff) + n * 2048); } } while (0)
#define PG8_MMA(ai, bj, At, Bt) do { __builtin_amdgcn_s_setprio(1); _Pragma("unroll") for (int m = 0; m < 4; ++m) _Pragma("unroll") for (int n = 0; n < 2; ++n) { \
        if constexpr (FP8) asm volatile("v_mfma_scale_f32_16x16x128_f8f6f4 %0, %1, %2, %0, %3, %3 op_sel_hi:[0,0,0]" : "+v"(acc[ai][bj][m][n]) : "v"(Bt##8[n]), "v"(At##8[m]), "v"(mxscale)); \
        else { _Pragma("unroll") for (int k = 0; k < 2; ++k) acc[ai][bj][m][n] = __builtin_amdgcn_mfma_f32_16x16x32_bf16(Bt[n][k], At[m][k], acc[ai][bj][m][n], 0, 0, 0); } } \
        __builtin_amdgcn_s_setprio(0); } while (0)
#define PG8_WAIT_V(n) asm volatile("s_waitcnt vmcnt(" #n ")" ::: "memory")
#define PG8_WAIT_L(n) asm volatile("s_waitcnt lgkmcnt(" #n ")" ::: "memory")
#define PG8_BAR __builtin_amdgcn_s_barrier()
#define PG8_SCHED __builtin_amdgcn_sched_barrier(0)
    Unit cur, nxt; int ui = 0;
    if (!S.next(0, cur)) return;
    f32x4 acc[2][2][4][2];
#pragma unroll
    for (int a = 0; a < 2; ++a)
#pragma unroll
        for (int b = 0; b < 2; ++b)
#pragma unroll
            for (int m = 0; m < 4; ++m)
#pragma unroll
                for (int n = 0; n < 2; ++n) acc[a][b][m][n] = (f32x4){0.f, 0.f, 0.f, 0.f};
    const int mxscale = 0x7f7f7f7f;
    bf16x8 At[4][2], B0[2][2], B1[2][2]; v8i_ At8[4], B08[2], B18[2];
    const char* cA = GATHER ? gA : cur.a; const char* cB = cur.b;
    if constexpr (GATHER) { PG8_GLOAD(vC, 0); PG8_WAIT_L(0); }
    if constexpr (SP2) {
        PG8_STAGE(PG8_SB(0, 0), cB, voffB); PG8_STAGE(PG8_SB(0, 1), cB + hstep, voffB);
        if constexpr (GATHER) { PG8_STAGE(PG8_SA(0, 0), cA, vC[0]); PG8_STAGE(PG8_SA(0, 1), cA, vC[1]); } else { PG8_STAGE(PG8_SA(0, 0), cA, voffA); PG8_STAGE(PG8_SA(0, 1), cA + hstep, voffA); }
        if (wr == 1) PG8_BAR;
        PG8_WAIT_V(2); PG8_BAR;
        PG8_STAGE(PG8_SB(1, 0), cB + kstep, voffB); if constexpr (GATHER) PG8_STAGE(PG8_SA(1, 0), cA + kstep, vC[0]); else PG8_STAGE(PG8_SA(1, 0), cA + kstep, voffA); PG8_STAGE(PG8_SB(1, 1), cB + hstep + kstep, voffB);
        PG8_WAIT_V(6); PG8_BAR;
    } else {
        PG8_STAGE(PG8_SB(0, 0), cB, voffB); PG8_STAGE(PG8_SA(0, 0), cA, voffA); PG8_STAGE(PG8_SB(0, 1), cB + hstep, voffB); PG8_STAGE(PG8_SA(0, 1), cA + hstep, voffA);
        if (wr == 1) PG8_BAR;
        PG8_WAIT_V(4); PG8_BAR;
        PG8_STAGE(PG8_SB(1, 0), cB + kstep, voffB); PG8_STAGE(PG8_SA(1, 0), cA + kstep, voffA); PG8_STAGE(PG8_SB(1, 1), cB + hstep + kstep, voffB);
        PG8_WAIT_V(6); PG8_BAR;
    }
    for (;;) {
        const bool has_next = S.next(ui + 1, nxt);
        const char* nA = GATHER ? cA : (has_next ? nxt.a : cA); const char* nB = has_next ? nxt.b : cB;
        if constexpr (GATHER) { if (has_next) { PG8_GLOAD(vN, ui + 1); } else { vN[0][0] = vC[0][0]; vN[0][1] = vC[0][1]; vN[1][0] = vC[1][0]; vN[1][1] = vC[1][1]; } }
#pragma unroll 1
        for (int t = 0; t < nt; t += 2) {
            const bool last = (t == nt - 2);
            const char* a1 = cA + (size_t)(t + 1) * kstep;
            const char* a2 = last ? nA : cA + (size_t)(t + 2) * kstep; const char* b2 = last ? nB : cB + (size_t)(t + 2) * kstep;
            const char* a3 = a2 + kstep; const char* b3 = b2 + kstep;
            if constexpr (Epi::MID_T >= 0) { if (t == Epi::MID_T) E.mid(acc, cur, wr, wc, fr, fq); }
            if constexpr (SP2) {
            if constexpr (GATHER) {
            unsigned g0[2] = {last ? vN[0][0] : vC[0][0], last ? vN[0][1] : vC[0][1]}, g1[2] = {last ? vN[1][0] : vC[1][0], last ? vN[1][1] : vC[1][1]};
            PG8_LDB(B0, 0, 0); PG8_LDB(B1, 0, 1); PG8_SCHED; PG8_LDA(At, 0, 0); PG8_STAGE(PG8_SA(1, 1), a1, vC[1]);
            PG8_WAIT_V(8); PG8_WAIT_L(0); PG8_BAR; PG8_MMA(0, 0, At, B0); PG8_MMA(0, 1, At, B1); PG8_BAR; PG8_SCHED;
            PG8_LDA(At, 0, 1); PG8_STAGE(PG8_SB(0, 0), b2, voffB); PG8_STAGE(PG8_SB(0, 1), b2 + hstep, voffB); PG8_STAGE(PG8_SA(0, 0), a2, g0);
            PG8_WAIT_V(8); PG8_WAIT_L(0); PG8_BAR; PG8_MMA(1, 0, At, B0); PG8_MMA(1, 1, At, B1); PG8_BAR; PG8_SCHED;
            PG8_LDB(B0, 1, 0); PG8_LDB(B1, 1, 1); PG8_SCHED; PG8_LDA(At, 1, 0); PG8_STAGE(PG8_SA(0, 1), a2, g1);
            PG8_WAIT_V(8); PG8_WAIT_L(0); PG8_BAR; PG8_MMA(0, 0, At, B0); PG8_MMA(0, 1, At, B1); PG8_BAR; PG8_SCHED;
            PG8_LDA(At, 1, 1); PG8_STAGE(PG8_SB(1, 0), b3, voffB); PG8_STAGE(PG8_SB(1, 1), b3 + hstep, voffB); PG8_STAGE(PG8_SA(1, 0), a3, g0);
            PG8_WAIT_V(8); PG8_WAIT_L(0); PG8_BAR; PG8_MMA(1, 0, At, B0); PG8_MMA(1, 1, At, B1); PG8_BAR; PG8_SCHED;
            } else {
            PG8_LDB(B0, 0, 0); PG8_LDB(B1, 0, 1); PG8_SCHED; PG8_LDA(At, 0, 0); PG8_STAGE(PG8_SA(1, 1), a1 + hstep, voffA);
            PG8_WAIT_V(8); PG8_WAIT_L(0); PG8_BAR; PG8_MMA(0, 0, At, B0); PG8_MMA(0, 1, At, B1); PG8_BAR; PG8_SCHED;
            PG8_LDA(At, 0, 1); PG8_STAGE(PG8_SB(0, 0), b2, voffB); PG8_STAGE(PG8_SB(0, 1), b2 + hstep, voffB); PG8_STAGE(PG8_SA(0, 0), a2, voffA);
            PG8_WAIT_V(8); PG8_WAIT_L(0); PG8_BAR; PG8_MMA(1, 0, At, B0); PG8_MMA(1, 1, At, B1); PG8_BAR; PG8_SCHED;
            PG8_LDB(B0, 1, 0); PG8_LDB(B1, 1, 1); PG8_SCHED; PG8_LDA(At, 1, 0); PG8_STAGE(PG8_SA(0, 1), a2 + hstep, voffA);
            PG8_WAIT_V(8); PG8_WAIT_L(0); PG8_BAR; PG8_MMA(0, 0, At, B0); PG8_MMA(0, 1, At, B1); PG8_BAR; PG8_SCHED;
            PG8_LDA(At, 1, 1); PG8_STAGE(PG8_SB(1, 0), b3, voffB); PG8_STAGE(PG8_SB(1, 1), b3 + hstep, voffB); PG8_STAGE(PG8_SA(1, 0), a3, voffA);
            PG8_WAIT_V(8); PG8_WAIT_L(0); PG8_BAR; PG8_MMA(1, 0, At, B0); PG8_MMA(1, 1, At, B1); PG8_BAR; PG8_SCHED;
            }
            } else {
            PG8_LDB(B0, 0, 0); PG8_SCHED; PG8_LDA(At, 0, 0); PG8_STAGE(PG8_SA(1, 1), a1 + hstep, voffA);
            PG8_WAIT_L(8); PG8_BAR; PG8_WAIT_L(0); PG8_MMA(0, 0, At, B0); PG8_BAR; PG8_SCHED;
            PG8_LDB(B1, 0, 1); PG8_STAGE(PG8_SB(0, 0), b2, voffB);
            PG8_BAR; PG8_WAIT_L(0); PG8_MMA(0, 1, At, B1); PG8_BAR;
            PG8_LDA(At, 0, 1); PG8_STAGE(PG8_SA(0, 0), a2, voffA);
            PG8_BAR; PG8_WAIT_L(0); PG8_MMA(1, 0, At, B0); PG8_BAR; PG8_SCHED;
            PG8_STAGE(PG8_SB(0, 1), b2 + hstep, voffB);
            PG8_WAIT_V(6); PG8_BAR; PG8_MMA(1, 1, At, B1); PG8_BAR;
            PG8_LDB(B0, 1, 0); PG8_SCHED; PG8_LDA(At, 1, 0); PG8_STAGE(PG8_SA(0, 1), a2 + hstep, voffA);
            PG8_WAIT_L(8); PG8_BAR; PG8_WAIT_L(0); PG8_MMA(0, 0, At, B0); PG8_BAR; PG8_SCHED;
            PG8_LDB(B1, 1, 1); PG8_STAGE(PG8_SB(1, 0), b3, voffB);
            PG8_BAR; PG8_WAIT_L(0); PG8_MMA(0, 1, At, B1); PG8_BAR;
            PG8_LDA(At, 1, 1); PG8_STAGE(PG8_SA(1, 0), a3, voffA);
            PG8_BAR; PG8_WAIT_L(0); PG8_MMA(1, 0, At, B0); PG8_BAR; PG8_SCHED;
            PG8_STAGE(PG8_SB(1, 1), b3 + hstep, voffB);
            PG8_WAIT_V(6); PG8_BAR; PG8_MMA(1, 1, At, B1); PG8_BAR;
            }
        }
        if constexpr (ALIGN_EPI) { if (wr == 0) PG8_BAR; }
        if constexpr (FP8) asm volatile("s_nop 15\n\ts_nop 15" ::: "memory");
        E(acc, cur, wr, wc, fr, fq);
        if (!has_next) break;
#pragma unroll
        for (int a = 0; a < 2; ++a)
#pragma unroll
            for (int b = 0; b < 2; ++b)
#pragma unroll
                for (int m = 0; m < 4; ++m)
#pragma unroll
                    for (int n = 0; n < 2; ++n) acc[a][b][m][n] = (f32x4){0.f, 0.f, 0.f, 0.f};
        cur = nxt; cA = nA; cB = nB; ++ui;
        if constexpr (GATHER) { vC[0][0] = vN[0][0]; vC[0][1] = vN[0][1]; vC[1][0] = vN[1][0]; vC[1][1] = vN[1][1]; }
        if constexpr (ALIGN_EPI) { if (wr == 1) PG8_BAR; }
    }
    PG8_WAIT_V(0);
    if constexpr (!ALIGN_EPI) { if (wr == 0) PG8_BAR; }
    PG8_BAR;
#undef PG8_GLOAD
#undef PG8_SA
#undef PG8_SB
#undef PG8_STAGE
#undef PG8_LDA
#undef PG8_LD8_
#undef PG8_LDB
#undef PG8_MMA
#undef PG8_WAIT_V
#undef PG8_WAIT_L
#undef PG8_BAR
#undef PG8_SCHED
}
}

struct RotF { float f[4]; };
__device__ __forceinline__ RotF rot_freqs(int q) { RotF r;
#pragma unroll
    for (int i = 0; i < 4; ++i) r.f[i] = fast_exp2(-(float)(2 * (4 * q + i)) * (13.287712379549449f / 64.f)) * 0.15915494309189535f;
    return r; }
__device__ __forceinline__ void rot_cs(const RotF& rf, int pos, f32x4& c4, f32x4& s4) {
    const float p = (float)pos;
#pragma unroll
    for (int i = 0; i < 4; ++i) { const float r = __builtin_amdgcn_fractf(p * rf.f[i]); c4[i] = __builtin_amdgcn_cosf(r); s4[i] = __builtin_amdgcn_sinf(r); }
}

typedef f32x4 acc_t[2][2][4][2];

struct EpiProj {
    static constexpr bool PERM = true; static constexpr int MID_T = -1;
    unsigned char* ws; bf16_t* gate; const float* bias; int pn_off; float descale;
    __device__ __forceinline__ void operator()(const acc_t& acc, const pg8::Unit& u, int wr, int wc, int fr, int fq) const {
        asm volatile("" : "+v"(fr), "+v"(fq));
        const int pn = u.pn + pn_off;
        const int row0 = u.pm * 256 + wr * 64 + fr;
        int mode, ld, colt; bf16_t* base; float sc = descale;
        if (pn < 6) { mode = 0; base = (bf16_t*)(ws + WS_QA); ld = 1536; colt = pn * 256; sc = QA_SCALE * descale; }
        else if (pn < 12) { mode = 0; base = (bf16_t*)(ws + WS_KA); ld = 1536; colt = (pn - 6) * 256; }
        else if (pn < 18) { mode = 1; base = (bf16_t*)(ws + WS_VA); ld = 1536; colt = (pn - 12) * 256; }
        else if (pn < 20) { mode = 0; base = (bf16_t*)(ws + WS_QR); ld = 512; colt = (pn - 18) * 256; }
        else if (pn < 22) { mode = 0; base = (bf16_t*)(ws + WS_KR); ld = 512; colt = (pn - 20) * 256; sc = 0.125f * descale; }
        else if (pn < 26) { mode = 1; base = (bf16_t*)(ws + WS_VR); ld = 1024; colt = (pn - 22) * 256; }
        else if (pn < 30) { mode = 2; base = (bf16_t*)(ws + WS_GR); ld = 1024; colt = (pn - 26) * 256; }
        else { mode = 3; base = (bf16_t*)(ws + WS_GATE); ld = 2048; colt = (pn - 30) * 256; }
        if (mode == 0) {
            const int q = 4 * (wc & 1) + fq; const RotF rf = rot_freqs(q);
#pragma unroll
            for (int ai = 0; ai < 2; ++ai)
#pragma unroll
                for (int m = 0; m < 4; ++m) {
                    const int row = row0 + ai * 128 + m * 16; const int pos = row & (SEQ - 1);
                    f32x4 c4, s4; rot_cs(rf, pos, c4, s4);
#pragma unroll
                    for (int bj = 0; bj < 2; ++bj) {
                        const f32x4 t1 = acc[ai][bj][m][0], t2 = acc[ai][bj][m][1];
                        const f32x4 o1 = (t1 * c4 - t2 * s4) * sc, o2 = (t1 * s4 + t2 * c4) * sc;
                        bf16_t* p = base + (size_t)row * ld + colt + 128 * bj + 64 * (wc >> 1) + 8 * q;
                        u32x4 w; w.x = cvt_pk_bf16(o1[0], o1[1]); w.y = cvt_pk_bf16(o1[2], o1[3]); w.z = cvt_pk_bf16(o2[0], o2[1]); w.w = cvt_pk_bf16(o2[2], o2[3]);
                        *(u32x4*)p = w;
                    }
                }
        } else {
            const int col0 = colt + wc * 32 + 8 * fq;
            if (mode == 1) {
#pragma unroll
                for (int ai = 0; ai < 2; ++ai)
#pragma unroll
                    for (int m = 0; m < 4; ++m) {
                        bf16_t* rowp = base + (size_t)(row0 + ai * 128 + m * 16) * ld + col0;
#pragma unroll
                        for (int bj = 0; bj < 2; ++bj) { const f32x4 v0 = acc[ai][bj][m][0] * sc, v1 = acc[ai][bj][m][1] * sc;
                            u32x4 w; w.x = cvt_pk_bf16(v0[0], v0[1]); w.y = cvt_pk_bf16(v0[2], v0[3]); w.z = cvt_pk_bf16(v1[0], v1[1]); w.w = cvt_pk_bf16(v1[2], v1[3]);
                            *(u32x4*)(rowp + bj * 128) = w; }
                    }
            } else if (mode == 2) {
                const float ks = -sc * LOG2E;
#pragma unroll
                for (int ai = 0; ai < 2; ++ai)
#pragma unroll
                    for (int m = 0; m < 4; ++m) {
                        bf16_t* rowp = base + (size_t)(row0 + ai * 128 + m * 16) * ld + col0;
#pragma unroll
                        for (int bj = 0; bj < 2; ++bj) {
                            const f32x4 a0 = acc[ai][bj][m][0], a1 = acc[ai][bj][m][1];
                            f32x4 e0 = a0 * ks, e1 = a1 * ks;
#pragma unroll
                            for (int i = 0; i < 4; ++i) { e0[i] = fast_exp2(e0[i]); e1[i] = fast_exp2(e1[i]); }
                            e0 = e0 + 1.f; e1 = e1 + 1.f;
#pragma unroll
                            for (int i = 0; i < 4; ++i) { e0[i] = fast_rcp(e0[i]); e1[i] = fast_rcp(e1[i]); }
                            const f32x4 v0 = (a0 * sc) * e0, v1 = (a1 * sc) * e1;
                            u32x4 w; w.x = cvt_pk_bf16(v0[0], v0[1]); w.y = cvt_pk_bf16(v0[2], v0[3]); w.z = cvt_pk_bf16(v1[0], v1[1]); w.w = cvt_pk_bf16(v1[2], v1[3]);
                            *(u32x4*)(rowp + bj * 128) = w; }
                    }
            } else {
                const float ks = -sc * LOG2E;
                f32x4 nb[2][2];
#pragma unroll
                for (int bj = 0; bj < 2; ++bj)
#pragma unroll
                    for (int n = 0; n < 2; ++n) nb[bj][n] = *(const f32x4*)(bias + col0 + bj * 128 + 4 * n) * (-LOG2E);
#pragma unroll
                for (int ai = 0; ai < 2; ++ai)
#pragma unroll
                    for (int m = 0; m < 4; ++m) {
                        bf16_t* rowp = base + (size_t)(row0 + ai * 128 + m * 16) * ld + col0;
#pragma unroll
                        for (int bj = 0; bj < 2; ++bj) {
                            f32x4 e0 = acc[ai][bj][m][0] * ks + nb[bj][0], e1 = acc[ai][bj][m][1] * ks + nb[bj][1];
#pragma unroll
                            for (int i = 0; i < 4; ++i) { e0[i] = fast_exp2(e0[i]); e1[i] = fast_exp2(e1[i]); }
                            e0 = e0 + 1.f; e1 = e1 + 1.f;
#pragma unroll
                            for (int i = 0; i < 4; ++i) { e0[i] = fast_rcp(e0[i]); e1[i] = fast_rcp(e1[i]); }
                            u32x4 w; w.x = cvt_pk_bf16(e0[0], e0[1]); w.y = cvt_pk_bf16(e0[2], e0[3]); w.z = cvt_pk_bf16(e1[0], e1[1]); w.w = cvt_pk_bf16(e1[2], e1[3]);
                            *(u32x4*)(rowp + bj * 128) = w; }
                    }
            }
        }
    }
};

struct EpiProjAtt {
    static constexpr bool PERM = true; static constexpr int MID_T = -1;
    unsigned char* ws; float descale;
    __device__ __forceinline__ void operator()(const acc_t& acc, const pg8::Unit& u, int wr, int wc, int, int) const {
        const int lane_ = opaque_tid() & 63, fr = lane_ & 15, fq = lane_ >> 4;
        const int pn = u.pn, row0 = u.pm * 256 + wr * 64 + fr;
        bf16_t* base = (bf16_t*)(ws + (pn < 6 ? WS_QA : (pn < 12 ? WS_KA : WS_VA))); const int pt = (pn < 6 ? pn : (pn < 12 ? pn - 6 : pn - 12));
        const float sc = (pn < 6 ? QA_SCALE : 1.f) * descale;
        const int grp = pt >> 1;
        if (pn < 12) {
            const int q = 4 * (wc & 1) + fq; const RotF rf = rot_freqs(q);
#pragma unroll
            for (int ai = 0; ai < 2; ++ai)
#pragma unroll
                for (int m = 0; m < 4; ++m) {
                    const int row = row0 + ai * 128 + m * 16; const int pos = row & (SEQ - 1), b = row >> 11;
                    f32x4 c4, s4; rot_cs(rf, pos, c4, s4);
#pragma unroll
                    for (int bj = 0; bj < 2; ++bj) {
                        const f32x4 t1 = acc[ai][bj][m][0], t2 = acc[ai][bj][m][1];
                        const f32x4 o1 = (t1 * c4 - t2 * s4) * sc, o2 = (t1 * s4 + t2 * c4) * sc;
                        const int hd = 4 * (pt & 1) + 2 * bj + (wc >> 1);
                        bf16_t* p = base + ((size_t)((b * 3 + grp) * 8 + hd) * SEQ + pos) * 64 + 8 * q;
                        u32x4 w; w.x = cvt_pk_bf16(o1[0], o1[1]); w.y = cvt_pk_bf16(o1[2], o1[3]); w.z = cvt_pk_bf16(o2[0], o2[1]); w.w = cvt_pk_bf16(o2[2], o2[3]);
                        *(u32x4*)p = w;
                    }
                }
        } else {
#pragma unroll
            for (int ai = 0; ai < 2; ++ai)
#pragma unroll
                for (int m = 0; m < 4; ++m) {
                    const int row = row0 + ai * 128 + m * 16; const int pos = row & (SEQ - 1), b = row >> 11;
#pragma unroll
                    for (int bj = 0; bj < 2; ++bj) {
                        const f32x4 v0 = acc[ai][bj][m][0] * sc, v1 = acc[ai][bj][m][1] * sc;
                        const int hd = 4 * (pt & 1) + 2 * bj + (wc >> 1);
                        bf16_t* p = base + ((size_t)((b * 3 + grp) * 8 + hd) * SEQ + pos) * 64 + 32 * (wc & 1) + 8 * fq;
                        u32x4 w; w.x = cvt_pk_bf16(v0[0], v0[1]); w.y = cvt_pk_bf16(v0[2], v0[3]); w.z = cvt_pk_bf16(v1[0], v1[1]); w.w = cvt_pk_bf16(v1[2], v1[3]);
                        *(u32x4*)p = w;
                    }
                }
        }
    }
};
struct EpiMerge {
    static constexpr bool PERM = true; static constexpr int MID_T = 8;
    bf16_t* out; const bf16_t* gate;
    __device__ __forceinline__ void mid(acc_t& acc, const pg8::Unit& u, int wr, int wc, int fr, int fq) const {
        int row0 = u.pm * 256 + wr * 64 + fr, col0 = u.pn * 256 + wc * 32 + 8 * fq;
        asm volatile("" : "+v"(row0), "+v"(col0));
#pragma unroll
        for (int ai = 0; ai < 2; ++ai) {
            u32x4 ga[4][2], gb[4][2];
#pragma unroll
            for (int m = 0; m < 4; ++m)
#pragma unroll
                for (int bj = 0; bj < 2; ++bj) { const bf16_t* gp = gate + (size_t)(row0 + ai * 128 + m * 16) * 2048 + col0 + bj * 128; ga[m][bj] = *(const u32x4*)gp; gb[m][bj] = *(const u32x4*)(gp + 1024); }
            asm volatile("" ::: "memory");
#pragma unroll
            for (int m = 0; m < 4; ++m)
#pragma unroll
                for (int bj = 0; bj < 2; ++bj) { const u32x4 a = ga[m][bj], b = gb[m][bj];
                    acc[ai][bj][m][0][0] *= bf_lo(a.x) * fast_rcp(bf_lo(b.x)); acc[ai][bj][m][0][1] *= bf_hi(a.x) * fast_rcp(bf_hi(b.x));
                    acc[ai][bj][m][0][2] *= bf_lo(a.y) * fast_rcp(bf_lo(b.y)); acc[ai][bj][m][0][3] *= bf_hi(a.y) * fast_rcp(bf_hi(b.y));
                    acc[ai][bj][m][1][0] *= bf_lo(a.z) * fast_rcp(bf_lo(b.z)); acc[ai][bj][m][1][1] *= bf_hi(a.z) * fast_rcp(bf_hi(b.z));
                    acc[ai][bj][m][1][2] *= bf_lo(a.w) * fast_rcp(bf_lo(b.w)); acc[ai][bj][m][1][3] *= bf_hi(a.w) * fast_rcp(bf_hi(b.w)); }
            asm volatile("" ::: "memory");
        }
    }
    __device__ __forceinline__ void operator()(const acc_t& acc, const pg8::Unit& u, int wr, int wc, int fr, int fq) const {
        const int row0 = u.pm * 256 + wr * 64 + fr, col0 = u.pn * 256 + wc * 32 + 8 * fq;
        u32x4 g[2][4][2];
#pragma unroll
        for (int ai = 0; ai < 2; ++ai)
#pragma unroll
            for (int m = 0; m < 4; ++m)
#pragma unroll
                for (int bj = 0; bj < 2; ++bj) g[ai][m][bj] = *(const u32x4*)(gate + (size_t)(row0 + ai * 128 + m * 16) * 2048 + 1024 + col0 + bj * 128);
        asm volatile("" ::: "memory");
#pragma unroll
        for (int ai = 0; ai < 2; ++ai)
#pragma unroll
            for (int m = 0; m < 4; ++m) {
                const size_t row = (size_t)(row0 + ai * 128 + m * 16);
#pragma unroll
                for (int bj = 0; bj < 2; ++bj) {
                    const u32x4 gg = g[ai][m][bj];
                    f32x4 v0 = acc[ai][bj][m][0], v1 = acc[ai][bj][m][1];
                    v0[0] *= bf_lo(gg.x); v0[1] *= bf_hi(gg.x); v0[2] *= bf_lo(gg.y); v0[3] *= bf_hi(gg.y);
                    v1[0] *= bf_lo(gg.z); v1[1] *= bf_hi(gg.z); v1[2] *= bf_lo(gg.w); v1[3] *= bf_hi(gg.w);
                    u32x4 w; w.x = cvt_pk_bf16(v0[0], v0[1]); w.y = cvt_pk_bf16(v0[2], v0[3]); w.z = cvt_pk_bf16(v1[0], v1[1]); w.w = cvt_pk_bf16(v1[2], v1[3]);
                    *(u32x4*)(out + row * 1024 + col0 + bj * 128) = w;
                }
            }
    }
};
struct EpiPlain {
    static constexpr bool PERM = true; static constexpr int MID_T = -1;
    bf16_t* O;
    __device__ __forceinline__ void operator()(const acc_t& acc, const pg8::Unit& u, int wr, int wc, int fr, int fq) const {
        const int row0 = u.pm * 256 + wr * 64 + fr, col0 = u.pn * 256 + wc * 32 + 8 * fq;
#pragma unroll
        for (int ai = 0; ai < 2; ++ai)
#pragma unroll
            for (int m = 0; m < 4; ++m) {
                bf16_t* rowp = O + (size_t)(row0 + ai * 128 + m * 16) * 1024 + col0;
#pragma unroll
                for (int bj = 0; bj < 2; ++bj) { const f32x4 v0 = acc[ai][bj][m][0], v1 = acc[ai][bj][m][1];
                    u32x4 w; w.x = cvt_pk_bf16(v0[0], v0[1]); w.y = cvt_pk_bf16(v0[2], v0[3]); w.z = cvt_pk_bf16(v1[0], v1[1]); w.w = cvt_pk_bf16(v1[2], v1[3]);
                    *(u32x4*)(rowp + bj * 128) = w; }
            }
    }
};
struct EpiSwiglu {
    static constexpr bool PERM = true; static constexpr int MID_T = -1;
    unsigned char* hid; const LAS float* rs_tab; int u0;
    __device__ __forceinline__ void operator()(const acc_t& acc, const pg8::Unit& u, int wr, int wc, int, int) const {
        const int lane_ = opaque_tid() & 63, fr = lane_ & 15, fq = lane_ >> 4;
        const int col0 = u.pn * 128 + wc * 32 + 8 * fq;
#pragma unroll
        for (int ai = 0; ai < 2; ++ai)
#pragma unroll
            for (int m = 0; m < 4; ++m) {
                const int rl = ai * 128 + wr * 64 + m * 16 + fr;
                const float rs = rs_tab[(u.pm - u0) * 256 + rl];
                f32x4 v0, v1;
#pragma unroll
                for (int i = 0; i < 4; ++i) { const float a0 = acc[ai][0][m][0][i] * rs, a1 = acc[ai][0][m][1][i] * rs;
                    v0[i] = a0 * sigmoidf_(a0) * (acc[ai][1][m][0][i] * rs); v1[i] = a1 * sigmoidf_(a1) * (acc[ai][1][m][1][i] * rs); }
                u32x2 w; w.x = pk_fp8x4(v0[0], v0[1], v0[2], v0[3]); w.y = pk_fp8x4(v1[0], v1[1], v1[2], v1[3]);
                if (rl < u.nrows) *(u32x2*)(hid + (size_t)(u.row0 + rl) * 512 + col0) = w;
            }
    }
};
struct EpiDown {
    static constexpr bool PERM = true; static constexpr int MID_T = -1;
    bf16_t* Y; float descale;
    __device__ __forceinline__ void operator()(const acc_t& acc, const pg8::Unit& u, int wr, int wc, int fr, int fq) const {
        const int col0 = u.pn * 256 + wc * 32 + 8 * fq;
#pragma unroll
        for (int ai = 0; ai < 2; ++ai)
#pragma unroll
            for (int m = 0; m < 4; ++m) {
                const int rl = ai * 128 + wr * 64 + m * 16 + fr;
#pragma unroll
                for (int bj = 0; bj < 2; ++bj) {
                    const f32x4 v0 = acc[ai][bj][m][0] * descale, v1 = acc[ai][bj][m][1] * descale;
                    u32x4 w; w.x = cvt_pk_bf16(v0[0], v0[1]); w.y = cvt_pk_bf16(v0[2], v0[3]); w.z = cvt_pk_bf16(v1[0], v1[1]); w.w = cvt_pk_bf16(v1[2], v1[3]);
                    if (rl < u.nrows) *(u32x4*)(Y + (size_t)(u.row0 + rl) * 1024 + col0 + bj * 128) = w;
                }
            }
    }
};

struct Args {
    const float* x; const float* norm_mix_w; const float* w_in; const float* b_gate; const float* dec_f; const float* dec_b; const float* gn_w;
    const float* w_a; const float* w_b; const float* w_o; const float* norm_moe_w; const float* wg; const float* bg; const float* we; const float* be;
    const float* w1; const float* w3; const float* w2; const float* norm_final_w;
    float* out; unsigned char* ws;
};

template <int MAP>
__device__ __forceinline__ void transpose_item(const float* W, int K, int N, bf16_t* WT, int row_off, LAS float* scr, int item, int lane, const float* kscale) {
    const int nblk = N / 32, kb = item / nblk, nb = item % nblk, k0 = 64 * kb, n0 = 32 * nb;
#pragma unroll 8
    for (int i = 0; i < 32; ++i) { const int kk = 2 * i + (lane >> 5); float v = W[(size_t)(k0 + kk) * N + n0 + (lane & 31)]; if (kscale) v *= kscale[k0 + kk]; scr[kk * 33 + (lane & 31)] = v; }
    LDS_WAIT(); asm volatile("" ::: "memory");
    const int c = lane & 7;
#pragma unroll
    for (int j = 0; j < 4; ++j) { const int n = (lane >> 3) + 8 * j; const LAS float* s = scr + (8 * c) * 33 + n;
        u32x4 o; o.x = cvt_pk_bf16(s[0 * 33], s[1 * 33]); o.y = cvt_pk_bf16(s[2 * 33], s[3 * 33]); o.z = cvt_pk_bf16(s[4 * 33], s[5 * 33]); o.w = cvt_pk_bf16(s[6 * 33], s[7 * 33]);
        const int lc = n0 + n; int dr;
        if (MAP == 0) dr = row_off + lc;
        else if (MAP == 1) dr = row_off + (lc & ~63) + 8 * ((lc & 31) >> 2) + 4 * ((lc >> 5) & 1) + (lc & 3);
        else dr = (lc >> 7) * 256 + row_off + (lc & 127);
        *(u32x4*)(WT + (size_t)dr * K + k0 + 8 * c) = o; }
    LDS_WAIT(); asm volatile("" ::: "memory");
}

template <int MAP, bool NT>
__device__ __forceinline__ void transpose_tile64(const float* W, int K, int N, bf16_t* WT, int row_off, LAS unsigned* T, int item, int lane, int ldw = 0, int koff = 0) {
    if (ldw == 0) ldw = K;
    const int kblk = K / 64, nb = item / kblk, kb = item % kblk, k0 = 64 * kb, n0 = 64 * nb;
    const int kp = lane >> 4, n4 = lane & 15;
    f32x4 ra[8], rb[8];
    const float* src = W + (size_t)(k0 + 2 * kp) * N + n0 + 4 * n4;
#pragma unroll
    for (int i = 0; i < 8; ++i) {
        const f32x4* pa = (const f32x4*)(src + (size_t)(8 * i) * N); const f32x4* pb = (const f32x4*)(src + (size_t)(8 * i + 1) * N);
        if (NT) { ra[i] = __builtin_nontemporal_load(pa); rb[i] = __builtin_nontemporal_load(pb); } else { ra[i] = *pa; rb[i] = *pb; }
    }
#pragma unroll
    for (int i = 0; i < 8; ++i)
#pragma unroll
        for (int c = 0; c < 4; ++c) { const int n = 4 * n4 + c, kpair = 4 * i + kp; T[n * 32 + (kpair ^ (((n >> 2) & 7) << 2))] = cvt_pk_bf16(ra[i][c], rb[i][c]); }
#pragma unroll
    for (int j = 0; j < 8; ++j) {
        const int row = 8 * j + (lane >> 3), chunk = lane & 7;
        const u32x4 v = *(const LAS u32x4*)(T + row * 32 + 4 * (chunk ^ ((row >> 2) & 7)));
        const int lc = n0 + row; int dr;
        if (MAP == 0) dr = row_off + lc;
        else if (MAP == 1) dr = row_off + (lc & ~63) + 8 * ((lc & 31) >> 2) + 4 * ((lc >> 5) & 1) + (lc & 3);
        else dr = (lc >> 7) * 256 + row_off + (lc & 127);
        *(u32x4*)(WT + (size_t)dr * ldw + koff + k0 + 8 * chunk) = v;
    }
}

template <int MAP, bool NT>
__device__ __forceinline__ void transpose_tile_fp8(const float* W, int K, int N, unsigned char* WT, int row_off, LAS unsigned* T, int item, int lane, float scale) {
    const int kblk = K / 128, nb = item / kblk, kb = item % kblk, k0 = 128 * kb, n0 = 64 * nb;
    const int kp = lane >> 4, n4 = lane & 15;
#pragma unroll
    for (int hh = 0; hh < 2; ++hh) {
        f32x4 r[4][4];
        const float* src = W + (size_t)(k0 + 64 * hh + 4 * kp) * N + n0 + 4 * n4;
#pragma unroll
        for (int i = 0; i < 4; ++i)
#pragma unroll
            for (int q = 0; q < 4; ++q) { const f32x4* p = (const f32x4*)(src + (size_t)(16 * i + q) * N); if (NT) r[i][q] = __builtin_nontemporal_load(p); else r[i][q] = *p; }
#pragma unroll
        for (int i = 0; i < 4; ++i)
#pragma unroll
            for (int c = 0; c < 4; ++c) { const int n = 4 * n4 + c, kq = 16 * hh + 4 * i + kp;
                T[n * 32 + (kq ^ (((n >> 2) & 7) << 2))] = pk_fp8x4(r[i][0][c] * scale, r[i][1][c] * scale, r[i][2][c] * scale, r[i][3][c] * scale); }
    }
#pragma unroll
    for (int j = 0; j < 8; ++j) {
        const int row = 8 * j + (lane >> 3), chunk = lane & 7;
        const u32x4 v = *(const LAS u32x4*)(T + row * 32 + 4 * (chunk ^ ((row >> 2) & 7)));
        const int lc = n0 + row; int dr;
        if (MAP == 0) dr = row_off + lc;
        else if (MAP == 1) dr = row_off + (lc & ~63) + 8 * ((lc & 31) >> 2) + 4 * ((lc >> 5) & 1) + (lc & 3);
        else dr = (lc >> 7) * 256 + row_off + (lc & 127);
        *(u32x4*)(WT + (size_t)dr * K + k0 + 16 * chunk) = v;
    }
}

__device__ __forceinline__ void rms_row_to_bf16(const float* xrow, const float* w, bf16_t* orow, int lane) {
    const f32x4* xr = (const f32x4*)xrow + lane; const f32x4* wr_ = (const f32x4*)w + lane;
    f32x4 v[4]; float s = 0.f;
#pragma unroll
    for (int j = 0; j < 4; ++j) { v[j] = xr[64 * j]; s += (v[j].x * v[j].x + v[j].y * v[j].y) + (v[j].z * v[j].z + v[j].w * v[j].w); }
    const float rstd = 1.f / sqrtf(wave_sum(s) * (1.f / DM) + NORM_EPS);
    u32x2* o8 = (u32x2*)orow + lane;
#pragma unroll
    for (int j = 0; j < 4; ++j) { const f32x4 ww = wr_[64 * j]; u32x2 o; o.x = cvt_pk_bf16(v[j].x * rstd * ww.x, v[j].y * rstd * ww.y); o.y = cvt_pk_bf16(v[j].z * rstd * ww.z, v[j].w * rstd * ww.w); o8[64 * j] = o; }
}

__device__ __forceinline__ float log_sigmoid(float x) { return x >= 0.f ? -log1pf(expf(-x)) : x - log1pf(expf(x)); }


#define XB_TMO      128
#define XB_XCNT(j)  (256  + 64 * (j))
#define XB_XSUB(j)  (1280 + 64 * (j))
#define XB_XGEN(j)  (2304 + 64 * (j))
#define XB_TOP      3328
#define XB_TOPGEN   3392
#define XCD_BAR_WORDS 3456
#define XB_SPIN_CAP (1u << 18)
__device__ __forceinline__ unsigned xb_ld(unsigned* p)              { return __hip_atomic_load(p, __ATOMIC_RELAXED, __HIP_MEMORY_SCOPE_AGENT); }
__device__ __forceinline__ unsigned xb_add(unsigned* p, unsigned v) { return __hip_atomic_fetch_add(p, v, __ATOMIC_RELAXED, __HIP_MEMORY_SCOPE_AGENT); }
__device__ __forceinline__ unsigned xb_xcc_id() { return (unsigned)__builtin_amdgcn_s_getreg((3 << 11) | 20) & 0xFu; }
#define XB_SPIN(cond, bar) do { unsigned _sp = 0; while (cond) { __builtin_amdgcn_s_sleep(1); \
    if ((++_sp & 255u) == 0u) { if (xb_ld(&(bar)[XB_TMO])) break; if (_sp > XB_SPIN_CAP) { atomicAdd(&(bar)[XB_TMO], 1u); break; } } } } while (0)
struct XcdBarrier { unsigned* bar; unsigned x; volatile LAS unsigned* st; };
__device__ __forceinline__ XcdBarrier xcd_barrier_post(unsigned* bar, volatile LAS unsigned* st) {
    XcdBarrier b; b.bar = bar; b.x = xb_xcc_id(); b.st = st;
    if (threadIdx.x == 0) (void)xb_add(&bar[XB_XCNT(b.x)], 1u);
    return b;
}
__device__ __forceinline__ void xcd_barrier_complete(unsigned* bar, unsigned x, unsigned& nloc, unsigned& nx) {
    const unsigned G = gridDim.x * gridDim.y * gridDim.z;
    unsigned sum, cnt, mine, sp = 0u;
    for (;;) {
        sum = 0u; cnt = 0u; mine = 0u;
#pragma unroll
        for (unsigned j = 0; j < 16; ++j) { const unsigned c = xb_ld(&bar[XB_XCNT(j)]); sum += c; cnt += (c > 0u) ? 1u : 0u; mine = (j == x) ? c : mine; }
        if (sum == G) break;
        __builtin_amdgcn_s_sleep(1);
        if ((++sp & 255u) == 0u) { if (xb_ld(&bar[XB_TMO])) break; if (sp > XB_SPIN_CAP) { atomicAdd(&bar[XB_TMO], 1u); break; } }
    }
    nloc = mine > 0u ? mine : 1u; nx = cnt > 0u ? cnt : 1u;
}
__device__ __forceinline__ void xcd_barrier(const XcdBarrier& b) {
    asm volatile("s_waitcnt vmcnt(0)" ::: "memory");
    __syncthreads();
    if (threadIdx.x == 0) {
        unsigned* bar = b.bar;
        __builtin_amdgcn_s_waitcnt(0);
        unsigned nloc = b.st[0], nx = b.st[1];
        if (nloc == 0u) { xcd_barrier_complete(bar, b.x, nloc, nx); b.st[0] = nloc; b.st[1] = nx; }
        const unsigned old = xb_add(&bar[XB_XSUB(b.x)], 1u);
        const unsigned gen = old / nloc;
        if (old + 1u == (gen + 1u) * nloc) {
            __builtin_amdgcn_fence(__ATOMIC_RELEASE, "agent");
            asm volatile("s_waitcnt vmcnt(0)" ::: "memory");
            const unsigned og = xb_add(&bar[XB_TOP], 1u);
            const unsigned tg = og / nx;
            if (og + 1u == (tg + 1u) * nx) xb_add(&bar[XB_TOPGEN], 1u);
            else XB_SPIN(xb_ld(&bar[XB_TOPGEN]) == tg, bar);
            __builtin_amdgcn_fence(__ATOMIC_ACQUIRE, "agent");
            xb_add(&bar[XB_XGEN(b.x)], 1u);
            asm volatile("s_waitcnt vmcnt(0)" ::: "memory");
        } else {
            XB_SPIN(xb_ld(&bar[XB_XGEN(b.x)]) == gen, bar);
            __builtin_amdgcn_fence(__ATOMIC_ACQUIRE, "agent");
            asm volatile("s_waitcnt vmcnt(0)" ::: "memory");
        }
    }
    __syncthreads();
}
#ifndef PROBE_A
#define PROBE_A -1
#endif
#ifndef PROBE_B
#define PROBE_B -1
#endif
#ifndef PROBE_A0
#define PROBE_A0 (PROBE_A - 1)
#endif
#ifndef PROBE_B0
#define PROBE_B0 (PROBE_B - 1)
#endif
#ifndef PROBE_SCALE
#define PROBE_SCALE 0.5e-6f
#endif
constexpr int CW_BAR = 4096, CW_TS = 8192;

typedef const __attribute__((address_space(4))) Args* KArgP;
__device__ __forceinline__ KArgP kargs() { KArgP p = (KArgP)__builtin_amdgcn_kernarg_segment_ptr(); asm volatile("" : "+s"(p)); return p; }
__global__ void __launch_bounds__(NTHREADS, 2) mega_fwd(Args A_) {
    extern __shared__ __attribute__((aligned(16))) unsigned char lds_raw[];
    LAS unsigned char* lds = (LAS unsigned char*)lds_raw;
    cg::grid_group grid = cg::this_grid();
    const int G = gridDim.x; const int bx = blockIdx.x;
    const int vcu = (G % 8 == 0) ? (bx % 8) * (G / 8) + bx / 8 : bx;
    const int NGW = G * NWAVES;
    unsigned char* ws = A_.ws;
    unsigned* ctl = (unsigned*)(ws + WS_CTL);
    LAS int* MISC = (LAS int*)(lds + MISC_OFF);
    LAS int* l_cnt = MISC; LAS int* l_tstart = MISC + 64; LAS int* l_sstart = MISC + 192;
    if (threadIdx.x < 2) MISC[300 + threadIdx.x] = 0;
    __syncthreads();
    (void)xcd_barrier_post(ctl + CW_BAR, (volatile LAS unsigned*)(MISC + 300));
#define STAMP(k) do { if ((PROBE_A >= 0 || PROBE_B >= 0) && blockIdx.x == 0 && threadIdx.x == 0) ((unsigned long long*)((unsigned*)(ws + WS_CTL) + CW_TS))[k] = __builtin_amdgcn_s_memrealtime(); } while (0)
#define GSYNC(k) do { XcdBarrier xb_; xb_.bar = (unsigned*)(ws + WS_CTL) + CW_BAR; xb_.x = xb_xcc_id(); xb_.st = (volatile LAS unsigned*)(lds + MISC_OFF) + 300; xcd_barrier(xb_); STAMP(k); } while (0)
    STAMP(0);

    {
        PHASE_IDS;
        KArgP K_ = kargs();
        const float* a_wg = K_->wg; const float* a_we = K_->we; const float* a_nmoe = K_->norm_moe_w; const float* a_win = K_->w_in; const float* a_wa = K_->w_a; const float* a_wb = K_->w_b; const float* a_wo = K_->w_o;
        const float* a_x = K_->x; const float* a_nmix = K_->norm_mix_w;
        for (int i = gw * 64 + lane; i < 80 * 1024; i += NGW * 64) {
            const int r = i >> 10, k = i & 1023; float v = 0.f;
            if (r < 8) v = a_wg[k * 8 + r]; else if (r >= 16) v = a_we[k * 64 + (r - 16)];
            v *= a_nmoe[k];
            const unsigned hi = cvt_pk_bf16(v, 0.f) & 0xffffu; const float lo = v - __uint_as_float(hi << 16);
            ((bf16_t*)(ws + WS_WR))[i] = (bf16_t)hi; ((bf16_t*)(ws + WS_WR))[80 * 1024 + i] = (bf16_t)(cvt_pk_bf16(lo, 0.f) & 0xffffu);
        }
        {
            LAS unsigned* T = (LAS unsigned*)(lds + wave * 8192);
            constexpr int I_IN8 = (DM / 128) * (4608 / 64), I_IN = (DM / 64) * ((IN_W - 4608) / 64), I_A = (512 / 64) * (DM / 64), I_B = (DM / 64) * (DM / 64), I_O = I_B;
            for (int it = gw; it < I_IN8 + I_IN + I_A + I_B + I_O; it += NGW) {
                int r = it;
                if (r < I_IN8) {
                    const int n0 = (r / (DM / 128)) * 64;
                    if (n0 < 3072) transpose_tile_fp8<1, false>(a_win, DM, IN_W, (unsigned char*)(ws + WS_WIN8), 0, T, r, lane, W8_SCALE);
                    else transpose_tile_fp8<0, false>(a_win, DM, IN_W, (unsigned char*)(ws + WS_WIN8), 0, T, r, lane, W8_SCALE);
                    continue; } r -= I_IN8;
                if (r < I_IN) {
                    const int r2 = r + (DM / 64) * (4608 / 64);
                    const int n0 = (r2 / (DM / 64)) * 64;
                    const bool rot = (n0 >= 4608 && n0 < 5632);
                    if (rot) transpose_tile64<1, false>(a_win, DM, IN_W, (bf16_t*)(ws + WS_WIN), 0, T, r2, lane);
                    else transpose_tile64<0, false>(a_win, DM, IN_W, (bf16_t*)(ws + WS_WIN), 0, T, r2, lane);
                    continue; } r -= I_IN;
                if (r < I_A) { transpose_tile64<0, false>(a_wa, 512, DM, (bf16_t*)(ws + WS_WA), 0, T, r, lane, 1536, 0); continue; } r -= I_A;
                if (r < I_B) { transpose_tile64<0, false>(a_wb, DM, DM, (bf16_t*)(ws + WS_WA), 0, T, r, lane, 1536, 512); continue; } r -= I_B;
                transpose_tile64<0, false>(a_wo, DM, DM, (bf16_t*)(ws + WS_WO), 0, T, r, lane);
            }
        }
        f32x4 wn[4];
#pragma unroll
        for (int j = 0; j < 4; ++j) wn[j] = ((const f32x4*)a_nmix + lane)[64 * j];
        for (int m = gw; m < NTOK; m += 2 * NGW) {
            const int m2 = (m + NGW < NTOK) ? m + NGW : m;
            const f32x4* xa = (const f32x4*)(a_x + (size_t)m * DM) + lane; const f32x4* xb = (const f32x4*)(a_x + (size_t)m2 * DM) + lane;
            f32x4 va[4], vb[4]; float sa = 0.f, sb = 0.f;
#pragma unroll
            for (int j = 0; j < 4; ++j) { va[j] = xa[64 * j]; vb[j] = xb[64 * j]; }
#pragma unroll
            for (int j = 0; j < 4; ++j) { sa += (va[j].x * va[j].x + va[j].y * va[j].y) + (va[j].z * va[j].z + va[j].w * va[j].w); sb += (vb[j].x * vb[j].x + vb[j].y * vb[j].y) + (vb[j].z * vb[j].z + vb[j].w * vb[j].w); }
#pragma unroll
            for (int o_ = 1; o_ < 64; o_ <<= 1) { sa += __shfl_xor(sa, o_); sb += __shfl_xor(sb, o_); }
            const float ra = 1.f / sqrtf(sa * (1.f / DM) + NORM_EPS), rb = 1.f / sqrtf(sb * (1.f / DM) + NORM_EPS);
            u32x2* oa = (u32x2*)((bf16_t*)(ws + WS_XN) + (size_t)m * DM) + lane; u32x2* ob = (u32x2*)((bf16_t*)(ws + WS_XN) + (size_t)m2 * DM) + lane;
#pragma unroll
            for (int j = 0; j < 4; ++j) { const f32x4 ww = wn[j];
                const f32x4 ya = va[j] * ra * ww, yb = vb[j] * rb * ww;
                u32x2 o; o.x = cvt_pk_bf16(ya.x, ya.y); o.y = cvt_pk_bf16(ya.z, ya.w); oa[64 * j] = o;
                u32x2 p; p.x = cvt_pk_bf16(yb.x, yb.y); p.y = cvt_pk_bf16(yb.z, yb.w); ob[64 * j] = p;
                ((unsigned*)((unsigned char*)(ws + WS_XN8) + (size_t)m * DM))[lane + 64 * j] = pk_fp8x4(ya.x, ya.y, ya.z, ya.w);
                ((unsigned*)((unsigned char*)(ws + WS_XN8) + (size_t)m2 * DM))[lane + 64 * j] = pk_fp8x4(yb.x, yb.y, yb.z, yb.w); }
        }
    }
    if (G > (1 << 24)) grid.sync();
    GSYNC(1);

    {
        pg8::StaticOrder S; S.init(ws + WS_XN8, ws + WS_WIN8, NTOK, 4608, DM / 2, G, bx);
        EpiProjAtt E{ws, W8_DESCALE};
        pg8::gemm_phase<EpiProjAtt, pg8::StaticOrder, true, true, false, true>(lds, DM / 2, S, E);
    }
    GSYNC(2);

#if EN_ATT
    {
        PHASE_IDS;
        const bf16_t* QA = (const bf16_t*)(ws + WS_QA); const bf16_t* KA = (const bf16_t*)(ws + WS_KA); const bf16_t* VA = (const bf16_t*)(ws + WS_VA);
        float* LSE = (float*)(ws + WS_LSE); bf16_t* YCAT = (bf16_t*)kargs()->out;
        const unsigned lds_base = (unsigned)(size_t)lds;
        const int qi = lane & 15, g4 = lane >> 4;
        const int swk = ((qi >> 1) & 3) << 1;
        const int koff0 = qi * 128 + ((g4 ^ swk) << 4), koff1 = qi * 128 + (((4 + g4) ^ swk) << 4);
        const int vrow_l = 4 * g4 + (qi >> 2), swv = ((vrow_l >> 1) & 3) << 1;
        int voff[4];
#pragma unroll
        for (int dt = 0; dt < 4; ++dt) voff[dt] = vrow_l * 128 + (((2 * dt + ((qi & 3) >> 1)) ^ swv) << 4) + 8 * (qi & 1);
        const int drow = lane >> 3, dchp = lane & 7;
        for (int unit = vcu; unit < 256; unit += G) {
            const int b = unit >> 4, h = (unit >> 1) & 7, half = unit & 1;
            const size_t tokb = (size_t)b * SEQ;
#define ATT_GEOM(s_) const int grp = (s_) >> 3, jj = (s_) & 7; const int dil = (grp == 0) ? 1 : (grp == 1 ? 4 : 16), L = SEQ / dil; \
            const int rr = (grp == 0) ? 0 : (grp == 1 ? (jj >> 1) : 2 * jj); \
            const int bstart = (grp == 0) ? (1024 * half + 128 * jj) : (grp == 1 ? (256 * half + 128 * (jj & 1)) : 64 * half);
#define ATT_DMA(s_, sl_) do { ATT_GEOM(s_) \
            _Pragma("unroll") for (int it = 0; it < 8; ++it) { const int ii = wave + 8 * it, tens = ii >> 5, rg = ii & 31; const int row = 8 * rg + drow; \
                int idx, rsel; if (grp == 2) { idx = row & 127; rsel = rr + (row >> 7); } else { idx = bstart - 64 + row; idx = idx < 0 ? 0 : (idx > L - 1 ? L - 1 : idx); rsel = rr; } \
                const int ch = dchp ^ (((row >> 1) & 3) << 1); \
                const bf16_t* src = (tens ? VA : KA) + ((size_t)((b * 3 + grp) * 8 + h) * SEQ + (size_t)idx * dil + rsel) * 64 + ch * 8; \
                glds16(src, (unsigned)__builtin_amdgcn_readfirstlane((int)(lds_base + (sl_) * 65536 + tens * 32768 + rg * 1024))); } } while (0)
#define ATT_QGEOM(s_) ATT_GEOM(s_) const int sub = wave >> 2; \
            const int qidx0 = (grp == 2) ? (bstart + 16 * (wave & 3)) : (bstart + 16 * wave); const int rq = (grp == 2) ? rr + sub : rr; \
            const int rowbase = (grp == 2) ? (128 * sub + qidx0 - 64) : 16 * wave; \
            const int sq = (qidx0 + qi) * dil + rq; const size_t hmq = ((size_t)((b * 3 + grp) * 8 + h) * SEQ + sq) * 64;        \
            const size_t tokq = tokb + sq;
            bf16x8 qn0, qn1; u32x2 pn[4]; float ln = 0.f;
#pragma unroll
            for (int dt = 0; dt < 4; ++dt) pn[dt] = (u32x2){0u, 0u};
            { ATT_QGEOM(0) const bf16_t* qp = QA + hmq + 8 * g4; qn0 = *(const bf16x8*)qp; qn1 = *(const bf16x8*)(qp + 32); (void)tokq; }
            ATT_DMA(0, 0);
            for (int s = 0; s < 24; ++s) {
                asm volatile("s_waitcnt vmcnt(0)" ::: "memory"); __builtin_amdgcn_s_barrier(); asm volatile("" ::: "memory");
                bf16x8 qf0 = qn0, qf1 = qn1; asm volatile("" : "+v"(qf0), "+v"(qf1));
                u32x2 pc[4]; float lc = ln;
#pragma unroll
                for (int dt = 0; dt < 4; ++dt) pc[dt] = pn[dt];
                asm volatile("" : "+v"(pc[0]), "+v"(pc[1]), "+v"(pc[2]), "+v"(pc[3]), "+v"(lc));
                if (s + 1 < 24) { ATT_DMA(s + 1, (s + 1) & 1); { ATT_QGEOM(s + 1) const bf16_t* qp = QA + hmq + 8 * g4; qn0 = *(const bf16x8*)qp; qn1 = *(const bf16x8*)(qp + 32);
                    if (s + 1 >= 8) { const bf16_t* yp = YCAT + tokq * 1536 + h * 64 + 4 * g4;
#pragma unroll
                        for (int dt = 0; dt < 4; ++dt) pn[dt] = *(const u32x2*)(yp + 16 * dt);
                        ln = LSE[tokq * 8 + h]; } } }
                {
                    ATT_QGEOM(s)
                    const LAS unsigned char* Kt = lds + (s & 1) * 65536; const LAS unsigned char* Vt = Kt + 32768;
                    f32x4 sc[9]; float mx = -INFINITY; int trow[9];
#pragma unroll
                    for (int kt = 0; kt < 9; ++kt) {
                        const int kidx0 = qidx0 - 64 + 16 * kt; const bool inr = (kidx0 >= 0) && (kidx0 < L);
                        const int tr_ = inr ? rowbase + 16 * kt : rowbase + 64; trow[kt] = tr_;
                        const LAS unsigned char* kp = Kt + tr_ * 128;
                        const bf16x8 k0 = *(const LAS bf16x8*)(kp + koff0), k1 = *(const LAS bf16x8*)(kp + koff1);
                        f32x4 sv = (f32x4){0.f, 0.f, 0.f, 0.f};
                        sv = __builtin_amdgcn_mfma_f32_16x16x32_bf16(k0, qf0, sv, 0, 0, 0);
                        sv = __builtin_amdgcn_mfma_f32_16x16x32_bf16(k1, qf1, sv, 0, 0, 0);
#pragma unroll
                        for (int i = 0; i < 4; ++i) { const int kr = 4 * g4 + i; bool ok = inr; if (kt == 0) ok = ok && (kr >= qi); if (kt == 8) ok = ok && (kr <= qi);
                            sv[i] = ok ? sv[i] : -INFINITY; mx = fmaxf(mx, sv[i]); }
                        sc[kt] = sv;
                    }
                    mx = fmaxf(mx, __shfl_xor(mx, 16)); mx = fmaxf(mx, __shfl_xor(mx, 32));
                    float lsum = 0.f;
#pragma unroll
                    for (int kt = 0; kt < 9; ++kt)
#pragma unroll
                        for (int i = 0; i < 4; ++i) { const float p = fast_exp2(sc[kt][i] - mx); sc[kt][i] = p; lsum += p; }
                    lsum += __shfl_xor(lsum, 16); lsum += __shfl_xor(lsum, 32);
                    f32x4 o[4];
#pragma unroll
                    for (int dt = 0; dt < 4; ++dt) o[dt] = (f32x4){0.f, 0.f, 0.f, 0.f};
#pragma unroll
                    for (int kk = 0; kk < 5; ++kk) {
                        const int t0 = 2 * kk, t1 = (kk == 4) ? 8 : 2 * kk + 1;
                        u32x4 pw; pw.x = cvt_pk_bf16(sc[t0][0], sc[t0][1]); pw.y = cvt_pk_bf16(sc[t0][2], sc[t0][3]);
                        if (kk == 4) { pw.z = 0u; pw.w = 0u; } else { pw.z = cvt_pk_bf16(sc[t1][0], sc[t1][1]); pw.w = cvt_pk_bf16(sc[t1][2], sc[t1][3]); }
                        const bf16x8 pf = __builtin_bit_cast(bf16x8, pw);
                        const LAS unsigned char* v0p = Vt + trow[t0] * 128; const LAS unsigned char* v1p = Vt + trow[t1] * 128;
#pragma unroll
                        for (int dt = 0; dt < 4; ++dt) {
                            const bf16x8 vf = cat4(tr_read((const LAS char*)(v0p + voff[dt])), tr_read((const LAS char*)(v1p + voff[dt])));
                            o[dt] = __builtin_amdgcn_mfma_f32_16x16x32_bf16(vf, pf, o[dt], 0, 0, 0);
                        }
                    }
                    const float rl = 1.f / lsum, lse2 = mx + log2f(lsum);
                    float fa = 0.f, fb = rl, lnew = lse2;
                    if (grp > 0) { const float m = fmaxf(lc, lse2), wa = fast_exp2(lc - m), wb = fast_exp2(lse2 - m), inv = 1.f / (wa + wb); fa = wa * inv; fb = wb * inv * rl; lnew = m + log2f(wa + wb); }
                    bf16_t* op = YCAT + tokq * 1536 + h * 64 + 4 * g4;
#pragma unroll
                    for (int dt = 0; dt < 4; ++dt) { u32x2 w;
                        w.x = cvt_pk_bf16(fa * bf_lo(pc[dt].x) + fb * o[dt][0], fa * bf_hi(pc[dt].x) + fb * o[dt][1]); w.y = cvt_pk_bf16(fa * bf_lo(pc[dt].y) + fb * o[dt][2], fa * bf_hi(pc[dt].y) + fb * o[dt][3]);
                        *(u32x2*)(op + 16 * dt) = w; }
                    if (g4 == 0 && grp < 2) LSE[tokq * 8 + h] = lnew;
                }
            }
#undef ATT_GEOM
#undef ATT_DMA
#undef ATT_QGEOM
            VM_WAIT();
            __syncthreads();
        }
    }
#else
    { PHASE_IDS; bf16_t* yc = (bf16_t*)kargs()->out; for (size_t i = (size_t)bx * NTHREADS + tid; i < (size_t)NTOK * 64; i += (size_t)G * NTHREADS) *(u32x4*)(yc + (i >> 6) * 1536 + (i & 63) * 8) = (u32x4){0u, 0u, 0u, 0u}; }
#endif
    GSYNC(3);

    {
        pg8::StaticOrder S; S.init(ws + WS_XN, ws + WS_WIN + (size_t)4608 * DM * 2, NTOK, 5120, DM, G, bx);
        KArgP K_ = kargs();
        EpiProj E{ws, (bf16_t*)K_->out, K_->b_gate, 18, 1.f};
        pg8::gemm_phase<EpiProj, pg8::StaticOrder, true, true>(lds, DM, S, E);
    }
    GSYNC(4);

#if EN_RET
    {
        PHASE_IDS;
        const bf16_t* KR = (const bf16_t*)(ws + WS_KR); const bf16_t* VR = (const bf16_t*)(ws + WS_VR); bf16_t* SST = (bf16_t*)(ws + WS_SST);
        constexpr int RSK = 160, RSV = 288; constexpr int KT_OFF = 0, VT_OFF = 128 * RSK;
        const int dcol = lane & 15, g4 = lane >> 4;
        for (int unit = vcu; unit < 256; unit += G) {
            const int b = unit >> 4, h = (unit >> 1) & 7, dir = unit & 1;
            KArgP K_ = kargs(); const float lg = log_sigmoid(dir ? K_->dec_b[h] : K_->dec_f[h]); const float lg2 = lg * LOG2E; const float cd = exp2f(128.f * lg2);
            f32x4 st[4];
#pragma unroll
            for (int dt = 0; dt < 4; ++dt) st[dt] = (f32x4){0.f, 0.f, 0.f, 0.f};
            constexpr int BUFB = 128 * RSK + 128 * RSV;
            u32x4 kA[2], vA[4], kB[2], vB[4];
            float zk[2];
#pragma unroll
            for (int it = 0; it < 2; ++it) { const int row = (tid + NTHREADS * it) >> 3; zk[it] = exp2f(lg2 * (float)(dir ? row : 127 - row)); }
#define P3A_LOAD(kr_, vr_, s_) do { const size_t tk_ = (size_t)b * SEQ + (dir ? 15 - (s_) : (s_)) * 128; \
                _Pragma("unroll") for (int it = 0; it < 2; ++it) { const int p = tid + NTHREADS * it, row = p >> 3, ch = p & 7; kr_[it] = *(const u32x4*)(KR + (tk_ + row) * 512 + h * 64 + ch * 8); } \
                _Pragma("unroll") for (int it = 0; it < 4; ++it) { const int p = tid + NTHREADS * it, row = p >> 4, ch = p & 15; vr_[it] = *(const u32x4*)(VR + (tk_ + row) * 1024 + h * 128 + ch * 8); } } while (0)
#define P3A_STAGE(kr_, vr_, buf_) do { \
                _Pragma("unroll") for (int it = 0; it < 2; ++it) { const int p = tid + NTHREADS * it, row = p >> 3, ch = p & 7; const u32x4 v = kr_[it]; const float z = zk[it]; \
                    u32x4 o; o.x = cvt_pk_bf16(bf_lo(v.x) * z, bf_hi(v.x) * z); o.y = cvt_pk_bf16(bf_lo(v.y) * z, bf_hi(v.y) * z); o.z = cvt_pk_bf16(bf_lo(v.z) * z, bf_hi(v.z) * z); o.w = cvt_pk_bf16(bf_lo(v.w) * z, bf_hi(v.w) * z); \
                    *(LAS u32x4*)(lds + (buf_) * BUFB + KT_OFF + row * RSK + ch * 16) = o; } \
                _Pragma("unroll") for (int it = 0; it < 4; ++it) { const int p = tid + NTHREADS * it, row = p >> 4, ch = p & 15; *(LAS u32x4*)(lds + (buf_) * BUFB + VT_OFF + row * RSV + ch * 16) = vr_[it]; } } while (0)
#define P3A_STEP(s_, kr_, vr_) do { const int n = dir ? 15 - (s_) : (s_); const int buf = (s_) & 1; \
                bf16_t* sp = SST + ((size_t)((b * 8 + h) * 2 + dir) * 16 + n) * 8192;        \
                _Pragma("unroll") for (int dt = 0; dt < 4; ++dt) { u32x2 w; w.x = cvt_pk_bf16(st[dt][0], st[dt][1]); w.y = cvt_pk_bf16(st[dt][2], st[dt][3]); *(u32x2*)(sp + (16 * dt + dcol) * 128 + 16 * wave + 4 * g4) = w; } \
                if ((s_) + 1 < 16) { P3A_STAGE(kr_, vr_, buf ^ 1); if ((s_) + 3 < 16) P3A_LOAD(kr_, vr_, (s_) + 3); } \
                _Pragma("unroll") for (int dt = 0; dt < 4; ++dt) st[dt] = st[dt] * cd; \
                _Pragma("unroll") for (int kk = 0; kk < 4; ++kk) { \
                    const int r0 = 32 * kk + 4 * g4 + (dcol >> 2), r1 = r0 + 16; \
                    const LAS unsigned char* vb = lds + buf * BUFB + VT_OFF + (16 * wave + 4 * (dcol & 3)) * 2; \
                    const bf16x8 af = cat4(tr_read((const LAS char*)(vb + r0 * RSV)), tr_read((const LAS char*)(vb + r1 * RSV))); \
                    _Pragma("unroll") for (int dt = 0; dt < 4; ++dt) { \
                        const LAS unsigned char* kb = lds + buf * BUFB + KT_OFF + (16 * dt + 4 * (dcol & 3)) * 2; \
                        const bf16x8 bfr = cat4(tr_read((const LAS char*)(kb + r0 * RSK)), tr_read((const LAS char*)(kb + r1 * RSK))); \
                        st[dt] = __builtin_amdgcn_mfma_f32_16x16x32_bf16(af, bfr, st[dt], 0, 0, 0); } } \
                __syncthreads(); } while (0)
            P3A_LOAD(kA, vA, 0); P3A_LOAD(kB, vB, 1);
            P3A_STAGE(kA, vA, 0); P3A_LOAD(kA, vA, 2);
            __syncthreads();
#pragma unroll 1
            for (int step = 0; step < 16; step += 2) {
                P3A_STEP(step, kB, vB);
                P3A_STEP(step + 1, kA, vA);
            }
#undef P3A_LOAD
#undef P3A_STAGE
#undef P3A_STEP
        }
    }
    GSYNC(5);
    {
        PHASE_IDS;
        const bf16_t* QR = (const bf16_t*)(ws + WS_QR); const bf16_t* KR = (const bf16_t*)(ws + WS_KR); const bf16_t* VR = (const bf16_t*)(ws + WS_VR);
        const bf16_t* GR = (const bf16_t*)(ws + WS_GR); const bf16_t* SST = (const bf16_t*)(ws + WS_SST); bf16_t* YCAT = (bf16_t*)kargs()->out;
        constexpr int RSK = 160, RSV = 288; constexpr int QT = 0, KT = 20480, VT = 40960, SF = 77824, SB = 96256, GNW = 114688, GT = 118784;
        const int qi = lane & 15, g4 = lane >> 4;
        { const float* a_gnw0 = kargs()->gn_w; ((LAS float*)(lds + GNW))[tid] = a_gnw0[tid]; ((LAS float*)(lds + GNW))[tid + 512] = a_gnw0[tid + 512]; }
        u32x4 pre[12];
#define P3B_LOAD(unit_) do { const int bh_ = (unit_) >> 4, n_ = (unit_) & 15, b_ = bh_ >> 3, h_ = bh_ & 7; const size_t tk_ = (size_t)b_ * SEQ + n_ * 128; \
            _Pragma("unroll") for (int it = 0; it < 2; ++it) { const int p = tid + NTHREADS * it, row = p >> 3, ch = p & 7; \
                pre[it] = *(const u32x4*)(QR + (tk_ + row) * 512 + h_ * 64 + ch * 8); pre[2 + it] = *(const u32x4*)(KR + (tk_ + row) * 512 + h_ * 64 + ch * 8); } \
            _Pragma("unroll") for (int it = 0; it < 4; ++it) { const int p = tid + NTHREADS * it, row = p >> 4, ch = p & 15; pre[4 + it] = *(const u32x4*)(VR + (tk_ + row) * 1024 + h_ * 128 + ch * 8); } \
            _Pragma("unroll") for (int it = 0; it < 2; ++it) { const int p = tid + NTHREADS * it, row = p >> 4, ch = p & 15; \
                pre[8 + it] = *(const u32x4*)(SST + ((size_t)(bh_ * 2 + 0) * 16 + n_) * 8192 + row * 128 + ch * 8); pre[10 + it] = *(const u32x4*)(SST + ((size_t)(bh_ * 2 + 1) * 16 + n_) * 8192 + row * 128 + ch * 8); } } while (0)
        if (vcu < 2048) P3B_LOAD(vcu);
        for (int unit = vcu; unit < 2048; unit += G) {
            const int bh = unit >> 4, n = unit & 15, b = bh >> 3, h = bh & 7;
            KArgP K_ = kargs(); const float lgf2 = log_sigmoid(K_->dec_f[h]) * LOG2E, lgb2 = log_sigmoid(K_->dec_b[h]) * LOG2E;
            const size_t tok0 = (size_t)b * SEQ + n * 128;
#pragma unroll
            for (int it = 0; it < 2; ++it) { const int p = tid + NTHREADS * it, row = p >> 3, ch = p & 7;
                *(LAS u32x4*)(lds + QT + row * RSK + ch * 16) = pre[it]; *(LAS u32x4*)(lds + KT + row * RSK + ch * 16) = pre[2 + it]; }
#pragma unroll
            for (int it = 0; it < 4; ++it) { const int p = tid + NTHREADS * it, row = p >> 4, ch = p & 15; *(LAS u32x4*)(lds + VT + row * RSV + ch * 16) = pre[4 + it]; }
#pragma unroll
            for (int it = 0; it < 2; ++it) { const int p = tid + NTHREADS * it, row = p >> 4, ch = p & 15;
                *(LAS u32x4*)(lds + SF + row * RSV + ch * 16) = pre[8 + it]; *(LAS u32x4*)(lds + SB + row * RSV + ch * 16) = pre[10 + it]; }
            __syncthreads();
            {
                const unsigned gdst = (unsigned)(size_t)lds + (unsigned)(wave < 3 ? GT + wave * 4096 : ROFF_OFF + (wave - 3) * 4096);
#pragma unroll
                for (int j = 0; j < 4; ++j) { const int row = 4 * j + (lane >> 4), c = (lane & 15) ^ row;
                    glds16(GR + (tok0 + 16 * wave + row) * 1024 + h * 128 + c * 8, (unsigned)__builtin_amdgcn_readfirstlane((int)(gdst + j * 1024))); }
            }
            if (unit + G < 2048) P3B_LOAD(unit + G);
            {
                const int qa = 16 * wave + qi;
                const LAS unsigned char* qrow = lds + QT + qa * RSK;
                const bf16x8 qf0 = *(const LAS bf16x8*)(qrow + g4 * 16), qf1 = *(const LAS bf16x8*)(qrow + 64 + g4 * 16);
                bf16x8 pf[4];
#pragma unroll
                for (int kk = 0; kk < 4; ++kk) {
                    u32x4 pw;
#pragma unroll
                    for (int tt = 0; tt < 2; ++tt) {
                        const int kt = 2 * kk + tt;
                        const LAS unsigned char* kp = lds + KT + (16 * kt + qi) * RSK + g4 * 16;
                        const bf16x8 k0 = *(const LAS bf16x8*)kp, k1 = *(const LAS bf16x8*)(kp + 64);
                        f32x4 s = (f32x4){0.f, 0.f, 0.f, 0.f};
                        s = __builtin_amdgcn_mfma_f32_16x16x32_bf16(k0, qf0, s, 0, 0, 0);
                        s = __builtin_amdgcn_mfma_f32_16x16x32_bf16(k1, qf1, s, 0, 0, 0);
#pragma unroll
                        for (int i = 0; i < 4; ++i) { const int kb_ = 16 * kt + 4 * g4 + i; const int dl = qa - kb_;
                            const float w = dl > 0 ? fast_exp2(lgf2 * (float)dl) : (dl < 0 ? fast_exp2(lgb2 * (float)(-dl)) : 2.f); s[i] *= w; }
                        if (tt == 0) { pw.x = cvt_pk_bf16(s[0], s[1]); pw.y = cvt_pk_bf16(s[2], s[3]); } else { pw.z = cvt_pk_bf16(s[0], s[1]); pw.w = cvt_pk_bf16(s[2], s[3]); }
                    }
                    pf[kk] = __builtin_bit_cast(bf16x8, pw);
                }
                const float xif = fast_exp2(lgf2 * (float)(qa + 1)), xib = fast_exp2(lgb2 * (float)(128 - qa));
                bf16x8 qxf[2], qxb[2];
#pragma unroll
                for (int kk = 0; kk < 2; ++kk) {
                    const u32x2 a = *(const LAS u32x2*)(qrow + (32 * kk + 4 * g4) * 2), c = *(const LAS u32x2*)(qrow + (32 * kk + 16 + 4 * g4) * 2);
                    u32x4 f, bq;
                    f.x = cvt_pk_bf16(bf_lo(a.x) * xif, bf_hi(a.x) * xif); f.y = cvt_pk_bf16(bf_lo(a.y) * xif, bf_hi(a.y) * xif); f.z = cvt_pk_bf16(bf_lo(c.x) * xif, bf_hi(c.x) * xif); f.w = cvt_pk_bf16(bf_lo(c.y) * xif, bf_hi(c.y) * xif);
                    bq.x = cvt_pk_bf16(bf_lo(a.x) * xib, bf_hi(a.x) * xib); bq.y = cvt_pk_bf16(bf_lo(a.y) * xib, bf_hi(a.y) * xib); bq.z = cvt_pk_bf16(bf_lo(c.x) * xib, bf_hi(c.x) * xib); bq.w = cvt_pk_bf16(bf_lo(c.y) * xib, bf_hi(c.y) * xib);
                    qxf[kk] = __builtin_bit_cast(bf16x8, f); qxb[kk] = __builtin_bit_cast(bf16x8, bq);
                }
                f32x4 o[8];
                const int trow = 4 * g4 + (qi >> 2), tcol = (qi & 3) * 8;
#pragma unroll
                for (int vt = 0; vt < 8; ++vt) {
                    f32x4 acc = (f32x4){0.f, 0.f, 0.f, 0.f};
#pragma unroll
                    for (int kk = 0; kk < 4; ++kk) {
                        const LAS unsigned char* vb = lds + VT + (32 * kk + trow) * RSV + vt * 32 + tcol;
                        const bf16x8 af = cat4(tr_read((const LAS char*)vb), tr_read((const LAS char*)(vb + 16 * RSV)));
                        acc = __builtin_amdgcn_mfma_f32_16x16x32_bf16(af, pf[kk], acc, 0, 0, 0);
                    }
#pragma unroll
                    for (int kk = 0; kk < 2; ++kk) {
                        const LAS unsigned char* sfp = lds + SF + (32 * kk + trow) * RSV + vt * 32 + tcol;
                        const bf16x8 af = cat4(tr_read((const LAS char*)sfp), tr_read((const LAS char*)(sfp + 16 * RSV)));
                        acc = __builtin_amdgcn_mfma_f32_16x16x32_bf16(af, qxf[kk], acc, 0, 0, 0);
                        const LAS unsigned char* sbp = lds + SB + (32 * kk + trow) * RSV + vt * 32 + tcol;
                        const bf16x8 ab = cat4(tr_read((const LAS char*)sbp), tr_read((const LAS char*)(sbp + 16 * RSV)));
                        acc = __builtin_amdgcn_mfma_f32_16x16x32_bf16(ab, qxb[kk], acc, 0, 0, 0);
                    }
                    o[vt] = acc;
                }
                float s = 0.f;
#pragma unroll
                for (int vt = 0; vt < 8; ++vt) s += (o[vt][0] + o[vt][1]) + (o[vt][2] + o[vt][3]);
                s += __shfl_xor(s, 16); s += __shfl_xor(s, 32);
                const float mu = s * (1.f / 128.f); float q2 = 0.f;
#pragma unroll
                for (int vt = 0; vt < 8; ++vt) { const f32x4 d = o[vt] - mu; q2 += (d[0] * d[0] + d[1] * d[1]) + (d[2] * d[2] + d[3] * d[3]); }
                q2 += __shfl_xor(q2, 16); q2 += __shfl_xor(q2, 32);
                const float rstd = 1.f / sqrtf(q2 * (1.f / 128.f) + NORM_EPS);
                const size_t tok = tok0 + qa;
                asm volatile("s_waitcnt vmcnt(0)" ::: "memory");
#pragma unroll
                for (int vt = 0; vt < 8; ++vt) {
                    const int col = h * 128 + 16 * vt + 4 * g4;
                    const f32x4 gw4 = *(const LAS f32x4*)(lds + GNW + col * 4); const u32x2 sg = *(const LAS u32x2*)(lds + (wave < 3 ? GT + wave * 4096 : ROFF_OFF + (wave - 3) * 4096) + qi * 256 + (((2 * vt + (g4 >> 1)) ^ qi) << 4) + 8 * (g4 & 1));
                    const f32x4 d = (o[vt] - mu) * rstd;
                    u32x2 w; w.x = cvt_pk_bf16(d[0] * gw4[0] * bf_lo(sg.x), d[1] * gw4[1] * bf_hi(sg.x)); w.y = cvt_pk_bf16(d[2] * gw4[2] * bf_lo(sg.y), d[3] * gw4[3] * bf_hi(sg.y));
                    *(u32x2*)(YCAT + tok * 1536 + 512 + col) = w;
                }
            }
            __syncthreads();
        }
    }
#else
    { PHASE_IDS; bf16_t* yc = (bf16_t*)kargs()->out; for (size_t i = (size_t)bx * NTHREADS + tid; i < (size_t)NTOK * 128; i += (size_t)G * NTHREADS) *(u32x4*)(yc + (i >> 7) * 1536 + 512 + (i & 127) * 8) = (u32x4){0u, 0u, 0u, 0u}; }
#endif
    GSYNC(6);

    {
        pg8::StaticOrder S; S.init(kargs()->out, ws + WS_WA, NTOK, DM, 1536, G, bx);
        EpiMerge E{(bf16_t*)(ws + WS_MERGED), (const bf16_t*)(ws + WS_GATE)};
        pg8::gemm_phase<EpiMerge, pg8::StaticOrder, true, true>(lds, 1536, S, E);
    }
    GSYNC(7);

    {
        pg8::StaticOrder S; S.init(ws + WS_MERGED, ws + WS_WO, NTOK, DM, DM, G, bx);
        EpiPlain E{(bf16_t*)(ws + WS_MIX)};
        pg8::gemm_phase<EpiPlain, pg8::StaticOrder, true, true>(lds, DM, S, E);
    }
    GSYNC(8);

#if EN_MOE
#ifndef NO_P6
    {
        PHASE_IDS;
        const float* H = kargs()->x; const bf16_t* MIX = (const bf16_t*)(ws + WS_MIX); const bf16_t* WRh = (const bf16_t*)(ws + WS_WR); unsigned char* HN = (unsigned char*)(ws + WS_HN);
        unsigned* ASG = (unsigned*)(ws + WS_ASG); float* RSTD = (float*)(ws + WS_RSTD);
        LAS float* NM = (LAS float*)(lds + 98304);
        { KArgP K0 = kargs(); const float* a_nmoe = K0->norm_moe_w; NM[tid] = a_nmoe[tid]; NM[tid + 512] = a_nmoe[tid + 512]; }
        if (tid < 2) MISC[310 + tid] = 0;
        if (tid < 64) MISC[320 + tid] = 0;
        __syncthreads();
        const int ntc = (NTOK / 16 - vcu * NWAVES + NGW - 1) / NGW * NWAVES;
        for (;;) {
            int kind = -1, widx = 0;
            if (lane == 0) {
                if (wave < 4) { widx = __hip_atomic_fetch_add(&MISC[311], 1, __ATOMIC_RELAXED, __HIP_MEMORY_SCOPE_WORKGROUP); if (widx < ntc) kind = 0;
                    else { widx = __hip_atomic_fetch_add(&MISC[310], 1, __ATOMIC_RELAXED, __HIP_MEMORY_SCOPE_WORKGROUP); if (vcu + G * widx < NEXP * 192) kind = 1; } }
                else { widx = __hip_atomic_fetch_add(&MISC[310], 1, __ATOMIC_RELAXED, __HIP_MEMORY_SCOPE_WORKGROUP); if (vcu + G * widx < NEXP * 192) kind = 1;
                    else { widx = __hip_atomic_fetch_add(&MISC[311], 1, __ATOMIC_RELAXED, __HIP_MEMORY_SCOPE_WORKGROUP); if (widx < ntc) kind = 0; } }
            }
            kind = __builtin_amdgcn_readfirstlane(kind); widx = __builtin_amdgcn_readfirstlane(widx);
            if (kind < 0) break;
            if (kind == 0) {
                KArgP K_ = kargs(); const float* a_bg = K_->bg; const float* a_be = K_->be;
                LAS float* LG = (LAS float*)(lds + wave * 8192);
                int lane_r = lane; asm volatile("" : "+v"(lane_r));
                const int tk = lane_r & 15, g4 = lane_r >> 4;
                const int tile = vcu * NWAVES + (widx & 7) + (widx >> 3) * NGW;
                const int t0 = tile * 16;
                f32x4 acc[5];
#pragma unroll
                for (int nt = 0; nt < 5; ++nt) acc[nt] = (f32x4){0.f, 0.f, 0.f, 0.f};
                float ss = 0.f;
                const float* hp = H + (size_t)(t0 + tk) * DM + 8 * g4; const bf16_t* mp = MIX + (size_t)(t0 + tk) * DM + 8 * g4;
                unsigned char* hnp = HN + (size_t)(t0 + tk) * DM + 8 * g4;
                const bf16_t* whp = WRh + (size_t)tk * DM + 8 * g4;
                f32x4 hA[2], hB[2], hC[2], hD[2]; bf16x8 wA[5], wB[5], wC[5], wD[5]; u32x4 mA, mB, mC, mD;
#define RT_LOAD(hS, wS, mS, ks_) do { hS[0] = *(const f32x4*)(hp + 32 * (ks_)); hS[1] = *(const f32x4*)(hp + 32 * (ks_) + 4); mS = *(const u32x4*)(mp + 32 * (ks_)); \
                    _Pragma("unroll") for (int nt = 0; nt < 5; ++nt) wS[nt] = *(const bf16x8*)(whp + (size_t)nt * 16 * DM + 32 * (ks_)); } while (0)
#define RT_COMP(hS, wS, mS, ks_) do { const f32x4 x0 = hS[0] + (f32x4){bf_lo(mS.x), bf_hi(mS.x), bf_lo(mS.y), bf_hi(mS.y)}, x1 = hS[1] + (f32x4){bf_lo(mS.z), bf_hi(mS.z), bf_lo(mS.w), bf_hi(mS.w)}; \
                    const f32x4 n0 = *(const LAS f32x4*)(NM + 32 * (ks_) + 8 * g4), n1 = *(const LAS f32x4*)(NM + 32 * (ks_) + 8 * g4 + 4); \
                    ss += (x0[0] * x0[0] + x0[1] * x0[1]) + (x0[2] * x0[2] + x0[3] * x0[3]) + (x1[0] * x1[0] + x1[1] * x1[1]) + (x1[2] * x1[2] + x1[3] * x1[3]); \
                    u32x2 hw; hw.x = pk_fp8x4(x0[0] * n0[0], x0[1] * n0[1], x0[2] * n0[2], x0[3] * n0[3]); hw.y = pk_fp8x4(x1[0] * n1[0], x1[1] * n1[1], x1[2] * n1[2], x1[3] * n1[3]); \
                    *(u32x2*)(hnp + 32 * (ks_)) = hw; \
                    u32x4 hi; hi.x = cvt_pk_bf16(x0[0], x0[1]); hi.y = cvt_pk_bf16(x0[2], x0[3]); hi.z = cvt_pk_bf16(x1[0], x1[1]); hi.w = cvt_pk_bf16(x1[2], x1[3]); \
                    u32x4 lo; lo.x = cvt_pk_bf16(x0[0] - bf_lo(hi.x), x0[1] - bf_hi(hi.x)); lo.y = cvt_pk_bf16(x0[2] - bf_lo(hi.y), x0[3] - bf_hi(hi.y)); \
                    lo.z = cvt_pk_bf16(x1[0] - bf_lo(hi.z), x1[1] - bf_hi(hi.z)); lo.w = cvt_pk_bf16(x1[2] - bf_lo(hi.w), x1[3] - bf_hi(hi.w)); \
                    const bf16x8 bh = __builtin_bit_cast(bf16x8, hi), bl = __builtin_bit_cast(bf16x8, lo); \
                    _Pragma("unroll") for (int nt = 0; nt < 5; ++nt) { acc[nt] = __builtin_amdgcn_mfma_f32_16x16x32_bf16(wS[nt], bh, acc[nt], 0, 0, 0); acc[nt] = __builtin_amdgcn_mfma_f32_16x16x32_bf16(wS[nt], bl, acc[nt], 0, 0, 0); } } while (0)
                RT_LOAD(hA, wA, mA, 0); RT_LOAD(hB, wB, mB, 1); RT_LOAD(hC, wC, mC, 2);
#pragma unroll 1
                for (int ks = 0; ks < 32; ks += 4) {
                    RT_LOAD(hD, wD, mD, ks + 3); RT_COMP(hA, wA, mA, ks);
                    if (ks + 4 < 32) RT_LOAD(hA, wA, mA, ks + 4); RT_COMP(hB, wB, mB, ks + 1);
                    if (ks + 5 < 32) RT_LOAD(hB, wB, mB, ks + 5); RT_COMP(hC, wC, mC, ks + 2);
                    if (ks + 6 < 32) RT_LOAD(hC, wC, mC, ks + 6); RT_COMP(hD, wD, mD, ks + 3);
                }
#undef RT_LOAD
#undef RT_COMP
                ss += __shfl_xor(ss, 16); ss += __shfl_xor(ss, 32);
                const float rstd = 1.f / sqrtf(ss * (1.f / DM) + NORM_EPS);
#pragma unroll
                for (int nt = 0; nt < 5; ++nt)
#pragma unroll
                    for (int i = 0; i < 4; ++i) LG[tk * 81 + 16 * nt + 4 * g4 + i] = acc[nt][i];
                LDS_WAIT(); asm volatile("" ::: "memory");
                int lane_t = lane; asm volatile("" : "+v"(lane_t));
                if (lane_t < 16) {
                    const int lane = lane_t;
                    const LAS float* lr = LG + lane * 81;
                    float gl[8]; float gmax = -INFINITY; int gi = 0;
#pragma unroll
                    for (int j = 0; j < 8; ++j) { gl[j] = lr[j] * rstd + a_bg[j]; if (gl[j] > gmax) { gmax = gl[j]; gi = j; } }
                    float gs = 0.f;
#pragma unroll
                    for (int j = 0; j < 8; ++j) gs += expf(gl[j] - gmax);
                    const float g_w = 1.f / gs;
                    float l1 = -INFINITY, l2 = -INFINITY; int i1 = 0, i2 = 0;
#pragma unroll
                    for (int j = 0; j < 8; ++j) { const float v = lr[16 + 8 * gi + j] * rstd + a_be[8 * gi + j];
                        if (v > l1) { l2 = l1; i2 = i1; l1 = v; i1 = j; } else if (v > l2) { l2 = v; i2 = j; } }
                    const float e1 = 1.f / (1.f + expf(l2 - l1)), e2 = 1.f - e1;
                    const int eid1 = gi * 8 + i1, eid2 = gi * 8 + i2;
                    const unsigned p1 = (unsigned)__hip_atomic_fetch_add(&MISC[320 + eid1], 1, __ATOMIC_RELAXED, __HIP_MEMORY_SCOPE_WORKGROUP), p2 = (unsigned)__hip_atomic_fetch_add(&MISC[320 + eid2], 1, __ATOMIC_RELAXED, __HIP_MEMORY_SCOPE_WORKGROUP);
                    u32x4 r0, r1; r0.x = (unsigned)eid1; r0.y = p1; r0.z = __float_as_uint(g_w * e1); r0.w = (unsigned)eid2; r1.x = p2; r1.y = __float_as_uint(g_w * e2); r1.z = 0u; r1.w = 0u;
                    *(u32x4*)(ASG + (size_t)(t0 + lane) * 8) = r0; *(u32x4*)(ASG + (size_t)(t0 + lane) * 8 + 4) = r1;
                    RSTD[t0 + lane] = rstd;
                }
                LDS_WAIT(); asm volatile("" ::: "memory");
            } else {
                LAS unsigned* T = (LAS unsigned*)(lds + wave * 8192);
                KArgP K2 = kargs(); const float* a_w1 = K2->w1; const float* a_w3 = K2->w3; const float* a_w2 = K2->w2;
                const int it = vcu + G * widx;
                int lane_c = lane; asm volatile("" : "+v"(lane_c));
                const int e = it / 192, r = it % 192;
                if (r < 64) transpose_tile_fp8<2, true>(a_w1 + (size_t)e * 1024 * 512, 1024, 512, (unsigned char*)(ws + WS_W13) + (size_t)e * 1024 * 1024, 0, T, r, lane_c, W8_SCALE);
                else if (r < 128) transpose_tile_fp8<2, true>(a_w3 + (size_t)e * 1024 * 512, 1024, 512, (unsigned char*)(ws + WS_W13) + (size_t)e * 1024 * 1024, 128, T, r - 64, lane_c, W8_SCALE);
                else transpose_tile_fp8<0, true>(a_w2 + (size_t)e * 512 * 1024, 512, 1024, (unsigned char*)(ws + WS_W2) + (size_t)e * 1024 * 512, 0, T, r - 128, lane_c, W8_SCALE);
                LDS_WAIT(); asm volatile("" ::: "memory");
            }
        }
        __syncthreads();
        if (tid < 64) ((int*)(ws + WS_CNTT))[vcu * 64 + tid] = MISC[320 + tid];
    }
#endif
    GSYNC(9);
    {
        PHASE_IDS;
        const int* CNTT = (const int*)(ws + WS_CNTT); LAS int* PS = (LAS int*)lds;
        {
            const int e = tid & 63; int tot = 0, bas = 0;
            for (int w = wave; w < G; w += NWAVES) { const int c = CNTT[w * 64 + e]; tot += c; bas += (w < vcu) ? c : 0; }
            PS[wave * 64 + e] = tot; PS[512 + wave * 64 + e] = bas;
        }
        __syncthreads();
        if (tid < 64) { int tot = 0, bas = 0;
#pragma unroll
            for (int q = 0; q < NWAVES; ++q) { tot += PS[q * 64 + tid]; bas += PS[512 + q * 64 + tid]; }
            l_cnt[tid] = tot; MISC[384 + tid] = bas; }
        __syncthreads();
        if (tid == 0) { int ts = 0, ss = 0; for (int e = 0; e < NEXP; ++e) { l_tstart[e] = ts; l_sstart[e] = ss; ts += (l_cnt[e] + 255) >> 8; ss += l_cnt[e]; } l_tstart[NEXP] = ts; l_sstart[NEXP] = ss; }
        __syncthreads();
        unsigned* ASG = (unsigned*)(ws + WS_ASG); int* TOKL = (int*)(ws + WS_TOKL);
        for (int tb = vcu * NWAVES; tb < NTOK / 16; tb += NGW) {
            if (tid < 256) {
                const int tok = tb * 16 + (tid >> 1), k = tid & 1;
                const unsigned eid = ASG[(size_t)tok * 8 + (k ? 3 : 0)], pos = ASG[(size_t)tok * 8 + (k ? 4 : 1)];
                const int slot = l_sstart[eid] + MISC[384 + eid] + (int)pos;
                TOKL[slot] = tok; ASG[(size_t)tok * 8 + 6 + k] = (unsigned)slot;
            }
        }
    }
    GSYNC(10);
#ifndef NO_P7
    {
        for (int pair = vcu; pair < NEXP * 4; pair += G) {
            const int e = pair >> 2, pn = pair & 3;
            const int cnt = l_cnt[e], sst = l_sstart[e], ntile = (cnt + 255) >> 8;
            for (int u0 = 0; u0 < ntile; u0 += ROFF_UNITS) {
                const int nb = (ntile - u0) < ROFF_UNITS ? (ntile - u0) : ROFF_UNITS;
                {
                    const int tid = opaque_tid(); const int* TOKL = (const int*)(ws + WS_TOKL); const float* RSTD = (const float*)(ws + WS_RSTD); LAS int* RO = (LAS int*)(lds + ROFF_OFF); LAS float* RS = (LAS float*)(lds + RSC_OFF);
                    for (int idx = tid; idx < nb * 256; idx += NTHREADS) { int row = u0 * 256 + idx; row = row < cnt ? row : cnt - 1; const int tok = TOKL[sst + row]; RO[idx] = tok * DM; RS[idx] = RSTD[tok] * W8_DESCALE; }
                }
                __syncthreads();
                pg8::ExpertOrder S{(const char*)(ws + WS_HN), (const char*)(ws + WS_W13), DM / 2, e, pn, cnt, sst, u0, nb};
                EpiSwiglu E{(unsigned char*)(ws + WS_HID), (const LAS float*)(lds + RSC_OFF), u0};
                pg8::gemm_phase<EpiSwiglu, pg8::ExpertOrder, true, true, true, true>(lds, DM / 2, S, E, (const LAS int*)(lds + ROFF_OFF), (const char*)(ws + WS_HN));
                __syncthreads();
            }
        }
    }
#endif
    GSYNC(11);
#ifndef NO_P8
    {
        for (int pair = vcu; pair < NEXP * 4; pair += G) {
            const int e = pair >> 2, pn = pair & 3;
            pg8::ExpertOrder S{(const char*)(ws + WS_HID), (const char*)(ws + WS_W2), 256, e, pn, l_cnt[e], l_sstart[e], 0, (l_cnt[e] + 255) >> 8};
            EpiDown E{(bf16_t*)(ws + WS_Y), W8_DESCALE};
            pg8::gemm_phase<EpiDown, pg8::ExpertOrder, true, true, false, true>(lds, 256, S, E);
            __syncthreads();
        }
    }
#endif
    GSYNC(12);
#endif
    {
        PHASE_IDS;
        const unsigned* ASG = (const unsigned*)(ws + WS_ASG); const bf16_t* Y = (const bf16_t*)(ws + WS_Y); const bf16_t* MIX = (const bf16_t*)(ws + WS_MIX);
        KArgP K_ = kargs(); const float* a_nf = K_->norm_final_w; float* a_out = K_->out; const float* H = K_->x;
        const f32x4* wf = (const f32x4*)a_nf + lane; f32x4 wfv[4];
#pragma unroll
        for (int j = 0; j < 4; ++j) wfv[j] = wf[64 * j];
        u32x4 ra0 = (u32x4){0u, 0u, 0u, 0u}, ra1 = ra0, rb0 = ra0, rb1 = ra0;
        if (gw < NTOK) { ra0 = *(const u32x4*)(ASG + (size_t)gw * 8); ra1 = *(const u32x4*)(ASG + (size_t)gw * 8 + 4); }
        if (gw + NGW < NTOK) { rb0 = *(const u32x4*)(ASG + (size_t)(gw + NGW) * 8); rb1 = *(const u32x4*)(ASG + (size_t)(gw + NGW) * 8 + 4); }
        for (int m = gw; m < NTOK; m += 2 * NGW) {
            const int m2 = m + NGW; const bool has2 = m2 < NTOK; const int mb = has2 ? m2 : m;
            const u32x4 a0 = ra0, a1 = ra1, b0 = rb0, b1 = rb1;
            { const int n1 = m + 2 * NGW, n2 = m + 3 * NGW;
              if (n1 < NTOK) { ra0 = *(const u32x4*)(ASG + (size_t)n1 * 8); ra1 = *(const u32x4*)(ASG + (size_t)n1 * 8 + 4); }
              if (n2 < NTOK) { rb0 = *(const u32x4*)(ASG + (size_t)n2 * 8); rb1 = *(const u32x4*)(ASG + (size_t)n2 * 8 + 4); } }
            const f32x4* xrA = (const f32x4*)(H + (size_t)m * DM) + lane; const u32x2* mrA = (const u32x2*)(MIX + (size_t)m * DM) + lane;
            const f32x4* xrB = (const f32x4*)(H + (size_t)mb * DM) + lane; const u32x2* mrB = (const u32x2*)(MIX + (size_t)mb * DM) + lane;
            f32x4 vA[4], vB[4];
#if EN_MOE
            const float gA1 = __uint_as_float(a0.z), gA2 = __uint_as_float(a1.y), gB1 = __uint_as_float(b0.z), gB2 = __uint_as_float(b1.y);
            const u32x2* yA1 = (const u32x2*)(Y + (size_t)a1.z * DM) + lane; const u32x2* yA2 = (const u32x2*)(Y + (size_t)a1.w * DM) + lane;
            const u32x2* yB1 = (const u32x2*)(Y + (size_t)(has2 ? b1.z : a1.z) * DM) + lane; const u32x2* yB2 = (const u32x2*)(Y + (size_t)(has2 ? b1.w : a1.w) * DM) + lane;
            u32x2 pA1[4], pA2[4], pB1[4], pB2[4];
#pragma unroll
            for (int j = 0; j < 4; ++j) { pA1[j] = yA1[64 * j]; pA2[j] = yA2[64 * j]; pB1[j] = yB1[64 * j]; pB2[j] = yB2[64 * j]; }
#endif
#pragma unroll
            for (int j = 0; j < 4; ++j) { const u32x2 mm = mrA[64 * j]; vA[j] = xrA[64 * j] + (f32x4){bf_lo(mm.x), bf_hi(mm.x), bf_lo(mm.y), bf_hi(mm.y)};
                                          const u32x2 mn = mrB[64 * j]; vB[j] = xrB[64 * j] + (f32x4){bf_lo(mn.x), bf_hi(mn.x), bf_lo(mn.y), bf_hi(mn.y)}; }
#if EN_MOE
#pragma unroll
            for (int j = 0; j < 4; ++j) {
                vA[j].x += gA1 * bf_lo(pA1[j].x) + gA2 * bf_lo(pA2[j].x); vA[j].y += gA1 * bf_hi(pA1[j].x) + gA2 * bf_hi(pA2[j].x); vA[j].z += gA1 * bf_lo(pA1[j].y) + gA2 * bf_lo(pA2[j].y); vA[j].w += gA1 * bf_hi(pA1[j].y) + gA2 * bf_hi(pA2[j].y);
                vB[j].x += gB1 * bf_lo(pB1[j].x) + gB2 * bf_lo(pB2[j].x); vB[j].y += gB1 * bf_hi(pB1[j].x) + gB2 * bf_hi(pB2[j].x); vB[j].z += gB1 * bf_lo(pB1[j].y) + gB2 * bf_lo(pB2[j].y); vB[j].w += gB1 * bf_hi(pB1[j].y) + gB2 * bf_hi(pB2[j].y); }
#endif
            float sA = 0.f, sB = 0.f;
#pragma unroll
            for (int j = 0; j < 4; ++j) { sA += (vA[j].x * vA[j].x + vA[j].y * vA[j].y) + (vA[j].z * vA[j].z + vA[j].w * vA[j].w); sB += (vB[j].x * vB[j].x + vB[j].y * vB[j].y) + (vB[j].z * vB[j].z + vB[j].w * vB[j].w); }
#pragma unroll
            for (int o_ = 1; o_ < 64; o_ <<= 1) { sA += __shfl_xor(sA, o_); sB += __shfl_xor(sB, o_); }
            const float rA = 1.f / sqrtf(sA * (1.f / DM) + NORM_EPS), rB = 1.f / sqrtf(sB * (1.f / DM) + NORM_EPS);
            float pscale = 1.f, padd = 0.f;
            if (PROBE_A >= 1) { const unsigned long long* ts = (const unsigned long long*)(ctl + CW_TS); const float us = (float)(ts[PROBE_A] - ts[PROBE_A0]) * 0.01f; pscale = 1.f + sqrtf(us * PROBE_SCALE); }
            if (PROBE_B >= 1) { const unsigned long long* ts = (const unsigned long long*)(ctl + CW_TS); const float us = (float)(ts[PROBE_B] - ts[PROBE_B0]) * 0.01f; if (m == 0 && lane == 0) padd = us * 0.01f; }
            f32x4* oA = (f32x4*)(a_out + (size_t)m * DM) + lane; f32x4* oB = (f32x4*)(a_out + (size_t)mb * DM) + lane;
#pragma unroll
            for (int j = 0; j < 4; ++j) { f32x4 r = vA[j] * (rA * pscale) * wfv[j]; if (j == 0) r.x += padd; oA[64 * j] = r; }
            if (has2) {
#pragma unroll
                for (int j = 0; j < 4; ++j) oB[64 * j] = vB[j] * (rB * pscale) * wfv[j];
            }
        }
    }
}

extern "C" void kernel_launch(void* const* d_in, const int* in_sizes, int n_in, void* d_out, int out_size, void* d_ws, size_t ws_size, hipStream_t stream) {
    static int grid = 0;
    if (grid == 0) {
        if (n_in != 19 || in_sizes[0] != NTOK * DM || out_size != NTOK * DM || ws_size < WS_END) { fprintf(stderr, "kernel_launch: unexpected problem (n_in %d, ws %zu)\n", n_in, ws_size); grid = -1; return; }
        int dev = 0, cus = 0, per_cu = 0;
        (void)hipGetDevice(&dev); (void)hipDeviceGetAttribute(&cus, hipDeviceAttributeMultiprocessorCount, dev);
        (void)hipFuncSetAttribute((const void*)mega_fwd, hipFuncAttributeMaxDynamicSharedMemorySize, LDS_BYTES);
        (void)hipOccupancyMaxActiveBlocksPerMultiprocessor(&per_cu, (const void*)mega_fwd, NTHREADS, LDS_BYTES);
        (void)hipGetLastError();
        if (per_cu < 1) { fprintf(stderr, "kernel_launch: occupancy query says %d blocks per CU\n", per_cu); per_cu = 1; }
        grid = cus;
    }
    if (grid < 0) return;
    (void)hipMemsetAsync((char*)d_ws + WS_CTL, 0, CTL_ZERO_BYTES, stream);
    Args a{};
    a.x = (const float*)d_in[0]; a.norm_mix_w = (const float*)d_in[1]; a.w_in = (const float*)d_in[2]; a.b_gate = (const float*)d_in[3]; a.dec_f = (const float*)d_in[4]; a.dec_b = (const float*)d_in[5];
    a.gn_w = (const float*)d_in[6]; a.w_a = (const float*)d_in[7]; a.w_b = (const float*)d_in[8]; a.w_o = (const float*)d_in[9]; a.norm_moe_w = (const float*)d_in[10]; a.wg = (const float*)d_in[11];
    a.bg = (const float*)d_in[12]; a.we = (const float*)d_in[13]; a.be = (const float*)d_in[14]; a.w1 = (const float*)d_in[15]; a.w3 = (const float*)d_in[16]; a.w2 = (const float*)d_in[17];
    a.norm_final_w = (const float*)d_in[18]; a.out = (float*)d_out; a.ws = (unsigned char*)d_ws;
    void* args[] = {&a};
    hipError_t e = hipLaunchCooperativeKernel((const void*)mega_fwd, dim3(grid), dim3(NTHREADS), args, LDS_BYTES, stream);
    if (e != hipSuccess) fprintf(stderr, "cooperative launch failed: %s (grid %d)\n", hipGetErrorString(e), grid);
}
```

```cpp
#include <hip/hip_runtime.h>
#include <hip/hip_cooperative_groups.h>
#include <cstdio>
#include <cstdint>
namespace cg = cooperative_groups;

#ifndef EN_ATT
#define EN_ATT 1
#endif
#ifndef EN_RET
#define EN_RET 1
#endif
#ifndef EN_MOE
#define EN_MOE 1
#endif

#define LAS __attribute__((address_space(3)))
#define GAS __attribute__((address_space(1)))
typedef unsigned short bf16_t;
typedef short bf16x8 __attribute__((ext_vector_type(8)));
typedef short s16x4 __attribute__((ext_vector_type(4)));
typedef float f32x4 __attribute__((ext_vector_type(4)));
typedef float f32x2 __attribute__((ext_vector_type(2)));
typedef unsigned u32x4 __attribute__((ext_vector_type(4)));
typedef unsigned u32x2 __attribute__((ext_vector_type(2)));

constexpr int NTOK = 32768, DM = 1024, SEQ = 2048, NBATCH = 16;
constexpr int IN_W = 9728;
constexpr int NEXP = 64;
constexpr float NORM_EPS = 1e-6f;
constexpr float LOG2E = 1.4426950408889634f, LN2 = 0.6931471805599453f;
constexpr float W8_SCALE = 32.f, W8_DESCALE = 1.f / 32.f;
constexpr float QA_SCALE = 0.125f * LOG2E;
constexpr int NWAVES = 8, NTHREADS = 512;

constexpr size_t MiB = (size_t)1 << 20;
constexpr size_t WS_CTL = 0, CTL_ZERO_BYTES = 65536;
constexpr size_t WS_COS = 1 * MiB, WS_SIN = WS_COS + 262144, WS_WR = WS_COS + 524288;
constexpr size_t WS_ASG = 2 * MiB;
constexpr size_t WS_LSE = 3 * MiB;
constexpr size_t WS_RSTD = 3 * MiB;
constexpr size_t WS_SRSTD = 3 * MiB + 262144;
constexpr size_t WS_TOKL = 4 * MiB;
constexpr size_t WS_CNTT = 5 * MiB;
constexpr size_t WS_WIN = 6 * MiB;
constexpr size_t WS_WA = 25 * MiB;
constexpr size_t WS_WB = 26 * MiB;
constexpr size_t WS_WO = 28 * MiB;
constexpr size_t WS_XN = 30 * MiB;
constexpr size_t WS_MERGED = 30 * MiB;
constexpr size_t WS_QA = 94 * MiB, WS_KA = 190 * MiB, WS_VA = 286 * MiB;
constexpr size_t WS_OUTG = 382 * MiB;
constexpr size_t WS_GATE = 350 * MiB;
constexpr size_t WS_QR = 94 * MiB, WS_KR = 126 * MiB;
constexpr size_t WS_VR = 158 * MiB, WS_GR = 222 * MiB;
constexpr size_t WS_SST = 286 * MiB;
constexpr size_t WS_MIX = 417 * MiB;
constexpr size_t WS_W2 = 30 * MiB;
constexpr size_t WS_W13 = 94 * MiB;
constexpr size_t WS_HN = 224 * MiB;
constexpr size_t WS_XS = 288 * MiB;
constexpr size_t WS_HID = 288 * MiB;
constexpr size_t WS_Y = 94 * MiB;
constexpr size_t WS_XN8 = 510 * MiB;
constexpr size_t WS_WIN8 = 542 * MiB;
constexpr size_t WS_END = 547 * MiB;

constexpr int RING_BYTES = 131072;
constexpr int MISC_OFF = RING_BYTES;
constexpr int ROFF_OFF = MISC_OFF + 2048;
constexpr int ROFF_UNITS = 15;
constexpr int RSC_OFF = ROFF_OFF + ROFF_UNITS * 256 * 4;
constexpr int LDS_BYTES = 163840;

__device__ __forceinline__ unsigned cvt_pk_bf16(float lo, float hi) { unsigned r; asm volatile("v_cvt_pk_bf16_f32 %0, %1, %2" : "=v"(r) : "v"(lo), "v"(hi)); return r; }
__device__ __forceinline__ unsigned pk_fp8x4(float a, float b, float c, float d) { int w = 0; w = __builtin_amdgcn_cvt_pk_fp8_f32(a, b, w, false); w = __builtin_amdgcn_cvt_pk_fp8_f32(c, d, w, true); return (unsigned)w; }
__device__ __forceinline__ float bf_lo(unsigned w) { return __uint_as_float(w << 16); }
__device__ __forceinline__ float bf_hi(unsigned w) { return __uint_as_float(w & 0xffff0000u); }
__device__ __forceinline__ float fast_exp2(float x) { return __builtin_amdgcn_exp2f(x); }
__device__ __forceinline__ float fast_rcp(float x) { return __builtin_amdgcn_rcpf(x); }
__device__ __forceinline__ float sigmoidf_(float x) { return fast_rcp(1.f + fast_exp2(-x * LOG2E)); }
__device__ __forceinline__ float wave_sum(float v) {
#pragma unroll
    for (int o = 1; o < 64; o <<= 1) v += __shfl_xor(v, o);
    return v;
}
__device__ __forceinline__ s16x4 tr_read(const LAS char* p) {
    typedef short v4i16_t __attribute__((ext_vector_type(4)));
    return __builtin_bit_cast(s16x4, __builtin_amdgcn_ds_read_tr16_b64_v4i16((LAS v4i16_t*)p));
}
__device__ __forceinline__ bf16x8 cat4(s16x4 a, s16x4 b) { return (bf16x8){a[0], a[1], a[2], a[3], b[0], b[1], b[2], b[3]}; }
__device__ __forceinline__ int opaque_tid() { int t = threadIdx.x; asm volatile("" : "+v"(t)); return t; }
#define PHASE_IDS const int tid = opaque_tid(), lane = tid & 63, wave = __builtin_amdgcn_readfirstlane(tid >> 6); const int gw = vcu * NWAVES + wave; (void)gw; (void)lane
__device__ __forceinline__ void glds16(const void* gsrc, unsigned lds_dst) { unsigned keep;
    asm volatile("s_mov_b32 %0, m0\n\ts_mov_b32 m0, %2\n\ts_nop 0\n\tglobal_load_lds_dwordx4 %1, off\n\ts_mov_b32 m0, %0" : "=&s"(keep) : "v"(gsrc), "s"(lds_dst) : "memory"); }
#define LDS_WAIT() asm volatile("s_waitcnt lgkmcnt(0)" ::: "memory")
#define VM_WAIT() asm volatile("s_waitcnt vmcnt(0)" ::: "memory")

namespace pg8 {
constexpr int BM = 256, BK = 64, HALF = 128, HTB = HALF * BK * 2, STAGE_BYTES = 8 * HTB, NXCD = 8, WGM = 8;
__host__ __device__ __forceinline__ int lds_byte(int r, int c) { const int st = (r >> 4) * 2 + (c >> 5), rr = r & 15, cc = c & 31, ob = rr * 64 + cc * 2; return st * 1024 + (ob ^ (((ob >> 9) & 1) << 5)); }
__host__ __device__ __forceinline__ void stage_rc(int b, int& R, int& C) { const int st = b / 1024, sb = b % 1024, swz = sb ^ (((sb >> 9) & 1) << 5); R = (st >> 1) * 16 + swz / 64; C = (st & 1) * 32 + (swz % 64) / 2; }
__host__ __device__ __forceinline__ int g8(int r) { return ((r >> 1) & 1) | (((r >> 3) & 1) << 2); }
__host__ __device__ __forceinline__ int g16(int r) { return (r >> 1) & 7; }
__host__ __device__ __forceinline__ int perm32(int rho) { const int n = rho >> 4, i = rho & 15; return 8 * (i >> 2) + 4 * n + (i & 3); }

struct Unit { int pm, pn; const char* a; const char* b; int e, row0, nrows; };

struct StaticOrder {
    const char* A; const char* Bt; int K;
    int nM, nN, nwg, G, c;
    __device__ void init(const void* A_, const void* Bt_, int M, int N, int K_, int G_, int c_) { A = (const char*)A_; Bt = (const char*)Bt_; K = K_; nM = M / BM; nN = N / BM; nwg = nM * nN; G = G_; c = c_; }
    __device__ bool next(int i, Unit& u) const {
        const long L = (long)i * G + c; if (L >= nwg) return false;
        int wgid = (int)L; { const int q = nwg / NXCD, r = nwg % NXCD, xcd = wgid % NXCD, off = wgid / NXCD; wgid = (xcd < r ? xcd * (q + 1) : r * (q + 1) + (xcd - r) * q) + off; }
        const int nig = WGM * nN, gid = wgid / nig, fm = gid * WGM, gsz = (nM - fm) < WGM ? (nM - fm) : WGM;
        u.pm = fm + ((wgid % nig) % gsz); u.pn = (wgid % nig) / gsz;
        u.a = A + (size_t)u.pm * BM * K * 2; u.b = Bt + (size_t)u.pn * BM * K * 2; u.e = 0; u.row0 = u.pm * BM; u.nrows = BM; return true;
    }
};
struct GroupedOrder {
    const char* A; const char* Bt; int K; int G, c;
    const LAS int* cnt; const LAS int* tstart; const LAS int* sstart;
    __device__ bool next(int i, Unit& u) const {
        const int total = tstart[NEXP] * 4; const long L = (long)i * G + c; if (L >= total) return false;
        int wg = (int)L; { const int q = total / NXCD, r = total % NXCD, xcd = wg % NXCD, off = wg / NXCD; wg = (xcd < r ? xcd * (q + 1) : r * (q + 1) + (xcd - r) * q) + off; }
        const int mtg = wg >> 2; u.pn = wg & 3;
        int e = 0; while (e < NEXP - 1 && tstart[e + 1] <= mtg) ++e;
        u.e = e; u.pm = mtg - tstart[e]; u.row0 = sstart[e] + u.pm * BM; int nr = cnt[e] - u.pm * BM; u.nrows = nr < BM ? nr : BM;
        u.a = A + (size_t)u.row0 * K * 2; u.b = Bt + ((size_t)e * 1024 + (size_t)u.pn * BM) * K * 2; return true;
    }
};

struct ExpertOrder {
    const char* A; const char* Bt; int K; int e, pn, cnt, sstart, u0, nb;
    __device__ bool next(int i, Unit& u) const {
        if (i >= nb) return false;
        const int m = u0 + i;
        u.pm = m; u.pn = pn; u.e = e; u.row0 = sstart + m * BM; const int nr = cnt - m * BM; u.nrows = nr < BM ? nr : BM;
        u.a = A + (size_t)u.row0 * K * 2; u.b = Bt + ((size_t)e * 1024 + (size_t)pn * BM) * K * 2; return true;
    }
};

template <class Epi, class Sched, bool ALIGN_EPI, bool SP2, bool GATHER = false, bool FP8 = false>
__device__ __forceinline__ void gemm_phase(LAS unsigned char* lds, const int K, const Sched& S, const Epi& E, const LAS int* roff = nullptr, const char* gA = nullptr) {
    const int tid = opaque_tid(), wid = __builtin_amdgcn_readfirstlane(tid >> 6), lane = tid & 63, wr = wid >> 2, wc = wid & 3, fr = lane & 15, fq = lane >> 4;
    const int nt = K / BK;
    unsigned voffA[2], voffB[2];
#pragma unroll
    for (int i = 0; i < 2; ++i) { const int R = (tid >> 3) + 64 * i, C = 8 * ((tid & 7) ^ (FP8 ? g8(R) : g16(R)));
        const int Rb = Epi::PERM ? ((R & ~31) + perm32(R & 31)) : R;
        voffA[i] = (unsigned)(R * K + C) * 2u; voffB[i] = (unsigned)(Rb * K + C) * 2u; }
    const size_t kstep = (size_t)(BK * 2);
    const size_t hstep = (size_t)HALF * K * 2;
    unsigned vC[2][2], vN[2][2];
#define PG8_GLOAD(dst, ui_) do { _Pragma("unroll") for (int h_ = 0; h_ < 2; ++h_) _Pragma("unroll") for (int i_ = 0; i_ < 2; ++i_) { const int R_ = (tid >> 3) + 64 * i_, C_ = 8 * ((tid & 7) ^ (FP8 ? g8(R_) : g16(R_))); \
        dst[h_][i_] = (unsigned)roff[(ui_) * BM + h_ * HALF + R_] + (unsigned)(C_ * 2); } } while (0)
    const unsigned ldsw = (unsigned)wid * 1024u;
    const int aoff = (wr * 64 + fr) * 128 + (FP8 ? (((2 * fq) ^ g8(fr)) << 4) : ((fq ^ g16(fr)) << 4));
    const int boff = (wc * 32 + fr) * 128 + (FP8 ? (((2 * fq) ^ g8(fr)) << 4) : ((fq ^ g16(fr)) << 4));
    const int aoff2 = aoff ^ (FP8 ? 16 : 64), boff2 = boff ^ (FP8 ? 16 : 64);
    typedef int v8i_ __attribute__((ext_vector_type(8))); typedef int v4i_ __attribute__((ext_vector_type(4)));
#define PG8_SA(b, h) (((b) * 2 + (h)) * HTB)
#define PG8_SB(b, h) ((4 + (b) * 2 + (h)) * HTB)
#define PG8_STAGE(bufoff, gbase, voff) do { _Pragma("unroll") for (int _i = 0; _i < 2; ++_i) \
        __builtin_amdgcn_global_load_lds((const unsigned*)((const char*)(gbase) + (voff)[_i]), (LAS unsigned*)(lds + (bufoff) + ldsw + _i * 8192), 16, 0, 0); } while (0)
#define PG8_LD8_(p_, q_) __builtin_shufflevector(*(const LAS v4i_*)(p_), *(const LAS v4i_*)(q_), 0, 1, 2, 3, 4, 5, 6, 7)
#define PG8_LDA(dst, b, h) do { if constexpr (FP8) { _Pragma("unroll") for (int m = 0; m < 4; ++m) dst##8[m] = PG8_LD8_(lds + PG8_SA(b, h) + aoff + m * 2048, lds + PG8_SA(b, h) + aoff2 + m * 2048); } \
        else { _Pragma("unroll") for (int m = 0; m < 4; ++m) _Pragma("unroll") for (int k = 0; k < 2; ++k) dst[m][k] = *(const LAS bf16x8*)(lds + PG8_SA(b, h) + (k ? aoff2 : aoff) + m * 2048); } } while (0)
#define PG8_LDB(dst, b, h) do { if constexpr (FP8) { _Pragma("unroll") for (int n = 0; n < 2; ++n) dst##8[n] = PG8_LD8_(lds + PG8_SB(b, h) + boff + n * 2048, lds + PG8_SB(b, h) + boff2 + n * 2048); } \
        else { _Pragma("unroll") for (int n = 0; n < 2; ++n) _Pragma("unroll") for (int k = 0; k < 2; ++k) dst[n][k] = *(const LAS bf16x8*)(lds + PG8_SB(b, h) + (k ? boff2 : boff) + n * 2048); } } while (0)
#define PG8_MMA(ai, bj, At, Bt) do { __builtin_amdgcn_s_setprio(1); _Pragma("unroll") for (int m = 0; m < 4; ++m) _Pragma("unroll") for (int n = 0; n < 2; ++n) { \
        if constexpr (FP8) asm volatile("v_mfma_scale_f32_16x16x128_f8f6f4 %0, %1, %2, %0, %3, %3 op_sel_hi:[0,0,0]" : "+v"(acc[ai][bj][m][n]) : "v"(Bt##8[n]), "v"(At##8[m]), "v"(mxscale)); \
        else { _Pragma("unroll") for (int k = 0; k < 2; ++k) acc[ai][bj][m][n] = __builtin_amdgcn_mfma_f32_16x16x32_bf16(Bt[n][k], At[m][k], acc[ai][bj][m][n], 0, 0, 0); } } \
        __builtin_amdgcn_s_setprio(0); } while (0)
#define PG8_WAIT_V(n) asm volatile("s_waitcnt vmcnt(" #n ")" ::: "memory")
#define PG8_WAIT_L(n) asm volatile("s_waitcnt lgkmcnt(" #n ")" ::: "memory")
#define PG8_BAR __builtin_amdgcn_s_barrier()
#define PG8_SCHED __builtin_amdgcn_sched_barrier(0)
    Unit cur, nxt; int ui = 0;
    if (!S.next(0, cur)) return;
    f32x4 acc[2][2][4][2];
#pragma unroll
    for (int a = 0; a < 2; ++a)
#pragma unroll
        for (int b = 0; b < 2; ++b)
#pragma unroll
            for (int m = 0; m < 4; ++m)
#pragma unroll
                for (int n = 0; n < 2; ++n) acc[a][b][m][n] = (f32x4){0.f, 0.f, 0.f, 0.f};
    const int mxscale = 0x7f7f7f7f;
    bf16x8 At[4][2], B0[2][2], B1[2][2]; v8i_ At8[4], B08[2], B18[2];
    const char* cA = GATHER ? gA : cur.a; const char* cB = cur.b;
    if constexpr (GATHER) { PG8_GLOAD(vC, 0); PG8_WAIT_L(0); }
    if constexpr (SP2) {
        PG8_STAGE(PG8_SB(0, 0), cB, voffB); PG8_STAGE(PG8_SB(0, 1), cB + hstep, voffB);
        if constexpr (GATHER) { PG8_STAGE(PG8_SA(0, 0), cA, vC[0]); PG8_STAGE(PG8_SA(0, 1), cA, vC[1]); } else { PG8_STAGE(PG8_SA(0, 0), cA, voffA); PG8_STAGE(PG8_SA(0, 1), cA + hstep, voffA); }
        if (wr == 1) PG8_BAR;
        PG8_WAIT_V(2); PG8_BAR;
        PG8_STAGE(PG8_SB(1, 0), cB + kstep, voffB); if constexpr (GATHER) PG8_STAGE(PG8_SA(1, 0), cA + kstep, vC[0]); else PG8_STAGE(PG8_SA(1, 0), cA + kstep, voffA); PG8_STAGE(PG8_SB(1, 1), cB + hstep + kstep, voffB);
        PG8_WAIT_V(6); PG8_BAR;
    } else {
        PG8_STAGE(PG8_SB(0, 0), cB, voffB); PG8_STAGE(PG8_SA(0, 0), cA, voffA); PG8_STAGE(PG8_SB(0, 1), cB + hstep, voffB); PG8_STAGE(PG8_SA(0, 1), cA + hstep, voffA);
        if (wr == 1) PG8_BAR;
        PG8_WAIT_V(4); PG8_BAR;
        PG8_STAGE(PG8_SB(1, 0), cB + kstep, voffB); PG8_STAGE(PG8_SA(1, 0), cA + kstep, voffA); PG8_STAGE(PG8_SB(1, 1), cB + hstep + kstep, voffB);
        PG8_WAIT_V(6); PG8_BAR;
    }
    for (;;) {
        const bool has_next = S.next(ui + 1, nxt);
        const char* nA = GATHER ? cA : (has_next ? nxt.a : cA); const char* nB = has_next ? nxt.b : cB;
        if constexpr (GATHER) { if (has_next) { PG8_GLOAD(vN, ui + 1); } else { vN[0][0] = vC[0][0]; vN[0][1] = vC[0][1]; vN[1][0] = vC[1][0]; vN[1][1] = vC[1][1]; } }
#pragma unroll 1
        for (int t = 0; t < nt; t += 2) {
            const bool last = (t == nt - 2);
            const char* a1 = cA + (size_t)(t + 1) * kstep;
            const char* a2 = last ? nA : cA + (size_t)(t + 2) * kstep; const char* b2 = last ? nB : cB + (size_t)(t + 2) * kstep;
            const char* a3 = a2 + kstep; const char* b3 = b2 + kstep;
            if constexpr (Epi::MID_T >= 0) { if (t == Epi::MID_T) E.mid(acc, cur, wr, wc, fr, fq); }
            if constexpr (SP2) {
            if constexpr (GATHER) {
            unsigned g0[2] = {last ? vN[0][0] : vC[0][0], last ? vN[0][1] : vC[0][1]}, g1[2] = {last ? vN[1][0] : vC[1][0], last ? vN[1][1] : vC[1][1]};
            PG8_LDB(B0, 0, 0); PG8_LDB(B1, 0, 1); PG8_SCHED; PG8_LDA(At, 0, 0); PG8_STAGE(PG8_SA(1, 1), a1, vC[1]);
            PG8_WAIT_V(8); PG8_WAIT_L(0); PG8_BAR; PG8_MMA(0, 0, At, B0); PG8_MMA(0, 1, At, B1); PG8_BAR; PG8_SCHED;
            PG8_LDA(At, 0, 1); PG8_STAGE(PG8_SB(0, 0), b2, voffB); PG8_STAGE(PG8_SB(0, 1), b2 + hstep, voffB); PG8_STAGE(PG8_SA(0, 0), a2, g0);
            PG8_WAIT_V(8); PG8_WAIT_L(0); PG8_BAR; PG8_MMA(1, 0, At, B0); PG8_MMA(1, 1, At, B1); PG8_BAR; PG8_SCHED;
            PG8_LDB(B0, 1, 0); PG8_LDB(B1, 1, 1); PG8_SCHED; PG8_LDA(At, 1, 0); PG8_STAGE(PG8_SA(0, 1), a2, g1);
            PG8_WAIT_V(8); PG8_WAIT_L(0); PG8_BAR; PG8_MMA(0, 0, At, B0); PG8_MMA(0, 1, At, B1); PG8_BAR; PG8_SCHED;
            PG8_LDA(At, 1, 1); PG8_STAGE(PG8_SB(1, 0), b3, voffB); PG8_STAGE(PG8_SB(1, 1), b3 + hstep, voffB); PG8_STAGE(PG8_SA(1, 0), a3, g0);
            PG8_WAIT_V(8); PG8_WAIT_L(0); PG8_BAR; PG8_MMA(1, 0, At, B0); PG8_MMA(1, 1, At, B1); PG8_BAR; PG8_SCHED;
            } else {
            PG8_LDB(B0, 0, 0); PG8_LDB(B1, 0, 1); PG8_SCHED; PG8_LDA(At, 0, 0); PG8_STAGE(PG8_SA(1, 1), a1 + hstep, voffA);
            PG8_WAIT_V(8); PG8_WAIT_L(0); PG8_BAR; PG8_MMA(0, 0, At, B0); PG8_MMA(0, 1, At, B1); PG8_BAR; PG8_SCHED;
            PG8_LDA(At, 0, 1); PG8_STAGE(PG8_SB(0, 0), b2, voffB); PG8_STAGE(PG8_SB(0, 1), b2 + hstep, voffB); PG8_STAGE(PG8_SA(0, 0), a2, voffA);
            PG8_WAIT_V(8); PG8_WAIT_L(0); PG8_BAR; PG8_MMA(1, 0, At, B0); PG8_MMA(1, 1, At, B1); PG8_BAR; PG8_SCHED;
            PG8_LDB(B0, 1, 0); PG8_LDB(B1, 1, 1); PG8_SCHED; PG8_LDA(At, 1, 0); PG8_STAGE(PG8_SA(0, 1), a2 + hstep, voffA);
            PG8_WAIT_V(8); PG8_WAIT_L(0); PG8_BAR; PG8_MMA(0, 0, At, B0); PG8_MMA(0, 1, At, B1); PG8_BAR; PG8_SCHED;
            PG8_LDA(At, 1, 1); PG8_STAGE(PG8_SB(1, 0), b3, voffB); PG8_STAGE(PG8_SB(1, 1), b3 + hstep, voffB); PG8_STAGE(PG8_SA(1, 0), a3, voffA);
            PG8_WAIT_V(8); PG8_WAIT_L(0); PG8_BAR; PG8_MMA(1, 0, At, B0); PG8_MMA(1, 1, At, B1); PG8_BAR; PG8_SCHED;
            }
            } else {
            PG8_LDB(B0, 0, 0); PG8_SCHED; PG8_LDA(At, 0, 0); PG8_STAGE(PG8_SA(1, 1), a1 + hstep, voffA);
            PG8_WAIT_L(8); PG8_BAR; PG8_WAIT_L(0); PG8_MMA(0, 0, At, B0); PG8_BAR; PG8_SCHED;
            PG8_LDB(B1, 0, 1); PG8_STAGE(PG8_SB(0, 0), b2, voffB);
            PG8_BAR; PG8_WAIT_L(0); PG8_MMA(0, 1, At, B1); PG8_BAR;
            PG8_LDA(At, 0, 1); PG8_STAGE(PG8_SA(0, 0), a2, voffA);
            PG8_BAR; PG8_WAIT_L(0); PG8_MMA(1, 0, At, B0); PG8_BAR; PG8_SCHED;
            PG8_STAGE(PG8_SB(0, 1), b2 + hstep, voffB);
            PG8_WAIT_V(6); PG8_BAR; PG8_MMA(1, 1, At, B1); PG8_BAR;
            PG8_LDB(B0, 1, 0); PG8_SCHED; PG8_LDA(At, 1, 0); PG8_STAGE(PG8_SA(0, 1), a2 + hstep, voffA);
            PG8_WAIT_L(8); PG8_BAR; PG8_WAIT_L(0); PG8_MMA(0, 0, At, B0); PG8_BAR; PG8_SCHED;
            PG8_LDB(B1, 1, 1); PG8_STAGE(PG8_SB(1, 0), b3, voffB);
            PG8_BAR; PG8_WAIT_L(0); PG8_MMA(0, 1, At, B1); PG8_BAR;
            PG8_LDA(At, 1, 1); PG8_STAGE(PG8_SA(1, 0), a3, voffA);
            PG8_BAR; PG8_WAIT_L(0); PG8_MMA(1, 0, At, B0); PG8_BAR; PG8_SCHED;
            PG8_STAGE(PG8_SB(1, 1), b3 + hstep, voffB);
            PG8_WAIT_V(6); PG8_BAR; PG8_MMA(1, 1, At, B1); PG8_BAR;
            }
        }
        if constexpr (ALIGN_EPI) { if (wr == 0) PG8_BAR; }
        if constexpr (FP8) asm volatile("s_nop 15\n\ts_nop 15" ::: "memory");
        E(acc, cur, wr, wc, fr, fq);
        if (!has_next) break;
#pragma unroll
        for (int a = 0; a < 2; ++a)
#pragma unroll
            for (int b = 0; b < 2; ++b)
#pragma unroll
                for (int m = 0; m < 4; ++m)
#pragma unroll
                    for (int n = 0; n < 2; ++n) acc[a][b][m][n] = (f32x4){0.f, 0.f, 0.f, 0.f};
        cur = nxt; cA = nA; cB = nB; ++ui;
        if constexpr (GATHER) { vC[0][0] = vN[0][0]; vC[0][1] = vN[0][1]; vC[1][0] = vN[1][0]; vC[1][1] = vN[1][1]; }
        if constexpr (ALIGN_EPI) { if (wr == 1) PG8_BAR; }
    }
    PG8_WAIT_V(0);
    if constexpr (!ALIGN_EPI) { if (wr == 0) PG8_BAR; }
    PG8_BAR;
#undef PG8_GLOAD
#undef PG8_SA
#undef PG8_SB
#undef PG8_STAGE
#undef PG8_LDA
#undef PG8_LD8_
#undef PG8_LDB
#undef PG8_MMA
#undef PG8_WAIT_V
#undef PG8_WAIT_L
#undef PG8_BAR
#undef PG8_SCHED
}
}

struct RotF { float f[4]; };
__device__ __forceinline__ RotF rot_freqs(int q) { RotF r;
#pragma unroll
    for (int i = 0; i < 4; ++i) r.f[i] = fast_exp2(-(float)(2 * (4 * q + i)) * (13.287712379549449f / 64.f)) * 0.15915494309189535f;
    return r; }
__device__ __forceinline__ void rot_cs(const RotF& rf, int pos, f32x4& c4, f32x4& s4) {
    const float p = (float)pos;
#pragma unroll
    for (int i = 0; i < 4; ++i) { const float r = __builtin_amdgcn_fractf(p * rf.f[i]); c4[i] = __builtin_amdgcn_cosf(r); s4[i] = __builtin_amdgcn_sinf(r); }
}

typedef f32x4 acc_t[2][2][4][2];

struct EpiProj {
    static constexpr bool PERM = true; static constexpr int MID_T = -1;
    unsigned char* ws; bf16_t* gate; const float* bias; int pn_off; float descale;
    __device__ __forceinline__ void operator()(const acc_t& acc, const pg8::Unit& u, int wr, int wc, int fr, int fq) const {
        asm volatile("" : "+v"(fr), "+v"(fq));
        const int pn = u.pn + pn_off;
        const int row0 = u.pm * 256 + wr * 64 + fr;
        int mode, ld, colt; bf16_t* base; float sc = descale;
        if (pn < 6) { mode = 0; base = (bf16_t*)(ws + WS_QA); ld = 1536; colt = pn * 256; sc = QA_SCALE * descale; }
        else if (pn < 12) { mode = 0; base = (bf16_t*)(ws + WS_KA); ld = 1536; colt = (pn - 6) * 256; }
        else if (pn < 18) { mode = 1; base = (bf16_t*)(ws + WS_VA); ld = 1536; colt = (pn - 12) * 256; }
        else if (pn < 20) { mode = 0; base = (bf16_t*)(ws + WS_QR); ld = 512; colt = (pn - 18) * 256; }
        else if (pn < 22) { mode = 0; base = (bf16_t*)(ws + WS_KR); ld = 512; colt = (pn - 20) * 256; sc = 0.125f * descale; }
        else if (pn < 26) { mode = 1; base = (bf16_t*)(ws + WS_VR); ld = 1024; colt = (pn - 22) * 256; }
        else if (pn < 30) { mode = 2; base = (bf16_t*)(ws + WS_GR); ld = 1024; colt = (pn - 26) * 256; }
        else { mode = 3; base = (bf16_t*)(ws + WS_GATE); ld = 2048; colt = (pn - 30) * 256; }
        if (mode == 0) {
            const int q = 4 * (wc & 1) + fq; const RotF rf = rot_freqs(q);
#pragma unroll
            for (int ai = 0; ai < 2; ++ai)
#pragma unroll
                for (int m = 0; m < 4; ++m) {
                    const int row = row0 + ai * 128 + m * 16; const int pos = row & (SEQ - 1);
                    f32x4 c4, s4; rot_cs(rf, pos, c4, s4);
#pragma unroll
                    for (int bj = 0; bj < 2; ++bj) {
                        const f32x4 t1 = acc[ai][bj][m][0], t2 = acc[ai][bj][m][1];
                        const f32x4 o1 = (t1 * c4 - t2 * s4) * sc, o2 = (t1 * s4 + t2 * c4) * sc;
                        bf16_t* p = base + (size_t)row * ld + colt + 128 * bj + 64 * (wc >> 1) + 8 * q;
                        u32x4 w; w.x = cvt_pk_bf16(o1[0], o1[1]); w.y = cvt_pk_bf16(o1[2], o1[3]); w.z = cvt_pk_bf16(o2[0], o2[1]); w.w = cvt_pk_bf16(o2[2], o2[3]);
                        *(u32x4*)p = w;
                    }
                }
        } else {
            const int col0 = colt + wc * 32 + 8 * fq;
            if (mode == 1) {
#pragma unroll
                for (int ai = 0; ai < 2; ++ai)
#pragma unroll
                    for (int m = 0; m < 4; ++m) {
                        bf16_t* rowp = base + (size_t)(row0 + ai * 128 + m * 16) * ld + col0;
#pragma unroll
                        for (int bj = 0; bj < 2; ++bj) { const f32x4 v0 = acc[ai][bj][m][0] * sc, v1 = acc[ai][bj][m][1] * sc;
                            u32x4 w; w.x = cvt_pk_bf16(v0[0], v0[1]); w.y = cvt_pk_bf16(v0[2], v0[3]); w.z = cvt_pk_bf16(v1[0], v1[1]); w.w = cvt_pk_bf16(v1[2], v1[3]);
                            *(u32x4*)(rowp + bj * 128) = w; }
                    }
            } else if (mode == 2) {
                const float ks = -sc * LOG2E;
#pragma unroll
                for (int ai = 0; ai < 2; ++ai)
#pragma unroll
                    for (int m = 0; m < 4; ++m) {
                        bf16_t* rowp = base + (size_t)(row0 + ai * 128 + m * 16) * ld + col0;
#pragma unroll
                        for (int bj = 0; bj < 2; ++bj) {
                            const f32x4 a0 = acc[ai][bj][m][0], a1 = acc[ai][bj][m][1];
                            f32x4 e0 = a0 * ks, e1 = a1 * ks;
#pragma unroll
                            for (int i = 0; i < 4; ++i) { e0[i] = fast_exp2(e0[i]); e1[i] = fast_exp2(e1[i]); }
                            e0 = e0 + 1.f; e1 = e1 + 1.f;
#pragma unroll
                            for (int i = 0; i < 4; ++i) { e0[i] = fast_rcp(e0[i]); e1[i] = fast_rcp(e1[i]); }
                            const f32x4 v0 = (a0 * sc) * e0, v1 = (a1 * sc) * e1;
                            u32x4 w; w.x = cvt_pk_bf16(v0[0], v0[1]); w.y = cvt_pk_bf16(v0[2], v0[3]); w.z = cvt_pk_bf16(v1[0], v1[1]); w.w = cvt_pk_bf16(v1[2], v1[3]);
                            *(u32x4*)(rowp + bj * 128) = w; }
                    }
            } else {
                const float ks = -sc * LOG2E;
                f32x4 nb[2][2];
#pragma unroll
                for (int bj = 0; bj < 2; ++bj)
#pragma unroll
                    for (int n = 0; n < 2; ++n) nb[bj][n] = *(const f32x4*)(bias + col0 + bj * 128 + 4 * n) * (-LOG2E);
#pragma unroll
                for (int ai = 0; ai < 2; ++ai)
#pragma unroll
                    for (int m = 0; m < 4; ++m) {
                        bf16_t* rowp = base + (size_t)(row0 + ai * 128 + m * 16) * ld + col0;
#pragma unroll
                        for (int bj = 0; bj < 2; ++bj) {
                            f32x4 e0 = acc[ai][bj][m][0] * ks + nb[bj][0], e1 = acc[ai][bj][m][1] * ks + nb[bj][1];
#pragma unroll
                            for (int i = 0; i < 4; ++i) { e0[i] = fast_exp2(e0[i]); e1[i] = fast_exp2(e1[i]); }
                            e0 = e0 + 1.f; e1 = e1 + 1.f;
#pragma unroll
                            for (int i = 0; i < 4; ++i) { e0[i] = fast_rcp(e0[i]); e1[i] = fast_rcp(e1[i]); }
                            u32x4 w; w.x = cvt_pk_bf16(e0[0], e0[1]); w.y = cvt_pk_bf16(e0[2], e0[3]); w.z = cvt_pk_bf16(e1[0], e1[1]); w.w = cvt_pk_bf16(e1[2], e1[3]);
                            *(u32x4*)(rowp + bj * 128) = w; }
                    }
            }
        }
    }
};

struct EpiProjAtt {
    static constexpr bool PERM = true; static constexpr int MID_T = -1;
    unsigned char* ws; float descale;
    __device__ __forceinline__ void operator()(const acc_t& acc, const pg8::Unit& u, int wr, int wc, int, int) const {
        const int lane_ = opaque_tid() & 63, fr = lane_ & 15, fq = lane_ >> 4;
        const int pn = u.pn, row0 = u.pm * 256 + wr * 64 + fr;
        bf16_t* base = (bf16_t*)(ws + (pn < 6 ? WS_QA : (pn < 12 ? WS_KA : WS_VA))); const int pt = (pn < 6 ? pn : (pn < 12 ? pn - 6 : pn - 12));
        const float sc = (pn < 6 ? QA_SCALE : 1.f) * descale;
        const int grp = pt >> 1;
        if (pn < 12) {
            const int q = 4 * (wc & 1) + fq; const RotF rf = rot_freqs(q);
#pragma unroll
            for (int ai = 0; ai < 2; ++ai)
#pragma unroll
                for (int m = 0; m < 4; ++m) {
                    const int row = row0 + ai * 128 + m * 16; const int pos = row & (SEQ - 1), b = row >> 11;
                    f32x4 c4, s4; rot_cs(rf, pos, c4, s4);
#pragma unroll
                    for (int bj = 0; bj < 2; ++bj) {
                        const f32x4 t1 = acc[ai][bj][m][0], t2 = acc[ai][bj][m][1];
                        const f32x4 o1 = (t1 * c4 - t2 * s4) * sc, o2 = (t1 * s4 + t2 * c4) * sc;
                        const int hd = 4 * (pt & 1) + 2 * bj + (wc >> 1);
                        bf16_t* p = base + ((size_t)((b * 3 + grp) * 8 + hd) * SEQ + pos) * 64 + 8 * q;
                        u32x4 w; w.x = cvt_pk_bf16(o1[0], o1[1]); w.y = cvt_pk_bf16(o1[2], o1[3]); w.z = cvt_pk_bf16(o2[0], o2[1]); w.w = cvt_pk_bf16(o2[2], o2[3]);
                        *(u32x4*)p = w;
                    }
                }
        } else {
#pragma unroll
            for (int ai = 0; ai < 2; ++ai)
#pragma unroll
                for (int m = 0; m < 4; ++m) {
                    const int row = row0 + ai * 128 + m * 16; const int pos = row & (SEQ - 1), b = row >> 11;
#pragma unroll
                    for (int bj = 0; bj < 2; ++bj) {
                        const f32x4 v0 = acc[ai][bj][m][0] * sc, v1 = acc[ai][bj][m][1] * sc;
                        const int hd = 4 * (pt & 1) + 2 * bj + (wc >> 1);
                        bf16_t* p = base + ((size_t)((b * 3 + grp) * 8 + hd) * SEQ + pos) * 64 + 32 * (wc & 1) + 8 * fq;
                        u32x4 w; w.x = cvt_pk_bf16(v0[0], v0[1]); w.y = cvt_pk_bf16(v0[2], v0[3]); w.z = cvt_pk_bf16(v1[0], v1[1]); w.w = cvt_pk_bf16(v1[2], v1[3]);
                        *(u32x4*)p = w;
                    }
                }
        }
    }
};
struct EpiMerge {
    static constexpr bool PERM = true; static constexpr int MID_T = 8;
    bf16_t* out; const bf16_t* gate;
    __device__ __forceinline__ void mid(acc_t& acc, const pg8::Unit& u, int wr, int wc, int fr, int fq) const {
        int row0 = u.pm * 256 + wr * 64 + fr, col0 = u.pn * 256 + wc * 32 + 8 * fq;
        asm volatile("" : "+v"(row0), "+v"(col0));
#pragma unroll
        for (int ai = 0; ai < 2; ++ai) {
            u32x4 ga[4][2], gb[4][2];
#pragma unroll
            for (int m = 0; m < 4; ++m)
#pragma unroll
                for (int bj = 0; bj < 2; ++bj) { const bf16_t* gp = gate + (size_t)(row0 + ai * 128 + m * 16) * 2048 + col0 + bj * 128; ga[m][bj] = *(const u32x4*)gp; gb[m][bj] = *(const u32x4*)(gp + 1024); }
            asm volatile("" ::: "memory");
#pragma unroll
            for (int m = 0; m < 4; ++m)
#pragma unroll
                for (int bj = 0; bj < 2; ++bj) { const u32x4 a = ga[m][bj], b = gb[m][bj];
                    acc[ai][bj][m][0][0] *= bf_lo(a.x) * fast_rcp(bf_lo(b.x)); acc[ai][bj][m][0][1] *= bf_hi(a.x) * fast_rcp(bf_hi(b.x));
                    acc[ai][bj][m][0][2] *= bf_lo(a.y) * fast_rcp(bf_lo(b.y)); acc[ai][bj][m][0][3] *= bf_hi(a.y) * fast_rcp(bf_hi(b.y));
                    acc[ai][bj][m][1][0] *= bf_lo(a.z) * fast_rcp(bf_lo(b.z)); acc[ai][bj][m][1][1] *= bf_hi(a.z) * fast_rcp(bf_hi(b.z));
                    acc[ai][bj][m][1][2] *= bf_lo(a.w) * fast_rcp(bf_lo(b.w)); acc[ai][bj][m][1][3] *= bf_hi(a.w) * fast_rcp(bf_hi(b.w)); }
            asm volatile("" ::: "memory");
        }
    }
    __device__ __forceinline__ void operator()(const acc_t& acc, const pg8::Unit& u, int wr, int wc, int fr, int fq) const {
        const int row0 = u.pm * 256 + wr * 64 + fr, col0 = u.pn * 256 + wc * 32 + 8 * fq;
        u32x4 g[2][4][2];
#pragma unroll
        for (int ai = 0; ai < 2; ++ai)
#pragma unroll
            for (int m = 0; m < 4; ++m)
#pragma unroll
                for (int bj = 0; bj < 2; ++bj) g[ai][m][bj] = *(const u32x4*)(gate + (size_t)(row0 + ai * 128 + m * 16) * 2048 + 1024 + col0 + bj * 128);
        asm volatile("" ::: "memory");
#pragma unroll
        for (int ai = 0; ai < 2; ++ai)
#pragma unroll
            for (int m = 0; m < 4; ++m) {
                const size_t row = (size_t)(row0 + ai * 128 + m * 16);
#pragma unroll
                for (int bj = 0; bj < 2; ++bj) {
                    const u32x4 gg = g[ai][m][bj];
                    f32x4 v0 = acc[ai][bj][m][0], v1 = acc[ai][bj][m][1];
                    v0[0] *= bf_lo(gg.x); v0[1] *= bf_hi(gg.x); v0[2] *= bf_lo(gg.y); v0[3] *= bf_hi(gg.y);
                    v1[0] *= bf_lo(gg.z); v1[1] *= bf_hi(gg.z); v1[2] *= bf_lo(gg.w); v1[3] *= bf_hi(gg.w);
                    u32x4 w; w.x = cvt_pk_bf16(v0[0], v0[1]); w.y = cvt_pk_bf16(v0[2], v0[3]); w.z = cvt_pk_bf16(v1[0], v1[1]); w.w = cvt_pk_bf16(v1[2], v1[3]);
                    *(u32x4*)(out + row * 1024 + col0 + bj * 128) = w;
                }
            }
    }
};
struct EpiPlain {
    static constexpr bool PERM = true; static constexpr int MID_T = -1;
    bf16_t* O;
    __device__ __forceinline__ void operator()(const acc_t& acc, const pg8::Unit& u, int wr, int wc, int fr, int fq) const {
        const int row0 = u.pm * 256 + wr * 64 + fr, col0 = u.pn * 256 + wc * 32 + 8 * fq;
#pragma unroll
        for (int ai = 0; ai < 2; ++ai)
#pragma unroll
            for (int m = 0; m < 4; ++m) {
                bf16_t* rowp = O + (size_t)(row0 + ai * 128 + m * 16) * 1024 + col0;
#pragma unroll
                for (int bj = 0; bj < 2; ++bj) { const f32x4 v0 = acc[ai][bj][m][0], v1 = acc[ai][bj][m][1];
                    u32x4 w; w.x = cvt_pk_bf16(v0[0], v0[1]); w.y = cvt_pk_bf16(v0[2], v0[3]); w.z = cvt_pk_bf16(v1[0], v1[1]); w.w = cvt_pk_bf16(v1[2], v1[3]);
                    *(u32x4*)(rowp + bj * 128) = w; }
            }
    }
};
struct EpiSwiglu {
    static constexpr bool PERM = true; static constexpr int MID_T = -1;
    unsigned char* hid; const LAS float* rs_tab; int u0;
    __device__ __forceinline__ void operator()(const acc_t& acc, const pg8::Unit& u, int wr, int wc, int, int) const {
        const int lane_ = opaque_tid() & 63, fr = lane_ & 15, fq = lane_ >> 4;
        const int col0 = u.pn * 128 + wc * 32 + 8 * fq;
#pragma unroll
        for (int ai = 0; ai < 2; ++ai)
#pragma unroll
            for (int m = 0; m < 4; ++m) {
                const int rl = ai * 128 + wr * 64 + m * 16 + fr;
                const float rs = rs_tab[(u.pm - u0) * 256 + rl];
                f32x4 v0, v1;
#pragma unroll
                for (int i = 0; i < 4; ++i) { const float a0 = acc[ai][0][m][0][i] * rs, a1 = acc[ai][0][m][1][i] * rs;
                    v0[i] = a0 * sigmoidf_(a0) * (acc[ai][1][m][0][i] * rs); v1[i] = a1 * sigmoidf_(a1) * (acc[ai][1][m][1][i] * rs); }
                u32x2 w; w.x = pk_fp8x4(v0[0], v0[1], v0[2], v0[3]); w.y = pk_fp8x4(v1[0], v1[1], v1[2], v1[3]);
                if (rl < u.nrows) *(u32x2*)(hid + (size_t)(u.row0 + rl) * 512 + col0) = w;
            }
    }
};
struct EpiDown {
    static constexpr bool PERM = true; static constexpr int MID_T = -1;
    bf16_t* Y; float descale;
    __device__ __forceinline__ void operator()(const acc_t& acc, const pg8::Unit& u, int wr, int wc, int fr, int fq) const {
        const int col0 = u.pn * 256 + wc * 32 + 8 * fq;
#pragma unroll
        for (int ai = 0; ai < 2; ++ai)
#pragma unroll
            for (int m = 0; m < 4; ++m) {
                const int rl = ai * 128 + wr * 64 + m * 16 + fr;
#pragma unroll
                for (int bj = 0; bj < 2; ++bj) {
                    const f32x4 v0 = acc[ai][bj][m][0] * descale, v1 = acc[ai][bj][m][1] * descale;
                    u32x4 w; w.x = cvt_pk_bf16(v0[0], v0[1]); w.y = cvt_pk_bf16(v0[2], v0[3]); w.z = cvt_pk_bf16(v1[0], v1[1]); w.w = cvt_pk_bf16(v1[2], v1[3]);
                    if (rl < u.nrows) *(u32x4*)(Y + (size_t)(u.row0 + rl) * 1024 + col0 + bj * 128) = w;
                }
            }
    }
};

struct Args {
    const float* x; const float* norm_mix_w; const float* w_in; const float* b_gate; const float* dec_f; const float* dec_b; const float* gn_w;
    const float* w_a; const float* w_b; const float* w_o; const float* norm_moe_w; const float* wg; const float* bg; const float* we; const float* be;
    const float* w1; const float* w3; const float* w2; const float* norm_final_w;
    float* out; unsigned char* ws;
};

template <int MAP>
__device__ __forceinline__ void transpose_item(const float* W, int K, int N, bf16_t* WT, int row_off, LAS float* scr, int item, int lane, const float* kscale) {
    const int nblk = N / 32, kb = item / nblk, nb = item % nblk, k0 = 64 * kb, n0 = 32 * nb;
#pragma unroll 8
    for (int i = 0; i < 32; ++i) { const int kk = 2 * i + (lane >> 5); float v = W[(size_t)(k0 + kk) * N + n0 + (lane & 31)]; if (kscale) v *= kscale[k0 + kk]; scr[kk * 33 + (lane & 31)] = v; }
    LDS_WAIT(); asm volatile("" ::: "memory");
    const int c = lane & 7;
#pragma unroll
    for (int j = 0; j < 4; ++j) { const int n = (lane >> 3) + 8 * j; const LAS float* s = scr + (8 * c) * 33 + n;
        u32x4 o; o.x = cvt_pk_bf16(s[0 * 33], s[1 * 33]); o.y = cvt_pk_bf16(s[2 * 33], s[3 * 33]); o.z = cvt_pk_bf16(s[4 * 33], s[5 * 33]); o.w = cvt_pk_bf16(s[6 * 33], s[7 * 33]);
        const int lc = n0 + n; int dr;
        if (MAP == 0) dr = row_off + lc;
        else if (MAP == 1) dr = row_off + (lc & ~63) + 8 * ((lc & 31) >> 2) + 4 * ((lc >> 5) & 1) + (lc & 3);
        else dr = (lc >> 7) * 256 + row_off + (lc & 127);
        *(u32x4*)(WT + (size_t)dr * K + k0 + 8 * c) = o; }
    LDS_WAIT(); asm volatile("" ::: "memory");
}

template <int MAP, bool NT>
__device__ __forceinline__ void transpose_tile64(const float* W, int K, int N, bf16_t* WT, int row_off, LAS unsigned* T, int item, int lane, int ldw = 0, int koff = 0) {
    if (ldw == 0) ldw = K;
    const int kblk = K / 64, nb = item / kblk, kb = item % kblk, k0 = 64 * kb, n0 = 64 * nb;
    const int kp = lane >> 4, n4 = lane & 15;
    f32x4 ra[8], rb[8];
    const float* src = W + (size_t)(k0 + 2 * kp) * N + n0 + 4 * n4;
#pragma unroll
    for (int i = 0; i < 8; ++i) {
        const f32x4* pa = (const f32x4*)(src + (size_t)(8 * i) * N); const f32x4* pb = (const f32x4*)(src + (size_t)(8 * i + 1) * N);
        if (NT) { ra[i] = __builtin_nontemporal_load(pa); rb[i] = __builtin_nontemporal_load(pb); } else { ra[i] = *pa; rb[i] = *pb; }
    }
#pragma unroll
    for (int i = 0; i < 8; ++i)
#pragma unroll
        for (int c = 0; c < 4; ++c) { const int n = 4 * n4 + c, kpair = 4 * i + kp; T[n * 32 + (kpair ^ (((n >> 2) & 7) << 2))] = cvt_pk_bf16(ra[i][c], rb[i][c]); }
#pragma unroll
    for (int j = 0; j < 8; ++j) {
        const int row = 8 * j + (lane >> 3), chunk = lane & 7;
        const u32x4 v = *(const LAS u32x4*)(T + row * 32 + 4 * (chunk ^ ((row >> 2) & 7)));
        const int lc = n0 + row; int dr;
        if (MAP == 0) dr = row_off + lc;
        else if (MAP == 1) dr = row_off + (lc & ~63) + 8 * ((lc & 31) >> 2) + 4 * ((lc >> 5) & 1) + (lc & 3);
        else dr = (lc >> 7) * 256 + row_off + (lc & 127);
        *(u32x4*)(WT + (size_t)dr * ldw + koff + k0 + 8 * chunk) = v;
    }
}

template <int MAP, bool NT>
__device__ __forceinline__ void transpose_tile_fp8(const float* W, int K, int N, unsigned char* WT, int row_off, LAS unsigned* T, int item, int lane, float scale) {
    const int kblk = K / 128, nb = item / kblk, kb = item % kblk, k0 = 128 * kb, n0 = 64 * nb;
    const int kp = lane >> 4, n4 = lane & 15;
#pragma unroll
    for (int hh = 0; hh < 2; ++hh) {
        f32x4 r[4][4];
        const float* src = W + (size_t)(k0 + 64 * hh + 4 * kp) * N + n0 + 4 * n4;
#pragma unroll
        for (int i = 0; i < 4; ++i)
#pragma unroll
            for (int q = 0; q < 4; ++q) { const f32x4* p = (const f32x4*)(src + (size_t)(16 * i + q) * N); if (NT) r[i][q] = __builtin_nontemporal_load(p); else r[i][q] = *p; }
#pragma unroll
        for (int i = 0; i < 4; ++i)
#pragma unroll
            for (int c = 0; c < 4; ++c) { const int n = 4 * n4 + c, kq = 16 * hh + 4 * i + kp;
                T[n * 32 + (kq ^ (((n >> 2) & 7) << 2))] = pk_fp8x4(r[i][0][c] * scale, r[i][1][c] * scale, r[i][2][c] * scale, r[i][3][c] * scale); }
    }
#pragma unroll
    for (int j = 0; j < 8; ++j) {
        const int row = 8 * j + (lane >> 3), chunk = lane & 7;
        const u32x4 v = *(const LAS u32x4*)(T + row * 32 + 4 * (chunk ^ ((row >> 2) & 7)));
        const int lc = n0 + row; int dr;
        if (MAP == 0) dr = row_off + lc;
        else if (MAP == 1) dr = row_off + (lc & ~63) + 8 * ((lc & 31) >> 2) + 4 * ((lc >> 5) & 1) + (lc & 3);
        else dr = (lc >> 7) * 256 + row_off + (lc & 127);
        *(u32x4*)(WT + (size_t)dr * K + k0 + 16 * chunk) = v;
    }
}

__device__ __forceinline__ void rms_row_to_bf16(const float* xrow, const float* w, bf16_t* orow, int lane) {
    const f32x4* xr = (const f32x4*)xrow + lane; const f32x4* wr_ = (const f32x4*)w + lane;
    f32x4 v[4]; float s = 0.f;
#pragma unroll
    for (int j = 0; j < 4; ++j) { v[j] = xr[64 * j]; s += (v[j].x * v[j].x + v[j].y * v[j].y) + (v[j].z * v[j].z + v[j].w * v[j].w); }
    const float rstd = 1.f / sqrtf(wave_sum(s) * (1.f / DM) + NORM_EPS);
    u32x2* o8 = (u32x2*)orow + lane;
#pragma unroll
    for (int j = 0; j < 4; ++j) { const f32x4 ww = wr_[64 * j]; u32x2 o; o.x = cvt_pk_bf16(v[j].x * rstd * ww.x, v[j].y * rstd * ww.y); o.y = cvt_pk_bf16(v[j].z * rstd * ww.z, v[j].w * rstd * ww.w); o8[64 * j] = o; }
}

__device__ __forceinline__ float log_sigmoid(float x) { return x >= 0.f ? -log1pf(expf(-x)) : x - log1pf(expf(x)); }


#define XB_TMO      128
#define XB_XCNT(j)  (256  + 64 * (j))
#define XB_XSUB(j)  (1280 + 64 * (j))
#define XB_XGEN(j)  (2304 + 64 * (j))
#define XB_TOP      3328
#define XB_TOPGEN   3392
#define XCD_BAR_WORDS 3456
#define XB_SPIN_CAP (1u << 18)
__device__ __forceinline__ unsigned xb_ld(unsigned* p)              { return __hip_atomic_load(p, __ATOMIC_RELAXED, __HIP_MEMORY_SCOPE_AGENT); }
__device__ __forceinline__ unsigned xb_add(unsigned* p, unsigned v) { return __hip_atomic_fetch_add(p, v, __ATOMIC_RELAXED, __HIP_MEMORY_SCOPE_AGENT); }
__device__ __forceinline__ unsigned xb_xcc_id() { return (unsigned)__builtin_amdgcn_s_getreg((3 << 11) | 20) & 0xFu; }
#define XB_SPIN(cond, bar) do { unsigned _sp = 0; while (cond) { __builtin_amdgcn_s_sleep(1); \
    if ((++_sp & 255u) == 0u) { if (xb_ld(&(bar)[XB_TMO])) break; if (_sp > XB_SPIN_CAP) { atomicAdd(&(bar)[XB_TMO], 1u); break; } } } } while (0)
struct XcdBarrier { unsigned* bar; unsigned x; volatile LAS unsigned* st; };
__device__ __forceinline__ XcdBarrier xcd_barrier_post(unsigned* bar, volatile LAS unsigned* st) {
    XcdBarrier b; b.bar = bar; b.x = xb_xcc_id(); b.st = st;
    if (threadIdx.x == 0) (void)xb_add(&bar[XB_XCNT(b.x)], 1u);
    return b;
}
__device__ __forceinline__ void xcd_barrier_complete(unsigned* bar, unsigned x, unsigned& nloc, unsigned& nx) {
    const unsigned G = gridDim.x * gridDim.y * gridDim.z;
    unsigned sum, cnt, mine, sp = 0u;
    for (;;) {
        sum = 0u; cnt = 0u; mine = 0u;
#pragma unroll
        for (unsigned j = 0; j < 16; ++j) { const unsigned c = xb_ld(&bar[XB_XCNT(j)]); sum += c; cnt += (c > 0u) ? 1u : 0u; mine = (j == x) ? c : mine; }
        if (sum == G) break;
        __builtin_amdgcn_s_sleep(1);
        if ((++sp & 255u) == 0u) { if (xb_ld(&bar[XB_TMO])) break; if (sp > XB_SPIN_CAP) { atomicAdd(&bar[XB_TMO], 1u); break; } }
    }
    nloc = mine > 0u ? mine : 1u; nx = cnt > 0u ? cnt : 1u;
}
__device__ __forceinline__ void xcd_barrier(const XcdBarrier& b) {
    asm volatile("s_waitcnt vmcnt(0)" ::: "memory");
    __syncthreads();
    if (threadIdx.x == 0) {
        unsigned* bar = b.bar;
        __builtin_amdgcn_s_waitcnt(0);
        unsigned nloc = b.st[0], nx = b.st[1];
        if (nloc == 0u) { xcd_barrier_complete(bar, b.x, nloc, nx); b.st[0] = nloc; b.st[1] = nx; }
        const unsigned old = xb_add(&bar[XB_XSUB(b.x)], 1u);
        const unsigned gen = old / nloc;
        if (old + 1u == (gen + 1u) * nloc) {
            __builtin_amdgcn_fence(__ATOMIC_RELEASE, "agent");
            asm volatile("s_waitcnt vmcnt(0)" ::: "memory");
            const unsigned og = xb_add(&bar[XB_TOP], 1u);
            const unsigned tg = og / nx;
            if (og + 1u == (tg + 1u) * nx) xb_add(&bar[XB_TOPGEN], 1u);
            else XB_SPIN(xb_ld(&bar[XB_TOPGEN]) == tg, bar);
            __builtin_amdgcn_fence(__ATOMIC_ACQUIRE, "agent");
            xb_add(&bar[XB_XGEN(b.x)], 1u);
            asm volatile("s_waitcnt vmcnt(0)" ::: "memory");
        } else {
            XB_SPIN(xb_ld(&bar[XB_XGEN(b.x)]) == gen, bar);
            __builtin_amdgcn_fence(__ATOMIC_ACQUIRE, "agent");
            asm volatile("s_waitcnt vmcnt(0)" ::: "memory");
        }
    }
    __syncthreads();
}
#ifndef PROBE_A
#define PROBE_A -1
#endif
#ifndef PROBE_B
#define PROBE_B -1
#endif
#ifndef PROBE_A0
#define PROBE_A0 (PROBE_A - 1)
#endif
#ifndef PROBE_B0
#define PROBE_B0 (PROBE_B - 1)
#endif
#ifndef PROBE_SCALE
#define PROBE_SCALE 0.5e-6f
#endif
constexpr int CW_BAR = 4096, CW_TS = 8192;

typedef const __attribute__((address_space(4))) Args* KArgP;
__device__ __forceinline__ KArgP kargs() { KArgP p = (KArgP)__builtin_amdgcn_kernarg_segment_ptr(); asm volatile("" : "+s"(p)); return p; }
__global__ void __launch_bounds__(NTHREADS, 2) mega_fwd(Args A_) {
    extern __shared__ __attribute__((aligned(16))) unsigned char lds_raw[];
    LAS unsigned char* lds = (LAS unsigned char*)lds_raw;
    cg::grid_group grid = cg::this_grid();
    const int G = gridDim.x; const int bx = blockIdx.x;
    const int vcu = (G % 8 == 0) ? (bx % 8) * (G / 8) + bx / 8 : bx;
    const int NGW = G * NWAVES;
    unsigned char* ws = A_.ws;
    unsigned* ctl = (unsigned*)(ws + WS_CTL);
    LAS int* MISC = (LAS int*)(lds + MISC_OFF);
    LAS int* l_cnt = MISC; LAS int* l_tstart = MISC + 64; LAS int* l_sstart = MISC + 192;
    if (threadIdx.x < 2) MISC[300 + threadIdx.x] = 0;
    __syncthreads();
    (void)xcd_barrier_post(ctl + CW_BAR, (volatile LAS unsigned*)(MISC + 300));
#define STAMP(k) do { if ((PROBE_A >= 0 || PROBE_B >= 0) && blockIdx.x == 0 && threadIdx.x == 0) ((unsigned long long*)((unsigned*)(ws + WS_CTL) + CW_TS))[k] = __builtin_amdgcn_s_memrealtime(); } while (0)
#define GSYNC(k) do { XcdBarrier xb_; xb_.bar = (unsigned*)(ws + WS_CTL) + CW_BAR; xb_.x = xb_xcc_id(); xb_.st = (volatile LAS unsigned*)(lds + MISC_OFF) + 300; xcd_barrier(xb_); STAMP(k); } while (0)
    STAMP(0);

    {
        PHASE_IDS;
        KArgP K_ = kargs();
        const float* a_wg = K_->wg; const float* a_we = K_->we; const float* a_nmoe = K_->norm_moe_w; const float* a_win = K_->w_in; const float* a_wa = K_->w_a; const float* a_wb = K_->w_b; const float* a_wo = K_->w_o;
        const float* a_x = K_->x; const float* a_nmix = K_->norm_mix_w;
        for (int i = gw * 64 + lane; i < 80 * 1024; i += NGW * 64) {
            const int r = i >> 10, k = i & 1023; float v = 0.f;
            if (r < 8) v = a_wg[k * 8 + r]; else if (r >= 16) v = a_we[k * 64 + (r - 16)];
            v *= a_nmoe[k];
            const unsigned hi = cvt_pk_bf16(v, 0.f) & 0xffffu; const float lo = v - __uint_as_float(hi << 16);
            ((bf16_t*)(ws + WS_WR))[i] = (bf16_t)hi; ((bf16_t*)(ws + WS_WR))[80 * 1024 + i] = (bf16_t)(cvt_pk_bf16(lo, 0.f) & 0xffffu);
        }
        {
            LAS unsigned* T = (LAS unsigned*)(lds + wave * 8192);
            constexpr int I_IN8 = (DM / 128) * (4608 / 64), I_IN = (DM / 64) * ((IN_W - 4608) / 64), I_A = (512 / 64) * (DM / 64), I_B = (DM / 64) * (DM / 64), I_O = I_B;
            for (int it = gw; it < I_IN8 + I_IN + I_A + I_B + I_O; it += NGW) {
                int r = it;
                if (r < I_IN8) {
                    const int n0 = (r / (DM / 128)) * 64;
                    if (n0 < 3072) transpose_tile_fp8<1, false>(a_win, DM, IN_W, (unsigned char*)(ws + WS_WIN8), 0, T, r, lane, W8_SCALE);
                    else transpose_tile_fp8<0, false>(a_win, DM, IN_W, (unsigned char*)(ws + WS_WIN8), 0, T, r, lane, W8_SCALE);
                    continue; } r -= I_IN8;
                if (r < I_IN) {
                    const int r2 = r + (DM / 64) * (4608 / 64);
                    const int n0 = (r2 / (DM / 64)) * 64;
                    const bool rot = (n0 >= 4608 && n0 < 5632);
                    if (rot) transpose_tile64<1, false>(a_win, DM, IN_W, (bf16_t*)(ws + WS_WIN), 0, T, r2, lane);
                    else transpose_tile64<0, false>(a_win, DM, IN_W, (bf16_t*)(ws + WS_WIN), 0, T, r2, lane);
                    continue; } r -= I_IN;
                if (r < I_A) { transpose_tile64<0, false>(a_wa, 512, DM, (bf16_t*)(ws + WS_WA), 0, T, r, lane, 1536, 0); continue; } r -= I_A;
                if (r < I_B) { transpose_tile64<0, false>(a_wb, DM, DM, (bf16_t*)(ws + WS_WA), 0, T, r, lane, 1536, 512); continue; } r -= I_B;
                transpose_tile64<0, false>(a_wo, DM, DM, (bf16_t*)(ws + WS_WO), 0, T, r, lane);
            }
        }
        f32x4 wn[4];
#pragma unroll
        for (int j = 0; j < 4; ++j) wn[j] = ((const f32x4*)a_nmix + lane)[64 * j];
        for (int m = gw; m < NTOK; m += 2 * NGW) {
            const int m2 = (m + NGW < NTOK) ? m + NGW : m;
            const f32x4* xa = (const f32x4*)(a_x + (size_t)m * DM) + lane; const f32x4* xb = (const f32x4*)(a_x + (size_t)m2 * DM) + lane;
            f32x4 va[4], vb[4]; float sa = 0.f, sb = 0.f;
#pragma unroll
            for (int j = 0; j < 4; ++j) { va[j] = xa[64 * j]; vb[j] = xb[64 * j]; }
#pragma unroll
            for (int j = 0; j < 4; ++j) { sa += (va[j].x * va[j].x + va[j].y * va[j].y) + (va[j].z * va[j].z + va[j].w * va[j].w); sb += (vb[j].x * vb[j].x + vb[j].y * vb[j].y) + (vb[j].z * vb[j].z + vb[j].w * vb[j].w); }
#pragma unroll
            for (int o_ = 1; o_ < 64; o_ <<= 1) { sa += __shfl_xor(sa, o_); sb += __shfl_xor(sb, o_); }
            const float ra = 1.f / sqrtf(sa * (1.f / DM) + NORM_EPS), rb = 1.f / sqrtf(sb * (1.f / DM) + NORM_EPS);
            u32x2* oa = (u32x2*)((bf16_t*)(ws + WS_XN) + (size_t)m * DM) + lane; u32x2* ob = (u32x2*)((bf16_t*)(ws + WS_XN) + (size_t)m2 * DM) + lane;
#pragma unroll
            for (int j = 0; j < 4; ++j) { const f32x4 ww = wn[j];
                const f32x4 ya = va[j] * ra * ww, yb = vb[j] * rb * ww;
                u32x2 o; o.x = cvt_pk_bf16(ya.x, ya.y); o.y = cvt_pk_bf16(ya.z, ya.w); oa[64 * j] = o;
                u32x2 p; p.x = cvt_pk_bf16(yb.x, yb.y); p.y = cvt_pk_bf16(yb.z, yb.w); ob[64 * j] = p;
                ((unsigned*)((unsigned char*)(ws + WS_XN8) + (size_t)m * DM))[lane + 64 * j] = pk_fp8x4(ya.x, ya.y, ya.z, ya.w);
                ((unsigned*)((unsigned char*)(ws + WS_XN8) + (size_t)m2 * DM))[lane + 64 * j] = pk_fp8x4(yb.x, yb.y, yb.z, yb.w); }
        }
    }
    if (G > (1 << 24)) grid.sync();
    GSYNC(1);

    {
        pg8::StaticOrder S; S.init(ws + WS_XN8, ws + WS_WIN8, NTOK, 4608, DM / 2, G, bx);
        EpiProjAtt E{ws, W8_DESCALE};
        pg8::gemm_phase<EpiProjAtt, pg8::StaticOrder, true, true, false, true>(lds, DM / 2, S, E);
    }
    GSYNC(2);

#if EN_ATT
    {
        PHASE_IDS;
        const bf16_t* QA = (const bf16_t*)(ws + WS_QA); const bf16_t* KA = (const bf16_t*)(ws + WS_KA); const bf16_t* VA = (const bf16_t*)(ws + WS_VA);
        float* LSE = (float*)(ws + WS_LSE); bf16_t* YCAT = (bf16_t*)kargs()->out;
        const unsigned lds_base = (unsigned)(size_t)lds;
        const int qi = lane & 15, g4 = lane >> 4;
        const int swk = ((qi >> 1) & 3) << 1;
        const int koff0 = qi * 128 + ((g4 ^ swk) << 4), koff1 = qi * 128 + (((4 + g4) ^ swk) << 4);
        const int vrow_l = 4 * g4 + (qi >> 2), swv = ((vrow_l >> 1) & 3) << 1;
        int voff[4];
#pragma unroll
        for (int dt = 0; dt < 4; ++dt) voff[dt] = vrow_l * 128 + (((2 * dt + ((qi & 3) >> 1)) ^ swv) << 4) + 8 * (qi & 1);
        const int drow = lane >> 3, dchp = lane & 7;
        for (int unit = vcu; unit < 256; unit += G) {
            const int b = unit >> 4, h = (unit >> 1) & 7, half = unit & 1;
            const size_t tokb = (size_t)b * SEQ;
#define ATT_GEOM(s_) const int grp = (s_) >> 3, jj = (s_) & 7; const int dil = (grp == 0) ? 1 : (grp == 1 ? 4 : 16), L = SEQ / dil; \
            const int rr = (grp == 0) ? 0 : (grp == 1 ? (jj >> 1) : 2 * jj); \
            const int bstart = (grp == 0) ? (1024 * half + 128 * jj) : (grp == 1 ? (256 * half + 128 * (jj & 1)) : 64 * half);
#define ATT_DMA(s_, sl_) do { ATT_GEOM(s_) \
            _Pragma("unroll") for (int it = 0; it < 8; ++it) { const int ii = wave + 8 * it, tens = ii >> 5, rg = ii & 31; const int row = 8 * rg + drow; \
                int idx, rsel; if (grp == 2) { idx = row & 127; rsel = rr + (row >> 7); } else { idx = bstart - 64 + row; idx = idx < 0 ? 0 : (idx > L - 1 ? L - 1 : idx); rsel = rr; } \
                const int ch = dchp ^ (((row >> 1) & 3) << 1); \
                const bf16_t* src = (tens ? VA : KA) + ((size_t)((b * 3 + grp) * 8 + h) * SEQ + (size_t)idx * dil + rsel) * 64 + ch * 8; \
                glds16(src, (unsigned)__builtin_amdgcn_readfirstlane((int)(lds_base + (sl_) * 65536 + tens * 32768 + rg * 1024))); } } while (0)
#define ATT_QGEOM(s_) ATT_GEOM(s_) const int sub = wave >> 2; \
            const int qidx0 = (grp == 2) ? (bstart + 16 * (wave & 3)) : (bstart + 16 * wave); const int rq = (grp == 2) ? rr + sub : rr; \
            const int rowbase = (grp == 2) ? (128 * sub + qidx0 - 64) : 16 * wave; \
            const int sq = (qidx0 + qi) * dil + rq; const size_t hmq = ((size_t)((b * 3 + grp) * 8 + h) * SEQ + sq) * 64;        \
            const size_t tokq = tokb + sq;
            bf16x8 qn0, qn1; u32x2 pn[4]; float ln = 0.f;
#pragma unroll
            for (int dt = 0; dt < 4; ++dt) pn[dt] = (u32x2){0u, 0u};
            { ATT_QGEOM(0) const bf16_t* qp = QA + hmq + 8 * g4; qn0 = *(const bf16x8*)qp; qn1 = *(const bf16x8*)(qp + 32); (void)tokq; }
            ATT_DMA(0, 0);
            for (int s = 0; s < 24; ++s) {
                asm volatile("s_waitcnt vmcnt(0)" ::: "memory"); __builtin_amdgcn_s_barrier(); asm volatile("" ::: "memory");
                bf16x8 qf0 = qn0, qf1 = qn1; asm volatile("" : "+v"(qf0), "+v"(qf1));
                u32x2 pc[4]; float lc = ln;
#pragma unroll
                for (int dt = 0; dt < 4; ++dt) pc[dt] = pn[dt];
                asm volatile("" : "+v"(pc[0]), "+v"(pc[1]), "+v"(pc[2]), "+v"(pc[3]), "+v"(lc));
                if (s + 1 < 24) { ATT_DMA(s + 1, (s + 1) & 1); { ATT_QGEOM(s + 1) const bf16_t* qp = QA + hmq + 8 * g4; qn0 = *(const bf16x8*)qp; qn1 = *(const bf16x8*)(qp + 32);
                    if (s + 1 >= 8) { const bf16_t* yp = YCAT + tokq * 1536 + h * 64 + 4 * g4;
#pragma unroll
                        for (int dt = 0; dt < 4; ++dt) pn[dt] = *(const u32x2*)(yp + 16 * dt);
                        ln = LSE[tokq * 8 + h]; } } }
                {
                    ATT_QGEOM(s)
                    const LAS unsigned char* Kt = lds + (s & 1) * 65536; const LAS unsigned char* Vt = Kt + 32768;
                    f32x4 sc[9]; float mx = -INFINITY; int trow[9];
#pragma unroll
                    for (int kt = 0; kt < 9; ++kt) {
                        const int kidx0 = qidx0 - 64 + 16 * kt; const bool inr = (kidx0 >= 0) && (kidx0 < L);
                        const int tr_ = inr ? rowbase + 16 * kt : rowbase + 64; trow[kt] = tr_;
                        const LAS unsigned char* kp = Kt + tr_ * 128;
                        const bf16x8 k0 = *(const LAS bf16x8*)(kp + koff0), k1 = *(const LAS bf16x8*)(kp + koff1);
                        f32x4 sv = (f32x4){0.f, 0.f, 0.f, 0.f};
                        sv = __builtin_amdgcn_mfma_f32_16x16x32_bf16(k0, qf0, sv, 0, 0, 0);
                        sv = __builtin_amdgcn_mfma_f32_16x16x32_bf16(k1, qf1, sv, 0, 0, 0);
#pragma unroll
                        for (int i = 0; i < 4; ++i) { const int kr = 4 * g4 + i; bool ok = inr; if (kt == 0) ok = ok && (kr >= qi); if (kt == 8) ok = ok && (kr <= qi);
                            sv[i] = ok ? sv[i] : -INFINITY; mx = fmaxf(mx, sv[i]); }
                        sc[kt] = sv;
                    }
                    mx = fmaxf(mx, __shfl_xor(mx, 16)); mx = fmaxf(mx, __shfl_xor(mx, 32));
                    float lsum = 0.f;
#pragma unroll
                    for (int kt = 0; kt < 9; ++kt)
#pragma unroll
                        for (int i = 0; i < 4; ++i) { const float p = fast_exp2(sc[kt][i] - mx); sc[kt][i] = p; lsum += p; }
                    lsum += __shfl_xor(lsum, 16); lsum += __shfl_xor(lsum, 32);
                    f32x4 o[4];
#pragma unroll
                    for (int dt = 0; dt < 4; ++dt) o[dt] = (f32x4){0.f, 0.f, 0.f, 0.f};
#pragma unroll
                    for (int kk = 0; kk < 5; ++kk) {
                        const int t0 = 2 * kk, t1 = (kk == 4) ? 8 : 2 * kk + 1;
                        u32x4 pw; pw.x = cvt_pk_bf16(sc[t0][0], sc[t0][1]); pw.y = cvt_pk_bf16(sc[t0][2], sc[t0][3]);
                        if (kk == 4) { pw.z = 0u; pw.w = 0u; } else { pw.z = cvt_pk_bf16(sc[t1][0], sc[t1][1]); pw.w = cvt_pk_bf16(sc[t1][2], sc[t1][3]); }
                        const bf16x8 pf = __builtin_bit_cast(bf16x8, pw);
                        const LAS unsigned char* v0p = Vt + trow[t0] * 128; const LAS unsigned char* v1p = Vt + trow[t1] * 128;
#pragma unroll
                        for (int dt = 0; dt < 4; ++dt) {
                            const bf16x8 vf = cat4(tr_read((const LAS char*)(v0p + voff[dt])), tr_read((const LAS char*)(v1p + voff[dt])));
                            o[dt] = __builtin_amdgcn_mfma_f32_16x16x32_bf16(vf, pf, o[dt], 0, 0, 0);
                        }
                    }
                    const float rl = 1.f / lsum, lse2 = mx + log2f(lsum);
                    float fa = 0.f, fb = rl, lnew = lse2;
                    if (grp > 0) { const float m = fmaxf(lc, lse2), wa = fast_exp2(lc - m), wb = fast_exp2(lse2 - m), inv = 1.f / (wa + wb); fa = wa * inv; fb = wb * inv * rl; lnew = m + log2f(wa + wb); }
                    bf16_t* op = YCAT + tokq * 1536 + h * 64 + 4 * g4;
#pragma unroll
                    for (int dt = 0; dt < 4; ++dt) { u32x2 w;
                        w.x = cvt_pk_bf16(fa * bf_lo(pc[dt].x) + fb * o[dt][0], fa * bf_hi(pc[dt].x) + fb * o[dt][1]); w.y = cvt_pk_bf16(fa * bf_lo(pc[dt].y) + fb * o[dt][2], fa * bf_hi(pc[dt].y) + fb * o[dt][3]);
                        *(u32x2*)(op + 16 * dt) = w; }
                    if (g4 == 0 && grp < 2) LSE[tokq * 8 + h] = lnew;
                }
            }
#undef ATT_GEOM
#undef ATT_DMA
#undef ATT_QGEOM
            VM_WAIT();
            __syncthreads();
        }
    }
#else
    { PHASE_IDS; bf16_t* yc = (bf16_t*)kargs()->out; for (size_t i = (size_t)bx * NTHREADS + tid; i < (size_t)NTOK * 64; i += (size_t)G * NTHREADS) *(u32x4*)(yc + (i >> 6) * 1536 + (i & 63) * 8) = (u32x4){0u, 0u, 0u, 0u}; }
#endif
    GSYNC(3);

    {
        pg8::StaticOrder S; S.init(ws + WS_XN, ws + WS_WIN + (size_t)4608 * DM * 2, NTOK, 5120, DM, G, bx);
        KArgP K_ = kargs();
        EpiProj E{ws, (bf16_t*)K_->out, K_->b_gate, 18, 1.f};
        pg8::gemm_phase<EpiProj, pg8::StaticOrder, true, true>(lds, DM, S, E);
    }
    GSYNC(4);

#if EN_RET
    {
        PHASE_IDS;
        const bf16_t* KR = (const bf16_t*)(ws + WS_KR); const bf16_t* VR = (const bf16_t*)(ws + WS_VR); bf16_t* SST = (bf16_t*)(ws + WS_SST);
        constexpr int RSK = 160, RSV = 288; constexpr int KT_OFF = 0, VT_OFF = 128 * RSK;
        const int dcol = lane & 15, g4 = lane >> 4;
        for (int unit = vcu; unit < 256; unit += G) {
            const int b = unit >> 4, h = (unit >> 1) & 7, dir = unit & 1;
            KArgP K_ = kargs(); const float lg = log_sigmoid(dir ? K_->dec_b[h] : K_->dec_f[h]); const float lg2 = lg * LOG2E; const float cd = exp2f(128.f * lg2);
            f32x4 st[4];
#pragma unroll
            for (int dt = 0; dt < 4; ++dt) st[dt] = (f32x4){0.f, 0.f, 0.f, 0.f};
            constexpr int BUFB = 128 * RSK + 128 * RSV;
            u32x4 kA[2], vA[4], kB[2], vB[4];
            float zk[2];
#pragma unroll
            for (int it = 0; it < 2; ++it) { const int row = (tid + NTHREADS * it) >> 3; zk[it] = exp2f(lg2 * (float)(dir ? row : 127 - row)); }
#define P3A_LOAD(kr_, vr_, s_) do { const size_t tk_ = (size_t)b * SEQ + (dir ? 15 - (s_) : (s_)) * 128; \
                _Pragma("unroll") for (int it = 0; it < 2; ++it) { const int p = tid + NTHREADS * it, row = p >> 3, ch = p & 7; kr_[it] = *(const u32x4*)(KR + (tk_ + row) * 512 + h * 64 + ch * 8); } \
                _Pragma("unroll") for (int it = 0; it < 4; ++it) { const int p = tid + NTHREADS * it, row = p >> 4, ch = p & 15; vr_[it] = *(const u32x4*)(VR + (tk_ + row) * 1024 + h * 128 + ch * 8); } } while (0)
#define P3A_STAGE(kr_, vr_, buf_) do { \
                _Pragma("unroll") for (int it = 0; it < 2; ++it) { const int p = tid + NTHREADS * it, row = p >> 3, ch = p & 7; const u32x4 v = kr_[it]; const float z = zk[it]; \
                    u32x4 o; o.x = cvt_pk_bf16(bf_lo(v.x) * z, bf_hi(v.x) * z); o.y = cvt_pk_bf16(bf_lo(v.y) * z, bf_hi(v.y) * z); o.z = cvt_pk_bf16(bf_lo(v.z) * z, bf_hi(v.z) * z); o.w = cvt_pk_bf16(bf_lo(v.w) * z, bf_hi(v.w) * z); \
                    *(LAS u32x4*)(lds + (buf_) * BUFB + KT_OFF + row * RSK + ch * 16) = o; } \
                _Pragma("unroll") for (int it = 0; it < 4; ++it) { const int p = tid + NTHREADS * it, row = p >> 4, ch = p & 15; *(LAS u32x4*)(lds + (buf_) * BUFB + VT_OFF + row * RSV + ch * 16) = vr_[it]; } } while (0)
#define P3A_STEP(s_, kr_, vr_) do { const int n = dir ? 15 - (s_) : (s_); const int buf = (s_) & 1; \
                bf16_t* sp = SST + ((size_t)((b * 8 + h) * 2 + dir) * 16 + n) * 8192;        \
                _Pragma("unroll") for (int dt = 0; dt < 4; ++dt) { u32x2 w; w.x = cvt_pk_bf16(st[dt][0], st[dt][1]); w.y = cvt_pk_bf16(st[dt][2], st[dt][3]); *(u32x2*)(sp + (16 * dt + dcol) * 128 + 16 * wave + 4 * g4) = w; } \
                if ((s_) + 1 < 16) { P3A_STAGE(kr_, vr_, buf ^ 1); if ((s_) + 3 < 16) P3A_LOAD(kr_, vr_, (s_) + 3); } \
                _Pragma("unroll") for (int dt = 0; dt < 4; ++dt) st[dt] = st[dt] * cd; \
                _Pragma("unroll") for (int kk = 0; kk < 4; ++kk) { \
                    const int r0 = 32 * kk + 4 * g4 + (dcol >> 2), r1 = r0 + 16; \
                    const LAS unsigned char* vb = lds + buf * BUFB + VT_OFF + (16 * wave + 4 * (dcol & 3)) * 2; \
                    const bf16x8 af = cat4(tr_read((const LAS char*)(vb + r0 * RSV)), tr_read((const LAS char*)(vb + r1 * RSV))); \
                    _Pragma("unroll") for (int dt = 0; dt < 4; ++dt) { \
                        const LAS unsigned char* kb = lds + buf * BUFB + KT_OFF + (16 * dt + 4 * (dcol & 3)) * 2; \
                        const bf16x8 bfr = cat4(tr_read((const LAS char*)(kb + r0 * RSK)), tr_read((const LAS char*)(kb + r1 * RSK))); \
                        st[dt] = __builtin_amdgcn_mfma_f32_16x16x32_bf16(af, bfr, st[dt], 0, 0, 0); } } \
                __syncthreads(); } while (0)
            P3A_LOAD(kA, vA, 0); P3A_LOAD(kB, vB, 1);
            P3A_STAGE(kA, vA, 0); P3A_LOAD(kA, vA, 2);
            __syncthreads();
#pragma unroll 1
            for (int step = 0; step < 16; step += 2) {
                P3A_STEP(step, kB, vB);
                P3A_STEP(step + 1, kA, vA);
            }
#undef P3A_LOAD
#undef P3A_STAGE
#undef P3A_STEP
        }
    }
    GSYNC(5);
    {
        PHASE_IDS;
        const bf16_t* QR = (const bf16_t*)(ws + WS_QR); const bf16_t* KR = (const bf16_t*)(ws + WS_KR); const bf16_t* VR = (const bf16_t*)(ws + WS_VR);
        const bf16_t* GR = (const bf16_t*)(ws + WS_GR); const bf16_t* SST = (const bf16_t*)(ws + WS_SST); bf16_t* YCAT = (bf16_t*)kargs()->out;
        constexpr int RSK = 160, RSV = 288; constexpr int QT = 0, KT = 20480, VT = 40960, SF = 77824, SB = 96256, GNW = 114688, GT = 118784;
        const int qi = lane & 15, g4 = lane >> 4;
        { const float* a_gnw0 = kargs()->gn_w; ((LAS float*)(lds + GNW))[tid] = a_gnw0[tid]; ((LAS float*)(lds + GNW))[tid + 512] = a_gnw0[tid + 512]; }
        u32x4 pre[12];
#define P3B_LOAD(unit_) do { const int bh_ = (unit_) >> 4, n_ = (unit_) & 15, b_ = bh_ >> 3, h_ = bh_ & 7; const size_t tk_ = (size_t)b_ * SEQ + n_ * 128; \
            _Pragma("unroll") for (int it = 0; it < 2; ++it) { const int p = tid + NTHREADS * it, row = p >> 3, ch = p & 7; \
                pre[it] = *(const u32x4*)(QR + (tk_ + row) * 512 + h_ * 64 + ch * 8); pre[2 + it] = *(const u32x4*)(KR + (tk_ + row) * 512 + h_ * 64 + ch * 8); } \
            _Pragma("unroll") for (int it = 0; it < 4; ++it) { const int p = tid + NTHREADS * it, row = p >> 4, ch = p & 15; pre[4 + it] = *(const u32x4*)(VR + (tk_ + row) * 1024 + h_ * 128 + ch * 8); } \
            _Pragma("unroll") for (int it = 0; it < 2; ++it) { const int p = tid + NTHREADS * it, row = p >> 4, ch = p & 15; \
                pre[8 + it] = *(const u32x4*)(SST + ((size_t)(bh_ * 2 + 0) * 16 + n_) * 8192 + row * 128 + ch * 8); pre[10 + it] = *(const u32x4*)(SST + ((size_t)(bh_ * 2 + 1) * 16 + n_) * 8192 + row * 128 + ch * 8); } } while (0)
        if (vcu < 2048) P3B_LOAD(vcu);
        constexpr int DW = ROFF_OFF + 20480;
        int h_cur = -1; float lgf2 = 0.f, lgb2 = 0.f, xif = 0.f, xib = 0.f;
        for (int unit = vcu; unit < 2048; unit += G) {
            const int bh = unit >> 4, n = unit & 15, b = bh >> 3, h = bh & 7;
            if (h != h_cur) {
                h_cur = h;
                KArgP K_ = kargs(); lgf2 = log_sigmoid(K_->dec_f[h]) * LOG2E; lgb2 = log_sigmoid(K_->dec_b[h]) * LOG2E;
                const int qa_ = 16 * wave + qi;
                xif = fast_exp2(lgf2 * (float)(qa_ + 1)); xib = fast_exp2(lgb2 * (float)(128 - qa_));
                if (tid < 255) { const int dl = 127 - tid; ((LAS float*)(lds + DW))[tid] = dl > 0 ? fast_exp2(lgf2 * (float)dl) : (dl < 0 ? fast_exp2(lgb2 * (float)(-dl)) : 2.f); }
            }
            const size_t tok0 = (size_t)b * SEQ + n * 128;
#pragma unroll
            for (int it = 0; it < 2; ++it) { const int p = tid + NTHREADS * it, row = p >> 3, ch = p & 7;
                *(LAS u32x4*)(lds + QT + row * RSK + ch * 16) = pre[it]; *(LAS u32x4*)(lds + KT + row * RSK + ch * 16) = pre[2 + it]; }
#pragma unroll
            for (int it = 0; it < 4; ++it) { const int p = tid + NTHREADS * it, row = p >> 4, ch = p & 15; *(LAS u32x4*)(lds + VT + row * RSV + ch * 16) = pre[4 + it]; }
#pragma unroll
            for (int it = 0; it < 2; ++it) { const int p = tid + NTHREADS * it, row = p >> 4, ch = p & 15;
                *(LAS u32x4*)(lds + SF + row * RSV + ch * 16) = pre[8 + it]; *(LAS u32x4*)(lds + SB + row * RSV + ch * 16) = pre[10 + it]; }
            __syncthreads();
            {
                const unsigned gdst = (unsigned)(size_t)lds + (unsigned)(wave < 3 ? GT + wave * 4096 : ROFF_OFF + (wave - 3) * 4096);
#pragma unroll
                for (int j = 0; j < 4; ++j) { const int row = 4 * j + (lane >> 4), c = (lane & 15) ^ row;
                    glds16(GR + (tok0 + 16 * wave + row) * 1024 + h * 128 + c * 8, (unsigned)__builtin_amdgcn_readfirstlane((int)(gdst + j * 1024))); }
            }
            if (unit + G < 2048) P3B_LOAD(unit + G);
            {
                const int qa = 16 * wave + qi;
                const LAS unsigned char* qrow = lds + QT + qa * RSK;
                const bf16x8 qf0 = *(const LAS bf16x8*)(qrow + g4 * 16), qf1 = *(const LAS bf16x8*)(qrow + 64 + g4 * 16);
                bf16x8 pf[4];
#pragma unroll
                for (int kk = 0; kk < 4; ++kk) {
                    u32x4 pw;
#pragma unroll
                    for (int tt = 0; tt < 2; ++tt) {
                        const int kt = 2 * kk + tt;
                        const LAS unsigned char* kp = lds + KT + (16 * kt + qi) * RSK + g4 * 16;
                        const bf16x8 k0 = *(const LAS bf16x8*)kp, k1 = *(const LAS bf16x8*)(kp + 64);
                        f32x4 s = (f32x4){0.f, 0.f, 0.f, 0.f};
                        s = __builtin_amdgcn_mfma_f32_16x16x32_bf16(k0, qf0, s, 0, 0, 0);
                        s = __builtin_amdgcn_mfma_f32_16x16x32_bf16(k1, qf1, s, 0, 0, 0);
#pragma unroll
                        for (int i = 0; i < 4; ++i) s[i] *= ((const LAS float*)(lds + DW))[127 - qa + 16 * kt + 4 * g4 + i];
                        if (tt == 0) { pw.x = cvt_pk_bf16(s[0], s[1]); pw.y = cvt_pk_bf16(s[2], s[3]); } else { pw.z = cvt_pk_bf16(s[0], s[1]); pw.w = cvt_pk_bf16(s[2], s[3]); }
                    }
                    pf[kk] = __builtin_bit_cast(bf16x8, pw);
                }
                bf16x8 qxf[2], qxb[2];
#pragma unroll
                for (int kk = 0; kk < 2; ++kk) {
                    const u32x2 a = *(const LAS u32x2*)(qrow + (32 * kk + 4 * g4) * 2), c = *(const LAS u32x2*)(qrow + (32 * kk + 16 + 4 * g4) * 2);
                    u32x4 f, bq;
                    f.x = cvt_pk_bf16(bf_lo(a.x) * xif, bf_hi(a.x) * xif); f.y = cvt_pk_bf16(bf_lo(a.y) * xif, bf_hi(a.y) * xif); f.z = cvt_pk_bf16(bf_lo(c.x) * xif, bf_hi(c.x) * xif); f.w = cvt_pk_bf16(bf_lo(c.y) * xif, bf_hi(c.y) * xif);
                    bq.x = cvt_pk_bf16(bf_lo(a.x) * xib, bf_hi(a.x) * xib); bq.y = cvt_pk_bf16(bf_lo(a.y) * xib, bf_hi(a.y) * xib); bq.z = cvt_pk_bf16(bf_lo(c.x) * xib, bf_hi(c.x) * xib); bq.w = cvt_pk_bf16(bf_lo(c.y) * xib, bf_hi(c.y) * xib);
                    qxf[kk] = __builtin_bit_cast(bf16x8, f); qxb[kk] = __builtin_bit_cast(bf16x8, bq);
                }
                f32x4 o[8];
                const int trow = 4 * g4 + (qi >> 2), tcol = (qi & 3) * 8;
#pragma unroll
                for (int vt = 0; vt < 8; ++vt) {
                    f32x4 acc = (f32x4){0.f, 0.f, 0.f, 0.f};
#pragma unroll
                    for (int kk = 0; kk < 4; ++kk) {
                        const LAS unsigned char* vb = lds + VT + (32 * kk + trow) * RSV + vt * 32 + tcol;
                        const bf16x8 af = cat4(tr_read((const LAS char*)vb), tr_read((const LAS char*)(vb + 16 * RSV)));
                        acc = __builtin_amdgcn_mfma_f32_16x16x32_bf16(af, pf[kk], acc, 0, 0, 0);
                    }
#pragma unroll
                    for (int kk = 0; kk < 2; ++kk) {
                        const LAS unsigned char* sfp = lds + SF + (32 * kk + trow) * RSV + vt * 32 + tcol;
                        const bf16x8 af = cat4(tr_read((const LAS char*)sfp), tr_read((const LAS char*)(sfp + 16 * RSV)));
                        acc = __builtin_amdgcn_mfma_f32_16x16x32_bf16(af, qxf[kk], acc, 0, 0, 0);
                        const LAS unsigned char* sbp = lds + SB + (32 * kk + trow) * RSV + vt * 32 + tcol;
                        const bf16x8 ab = cat4(tr_read((const LAS char*)sbp), tr_read((const LAS char*)(sbp + 16 * RSV)));
                        acc = __builtin_amdgcn_mfma_f32_16x16x32_bf16(ab, qxb[kk], acc, 0, 0, 0);
                    }
                    o[vt] = acc;
                }
                float s = 0.f;
#pragma unroll
                for (int vt = 0; vt < 8; ++vt) s += (o[vt][0] + o[vt][1]) + (o[vt][2] + o[vt][3]);
                s += __shfl_xor(s, 16); s += __shfl_xor(s, 32);
                const float mu = s * (1.f / 128.f); float q2 = 0.f;
#pragma unroll
                for (int vt = 0; vt < 8; ++vt) { const f32x4 d = o[vt] - mu; q2 += (d[0] * d[0] + d[1] * d[1]) + (d[2] * d[2] + d[3] * d[3]); }
                q2 += __shfl_xor(q2, 16); q2 += __shfl_xor(q2, 32);
                const float rstd = 1.f / sqrtf(q2 * (1.f / 128.f) + NORM_EPS);
                const size_t tok = tok0 + qa;
                asm volatile("s_waitcnt vmcnt(0)" ::: "memory");
#pragma unroll
                for (int vt = 0; vt < 8; ++vt) {
                    const int col = h * 128 + 16 * vt + 4 * g4;
                    const f32x4 gw4 = *(const LAS f32x4*)(lds + GNW + col * 4); const u32x2 sg = *(const LAS u32x2*)(lds + (wave < 3 ? GT + wave * 4096 : ROFF_OFF + (wave - 3) * 4096) + qi * 256 + (((2 * vt + (g4 >> 1)) ^ qi) << 4) + 8 * (g4 & 1));
                    const f32x4 d = (o[vt] - mu) * rstd;
                    u32x2 w; w.x = cvt_pk_bf16(d[0] * gw4[0] * bf_lo(sg.x), d[1] * gw4[1] * bf_hi(sg.x)); w.y = cvt_pk_bf16(d[2] * gw4[2] * bf_lo(sg.y), d[3] * gw4[3] * bf_hi(sg.y));
                    *(u32x2*)(YCAT + tok * 1536 + 512 + col) = w;
                }
            }
            __syncthreads();
        }
    }
#else
    { PHASE_IDS; bf16_t* yc = (bf16_t*)kargs()->out; for (size_t i = (size_t)bx * NTHREADS + tid; i < (size_t)NTOK * 128; i += (size_t)G * NTHREADS) *(u32x4*)(yc + (i >> 7) * 1536 + 512 + (i & 127) * 8) = (u32x4){0u, 0u, 0u, 0u}; }
#endif
    GSYNC(6);

    {
        pg8::StaticOrder S; S.init(kargs()->out, ws + WS_WA, NTOK, DM, 1536, G, bx);
        EpiMerge E{(bf16_t*)(ws + WS_MERGED), (const bf16_t*)(ws + WS_GATE)};
        pg8::gemm_phase<EpiMerge, pg8::StaticOrder, true, true>(lds, 1536, S, E);
    }
    GSYNC(7);

    {
        pg8::StaticOrder S; S.init(ws + WS_MERGED, ws + WS_WO, NTOK, DM, DM, G, bx);
        EpiPlain E{(bf16_t*)(ws + WS_MIX)};
        pg8::gemm_phase<EpiPlain, pg8::StaticOrder, true, true>(lds, DM, S, E);
    }
    GSYNC(8);

#if EN_MOE
#ifndef NO_P6
    {
        PHASE_IDS;
        const float* H = kargs()->x; const bf16_t* MIX = (const bf16_t*)(ws + WS_MIX); const bf16_t* WRh = (const bf16_t*)(ws + WS_WR); unsigned char* HN = (unsigned char*)(ws + WS_HN);
        unsigned* ASG = (unsigned*)(ws + WS_ASG); float* RSTD = (float*)(ws + WS_RSTD);
        LAS float* NM = (LAS float*)(lds + 98304);
        { KArgP K0 = kargs(); const float* a_nmoe = K0->norm_moe_w; NM[tid] = a_nmoe[tid]; NM[tid + 512] = a_nmoe[tid + 512]; }
        if (tid < 2) MISC[310 + tid] = 0;
        if (tid < 64) MISC[320 + tid] = 0;
        __syncthreads();
        const int ntc = (NTOK / 16 - vcu * NWAVES + NGW - 1) / NGW * NWAVES;
        for (;;) {
            int kind = -1, widx = 0;
            if (lane == 0) {
                if (wave < 4) { widx = __hip_atomic_fetch_add(&MISC[311], 1, __ATOMIC_RELAXED, __HIP_MEMORY_SCOPE_WORKGROUP); if (widx < ntc) kind = 0;
                    else { widx = __hip_atomic_fetch_add(&MISC[310], 1, __ATOMIC_RELAXED, __HIP_MEMORY_SCOPE_WORKGROUP); if (vcu + G * widx < NEXP * 192) kind = 1; } }
                else { widx = __hip_atomic_fetch_add(&MISC[310], 1, __ATOMIC_RELAXED, __HIP_MEMORY_SCOPE_WORKGROUP); if (vcu + G * widx < NEXP * 192) kind = 1;
                    else { widx = __hip_atomic_fetch_add(&MISC[311], 1, __ATOMIC_RELAXED, __HIP_MEMORY_SCOPE_WORKGROUP); if (widx < ntc) kind = 0; } }
            }
            kind = __builtin_amdgcn_readfirstlane(kind); widx = __builtin_amdgcn_readfirstlane(widx);
            if (kind < 0) break;
            if (kind == 0) {
                KArgP K_ = kargs(); const float* a_bg = K_->bg; const float* a_be = K_->be;
                LAS float* LG = (LAS float*)(lds + wave * 8192);
                int lane_r = lane; asm volatile("" : "+v"(lane_r));
                const int tk = lane_r & 15, g4 = lane_r >> 4;
                const int tile = vcu * NWAVES + (widx & 7) + (widx >> 3) * NGW;
                const int t0 = tile * 16;
                f32x4 acc[5];
#pragma unroll
                for (int nt = 0; nt < 5; ++nt) acc[nt] = (f32x4){0.f, 0.f, 0.f, 0.f};
                float ss = 0.f;
                const float* hp = H + (size_t)(t0 + tk) * DM + 8 * g4; const bf16_t* mp = MIX + (size_t)(t0 + tk) * DM + 8 * g4;
                unsigned char* hnp = HN + (size_t)(t0 + tk) * DM + 8 * g4;
                const bf16_t* whp = WRh + (size_t)tk * DM + 8 * g4;
                f32x4 hA[2], hB[2], hC[2], hD[2]; bf16x8 wA[5], wB[5], wC[5], wD[5]; u32x4 mA, mB, mC, mD;
#define RT_LOAD(hS, wS, mS, ks_) do { hS[0] = *(const f32x4*)(hp + 32 * (ks_)); hS[1] = *(const f32x4*)(hp + 32 * (ks_) + 4); mS = *(const u32x4*)(mp + 32 * (ks_)); \
                    _Pragma("unroll") for (int nt = 0; nt < 5; ++nt) wS[nt] = *(const bf16x8*)(whp + (size_t)nt * 16 * DM + 32 * (ks_)); } while (0)
#define RT_COMP(hS, wS, mS, ks_) do { const f32x4 x0 = hS[0] + (f32x4){bf_lo(mS.x), bf_hi(mS.x), bf_lo(mS.y), bf_hi(mS.y)}, x1 = hS[1] + (f32x4){bf_lo(mS.z), bf_hi(mS.z), bf_lo(mS.w), bf_hi(mS.w)}; \
                    const f32x4 n0 = *(const LAS f32x4*)(NM + 32 * (ks_) + 8 * g4), n1 = *(const LAS f32x4*)(NM + 32 * (ks_) + 8 * g4 + 4); \
                    ss += (x0[0] * x0[0] + x0[1] * x0[1]) + (x0[2] * x0[2] + x0[3] * x0[3]) + (x1[0] * x1[0] + x1[1] * x1[1]) + (x1[2] * x1[2] + x1[3] * x1[3]); \
                    u32x2 hw; hw.x = pk_fp8x4(x0[0] * n0[0], x0[1] * n0[1], x0[2] * n0[2], x0[3] * n0[3]); hw.y = pk_fp8x4(x1[0] * n1[0], x1[1] * n1[1], x1[2] * n1[2], x1[3] * n1[3]); \
                    *(u32x2*)(hnp + 32 * (ks_)) = hw; \
                    u32x4 hi; hi.x = cvt_pk_bf16(x0[0], x0[1]); hi.y = cvt_pk_bf16(x0[2], x0[3]); hi.z = cvt_pk_bf16(x1[0], x1[1]); hi.w = cvt_pk_bf16(x1[2], x1[3]); \
                    u32x4 lo; lo.x = cvt_pk_bf16(x0[0] - bf_lo(hi.x), x0[1] - bf_hi(hi.x)); lo.y = cvt_pk_bf16(x0[2] - bf_lo(hi.y), x0[3] - bf_hi(hi.y)); \
                    lo.z = cvt_pk_bf16(x1[0] - bf_lo(hi.z), x1[1] - bf_hi(hi.z)); lo.w = cvt_pk_bf16(x1[2] - bf_lo(hi.w), x1[3] - bf_hi(hi.w)); \
                    const bf16x8 bh = __builtin_bit_cast(bf16x8, hi), bl = __builtin_bit_cast(bf16x8, lo); \
                    _Pragma("unroll") for (int nt = 0; nt < 5; ++nt) { acc[nt] = __builtin_amdgcn_mfma_f32_16x16x32_bf16(wS[nt], bh, acc[nt], 0, 0, 0); acc[nt] = __builtin_amdgcn_mfma_f32_16x16x32_bf16(wS[nt], bl, acc[nt], 0, 0, 0); } } while (0)
                RT_LOAD(hA, wA, mA, 0); RT_LOAD(hB, wB, mB, 1); RT_LOAD(hC, wC, mC, 2);
#pragma unroll 1
                for (int ks = 0; ks < 32; ks += 4) {
                    RT_LOAD(hD, wD, mD, ks + 3); RT_COMP(hA, wA, mA, ks);
                    if (ks + 4 < 32) RT_LOAD(hA, wA, mA, ks + 4); RT_COMP(hB, wB, mB, ks + 1);
                    if (ks + 5 < 32) RT_LOAD(hB, wB, mB, ks + 5); RT_COMP(hC, wC, mC, ks + 2);
                    if (ks + 6 < 32) RT_LOAD(hC, wC, mC, ks + 6); RT_COMP(hD, wD, mD, ks + 3);
                }
#undef RT_LOAD
#undef RT_COMP
                ss += __shfl_xor(ss, 16); ss += __shfl_xor(ss, 32);
                const float rstd = 1.f / sqrtf(ss * (1.f / DM) + NORM_EPS);
#pragma unroll
                for (int nt = 0; nt < 5; ++nt)
#pragma unroll
                    for (int i = 0; i < 4; ++i) LG[tk * 81 + 16 * nt + 4 * g4 + i] = acc[nt][i];
                LDS_WAIT(); asm volatile("" ::: "memory");
                int lane_t = lane; asm volatile("" : "+v"(lane_t));
                if (lane_t < 16) {
                    const int lane = lane_t;
                    const LAS float* lr = LG + lane * 81;
                    float gl[8]; float gmax = -INFINITY; int gi = 0;
#pragma unroll
                    for (int j = 0; j < 8; ++j) { gl[j] = lr[j] * rstd + a_bg[j]; if (gl[j] > gmax) { gmax = gl[j]; gi = j; } }
                    float gs = 0.f;
#pragma unroll
                    for (int j = 0; j < 8; ++j) gs += expf(gl[j] - gmax);
                    const float g_w = 1.f / gs;
                    float l1 = -INFINITY, l2 = -INFINITY; int i1 = 0, i2 = 0;
#pragma unroll
                    for (int j = 0; j < 8; ++j) { const float v = lr[16 + 8 * gi + j] * rstd + a_be[8 * gi + j];
                        if (v > l1) { l2 = l1; i2 = i1; l1 = v; i1 = j; } else if (v > l2) { l2 = v; i2 = j; } }
                    const float e1 = 1.f / (1.f + expf(l2 - l1)), e2 = 1.f - e1;
                    const int eid1 = gi * 8 + i1, eid2 = gi * 8 + i2;
                    const unsigned p1 = (unsigned)__hip_atomic_fetch_add(&MISC[320 + eid1], 1, __ATOMIC_RELAXED, __HIP_MEMORY_SCOPE_WORKGROUP), p2 = (unsigned)__hip_atomic_fetch_add(&MISC[320 + eid2], 1, __ATOMIC_RELAXED, __HIP_MEMORY_SCOPE_WORKGROUP);
                    u32x4 r0, r1; r0.x = (unsigned)eid1; r0.y = p1; r0.z = __float_as_uint(g_w * e1); r0.w = (unsigned)eid2; r1.x = p2; r1.y = __float_as_uint(g_w * e2); r1.z = 0u; r1.w = 0u;
                    *(u32x4*)(ASG + (size_t)(t0 + lane) * 8) = r0; *(u32x4*)(ASG + (size_t)(t0 + lane) * 8 + 4) = r1;
                    RSTD[t0 + lane] = rstd;
                }
                LDS_WAIT(); asm volatile("" ::: "memory");
            } else {
                LAS unsigned* T = (LAS unsigned*)(lds + wave * 8192);
                KArgP K2 = kargs(); const float* a_w1 = K2->w1; const float* a_w3 = K2->w3; const float* a_w2 = K2->w2;
                const int it = vcu + G * widx;
                int lane_c = lane; asm volatile("" : "+v"(lane_c));
                const int e = it / 192, r = it % 192;
                if (r < 64) transpose_tile_fp8<2, true>(a_w1 + (size_t)e * 1024 * 512, 1024, 512, (unsigned char*)(ws + WS_W13) + (size_t)e * 1024 * 1024, 0, T, r, lane_c, W8_SCALE);
                else if (r < 128) transpose_tile_fp8<2, true>(a_w3 + (size_t)e * 1024 * 512, 1024, 512, (unsigned char*)(ws + WS_W13) + (size_t)e * 1024 * 1024, 128, T, r - 64, lane_c, W8_SCALE);
                else transpose_tile_fp8<0, true>(a_w2 + (size_t)e * 512 * 1024, 512, 1024, (unsigned char*)(ws + WS_W2) + (size_t)e * 1024 * 512, 0, T, r - 128, lane_c, W8_SCALE);
                LDS_WAIT(); asm volatile("" ::: "memory");
            }
        }
        __syncthreads();
        if (tid < 64) ((int*)(ws + WS_CNTT))[vcu * 64 + tid] = MISC[320 + tid];
    }
#endif
    GSYNC(9);
    {
        PHASE_IDS;
        const int* CNTT = (const int*)(ws + WS_CNTT); LAS int* PS = (LAS int*)lds;
        {
            const int e = tid & 63; int tot = 0, bas = 0;
            for (int w = wave; w < G; w += NWAVES) { const int c = CNTT[w * 64 + e]; tot += c; bas += (w < vcu) ? c : 0; }
            PS[wave * 64 + e] = tot; PS[512 + wave * 64 + e] = bas;
        }
        __syncthreads();
        if (tid < 64) { int tot = 0, bas = 0;
#pragma unroll
            for (int q = 0; q < NWAVES; ++q) { tot += PS[q * 64 + tid]; bas += PS[512 + q * 64 + tid]; }
            l_cnt[tid] = tot; MISC[384 + tid] = bas; }
        __syncthreads();
        if (tid == 0) { int ts = 0, ss = 0; for (int e = 0; e < NEXP; ++e) { l_tstart[e] = ts; l_sstart[e] = ss; ts += (l_cnt[e] + 255) >> 8; ss += l_cnt[e]; } l_tstart[NEXP] = ts; l_sstart[NEXP] = ss; }
        __syncthreads();
        unsigned* ASG = (unsigned*)(ws + WS_ASG); int* TOKL = (int*)(ws + WS_TOKL);
        for (int tb = vcu * NWAVES; tb < NTOK / 16; tb += NGW) {
            if (tid < 256) {
                const int tok = tb * 16 + (tid >> 1), k = tid & 1;
                const unsigned eid = ASG[(size_t)tok * 8 + (k ? 3 : 0)], pos = ASG[(size_t)tok * 8 + (k ? 4 : 1)];
                const int slot = l_sstart[eid] + MISC[384 + eid] + (int)pos;
                TOKL[slot] = tok; ASG[(size_t)tok * 8 + 6 + k] = (unsigned)slot;
            }
        }
    }
    GSYNC(10);
#ifndef NO_P7
    {
        for (int pair = vcu; pair < NEXP * 4; pair += G) {
            const int e = pair >> 2, pn = pair & 3;
            const int cnt = l_cnt[e], sst = l_sstart[e], ntile = (cnt + 255) >> 8;
            for (int u0 = 0; u0 < ntile; u0 += ROFF_UNITS) {
                const int nb = (ntile - u0) < ROFF_UNITS ? (ntile - u0) : ROFF_UNITS;
                {
                    const int tid = opaque_tid(); const int* TOKL = (const int*)(ws + WS_TOKL); const float* RSTD = (const float*)(ws + WS_RSTD); LAS int* RO = (LAS int*)(lds + ROFF_OFF); LAS float* RS = (LAS float*)(lds + RSC_OFF);
                    for (int idx = tid; idx < nb * 256; idx += NTHREADS) { int row = u0 * 256 + idx; row = row < cnt ? row : cnt - 1; const int tok = TOKL[sst + row]; RO[idx] = tok * DM; RS[idx] = RSTD[tok] * W8_DESCALE; }
                }
                __syncthreads();
                pg8::ExpertOrder S{(const char*)(ws + WS_HN), (const char*)(ws + WS_W13), DM / 2, e, pn, cnt, sst, u0, nb};
                EpiSwiglu E{(unsigned char*)(ws + WS_HID), (const LAS float*)(lds + RSC_OFF), u0};
                pg8::gemm_phase<EpiSwiglu, pg8::ExpertOrder, true, true, true, true>(lds, DM / 2, S, E, (const LAS int*)(lds + ROFF_OFF), (const char*)(ws + WS_HN));
                __syncthreads();
            }
        }
    }
#endif
    GSYNC(11);
#ifndef NO_P8
    {
        for (int pair = vcu; pair < NEXP * 4; pair += G) {
            const int e = pair >> 2, pn = pair & 3;
            pg8::ExpertOrder S{(const char*)(ws + WS_HID), (const char*)(ws + WS_W2), 256, e, pn, l_cnt[e], l_sstart[e], 0, (l_cnt[e] + 255) >> 8};
            EpiDown E{(bf16_t*)(ws + WS_Y), W8_DESCALE};
            pg8::gemm_phase<EpiDown, pg8::ExpertOrder, true, true, false, true>(lds, 256, S, E);
            __syncthreads();
        }
    }
#endif
    GSYNC(12);
#endif
    {
        PHASE_IDS;
        const unsigned* ASG = (const unsigned*)(ws + WS_ASG); const bf16_t* Y = (const bf16_t*)(ws + WS_Y); const bf16_t* MIX = (const bf16_t*)(ws + WS_MIX);
        KArgP K_ = kargs(); const float* a_nf = K_->norm_final_w; float* a_out = K_->out; const float* H = K_->x;
        const f32x4* wf = (const f32x4*)a_nf + lane; f32x4 wfv[4];
#pragma unroll
        for (int j = 0; j < 4; ++j) wfv[j] = wf[64 * j];
        u32x4 ra0 = (u32x4){0u, 0u, 0u, 0u}, ra1 = ra0, rb0 = ra0, rb1 = ra0;
        if (gw < NTOK) { ra0 = *(const u32x4*)(ASG + (size_t)gw * 8); ra1 = *(const u32x4*)(ASG + (size_t)gw * 8 + 4); }
        if (gw + NGW < NTOK) { rb0 = *(const u32x4*)(ASG + (size_t)(gw + NGW) * 8); rb1 = *(const u32x4*)(ASG + (size_t)(gw + NGW) * 8 + 4); }
        for (int m = gw; m < NTOK; m += 2 * NGW) {
            const int m2 = m + NGW; const bool has2 = m2 < NTOK; const int mb = has2 ? m2 : m;
            const u32x4 a0 = ra0, a1 = ra1, b0 = rb0, b1 = rb1;
            { const int n1 = m + 2 * NGW, n2 = m + 3 * NGW;
              if (n1 < NTOK) { ra0 = *(const u32x4*)(ASG + (size_t)n1 * 8); ra1 = *(const u32x4*)(ASG + (size_t)n1 * 8 + 4); }
              if (n2 < NTOK) { rb0 = *(const u32x4*)(ASG + (size_t)n2 * 8); rb1 = *(const u32x4*)(ASG + (size_t)n2 * 8 + 4); } }
            const f32x4* xrA = (const f32x4*)(H + (size_t)m * DM) + lane; const u32x2* mrA = (const u32x2*)(MIX + (size_t)m * DM) + lane;
            const f32x4* xrB = (const f32x4*)(H + (size_t)mb * DM) + lane; const u32x2* mrB = (const u32x2*)(MIX + (size_t)mb * DM) + lane;
            f32x4 vA[4], vB[4];
#if EN_MOE
            const float gA1 = __uint_as_float(a0.z), gA2 = __uint_as_float(a1.y), gB1 = __uint_as_float(b0.z), gB2 = __uint_as_float(b1.y);
            const u32x2* yA1 = (const u32x2*)(Y + (size_t)a1.z * DM) + lane; const u32x2* yA2 = (const u32x2*)(Y + (size_t)a1.w * DM) + lane;
            const u32x2* yB1 = (const u32x2*)(Y + (size_t)(has2 ? b1.z : a1.z) * DM) + lane; const u32x2* yB2 = (const u32x2*)(Y + (size_t)(has2 ? b1.w : a1.w) * DM) + lane;
            u32x2 pA1[4], pA2[4], pB1[4], pB2[4];
#pragma unroll
            for (int j = 0; j < 4; ++j) { pA1[j] = yA1[64 * j]; pA2[j] = yA2[64 * j]; pB1[j] = yB1[64 * j]; pB2[j] = yB2[64 * j]; }
#endif
#pragma unroll
            for (int j = 0; j < 4; ++j) { const u32x2 mm = mrA[64 * j]; vA[j] = xrA[64 * j] + (f32x4){bf_lo(mm.x), bf_hi(mm.x), bf_lo(mm.y), bf_hi(mm.y)};
                                          const u32x2 mn = mrB[64 * j]; vB[j] = xrB[64 * j] + (f32x4){bf_lo(mn.x), bf_hi(mn.x), bf_lo(mn.y), bf_hi(mn.y)}; }
#if EN_MOE
#pragma unroll
            for (int j = 0; j < 4; ++j) {
                vA[j].x += gA1 * bf_lo(pA1[j].x) + gA2 * bf_lo(pA2[j].x); vA[j].y += gA1 * bf_hi(pA1[j].x) + gA2 * bf_hi(pA2[j].x); vA[j].z += gA1 * bf_lo(pA1[j].y) + gA2 * bf_lo(pA2[j].y); vA[j].w += gA1 * bf_hi(pA1[j].y) + gA2 * bf_hi(pA2[j].y);
                vB[j].x += gB1 * bf_lo(pB1[j].x) + gB2 * bf_lo(pB2[j].x); vB[j].y += gB1 * bf_hi(pB1[j].x) + gB2 * bf_hi(pB2[j].x); vB[j].z += gB1 * bf_lo(pB1[j].y) + gB2 * bf_lo(pB2[j].y); vB[j].w += gB1 * bf_hi(pB1[j].y) + gB2 * bf_hi(pB2[j].y); }
#endif
            float sA = 0.f, sB = 0.f;
#pragma unroll
            for (int j = 0; j < 4; ++j) { sA += (vA[j].x * vA[j].x + vA[j].y * vA[j].y) + (vA[j].z * vA[j].z + vA[j].w * vA[j].w); sB += (vB[j].x * vB[j].x + vB[j].y * vB[j].y) + (vB[j].z * vB[j].z + vB[j].w * vB[j].w); }
#pragma unroll
            for (int o_ = 1; o_ < 64; o_ <<= 1) { sA += __shfl_xor(sA, o_); sB += __shfl_xor(sB, o_); }
            const float rA = 1.f / sqrtf(sA * (1.f / DM) + NORM_EPS), rB = 1.f / sqrtf(sB * (1.f / DM) + NORM_EPS);
            float pscale = 1.f, padd = 0.f;
            if (PROBE_A >= 1) { const unsigned long long* ts = (const unsigned long long*)(ctl + CW_TS); const float us = (float)(ts[PROBE_A] - ts[PROBE_A0]) * 0.01f; pscale = 1.f + sqrtf(us * PROBE_SCALE); }
            if (PROBE_B >= 1) { const unsigned long long* ts = (const unsigned long long*)(ctl + CW_TS); const float us = (float)(ts[PROBE_B] - ts[PROBE_B0]) * 0.01f; if (m == 0 && lane == 0) padd = us * 0.01f; }
            f32x4* oA = (f32x4*)(a_out + (size_t)m * DM) + lane; f32x4* oB = (f32x4*)(a_out + (size_t)mb * DM) + lane;
#pragma unroll
            for (int j = 0; j < 4; ++j) { f32x4 r = vA[j] * (rA * pscale) * wfv[j]; if (j == 0) r.x += padd; oA[64 * j] = r; }
            if (has2) {
#pragma unroll
                for (int j = 0; j < 4; ++j) oB[64 * j] = vB[j] * (rB * pscale) * wfv[j];
            }
        }
    }
}

extern "C" void kernel_launch(void* const* d_in, const int* in_sizes, int n_in, void* d_out, int out_size, void* d_ws, size_t ws_size, hipStream_t stream) {
    static int grid = 0;
    if (grid == 0) {
        if (n_in != 19 || in_sizes[0] != NTOK * DM || out_size != NTOK * DM || ws_size < WS_END) { fprintf(stderr, "kernel_launch: unexpected problem (n_in %d, ws %zu)\n", n_in, ws_size); grid = -1; return; }
        int dev = 0, cus = 0, per_cu = 0;
        (void)hipGetDevice(&dev); (void)hipDeviceGetAttribute(&cus, hipDeviceAttributeMultiprocessorCount, dev);
        (void)hipFuncSetAttribute((const void*)mega_fwd, hipFuncAttributeMaxDynamicSharedMemorySize, LDS_BYTES);
        (void)hipOccupancyMaxActiveBlocksPerMultiprocessor(&per_cu, (const void*)mega_fwd, NTHREADS, LDS_BYTES);
        (void)hipGetLastError();
        if (per_cu < 1) { fprintf(stderr, "kernel_launch: occupancy query says %d blocks per CU\n", per_cu); per_cu = 1; }
        grid = cus;
    }
    if (grid < 0) return;
    (void)hipMemsetAsync((char*)d_ws + WS_CTL, 0, CTL_ZERO_BYTES, stream);
    Args a{};
    a.x = (const float*)d_in[0]; a.norm_mix_w = (const float*)d_in[1]; a.w_in = (const float*)d_in[2]; a.b_gate = (const float*)d_in[3]; a.dec_f = (const float*)d_in[4]; a.dec_b = (const float*)d_in[5];
    a.gn_w = (const float*)d_in[6]; a.w_a = (const float*)d_in[7]; a.w_b = (const float*)d_in[8]; a.w_o = (const float*)d_in[9]; a.norm_moe_w = (const float*)d_in[10]; a.wg = (const float*)d_in[11];
    a.bg = (const float*)d_in[12]; a.we = (const float*)d_in[13]; a.be = (const float*)d_in[14]; a.w1 = (const float*)d_in[15]; a.w3 = (const float*)d_in[16]; a.w2 = (const float*)d_in[17];
    a.norm_final_w = (const float*)d_in[18]; a.out = (float*)d_out; a.ws = (unsigned char*)d_ws;
    void* args[] = {&a};
    hipError_t e = hipLaunchCooperativeKernel((const void*)mega_fwd, dim3(grid), dim3(NTHREADS), args, LDS_BYTES, stream);
    if (e != hipSuccess) fprintf(stderr, "cooperative launch failed: %s (grid %d)\n", hipGetErrorString(e), grid);
}
```

```cpp
#include <hip/hip_runtime.h>
#include <hip/hip_cooperative_groups.h>
#include <cstdio>
#include <cstdint>
namespace cg = cooperative_groups;

#ifndef EN_ATT
#define EN_ATT 1
#endif
#ifndef EN_RET
#define EN_RET 1
#endif
#ifndef EN_MOE
#define EN_MOE 1
#endif

#define LAS __attribute__((address_space(3)))
#define GAS __attribute__((address_space(1)))
typedef unsigned short bf16_t;
typedef short bf16x8 __attribute__((ext_vector_type(8)));
typedef short s16x4 __attribute__((ext_vector_type(4)));
typedef float f32x4 __attribute__((ext_vector_type(4)));
typedef float f32x2 __attribute__((ext_vector_type(2)));
typedef unsigned u32x4 __attribute__((ext_vector_type(4)));
typedef unsigned u32x2 __attribute__((ext_vector_type(2)));

constexpr int NTOK = 32768, DM = 1024, SEQ = 2048, NBATCH = 16;
constexpr int IN_W = 9728;
constexpr int NEXP = 64;
constexpr float NORM_EPS = 1e-6f;
constexpr float LOG2E = 1.4426950408889634f, LN2 = 0.6931471805599453f;
constexpr float W8_SCALE = 32.f, W8_DESCALE = 1.f / 32.f;
constexpr float QA_SCALE = 0.125f * LOG2E;
constexpr int NWAVES = 8, NTHREADS = 512;

constexpr size_t MiB = (size_t)1 << 20;
constexpr size_t WS_CTL = 0, CTL_ZERO_BYTES = 65536;
constexpr size_t WS_COS = 1 * MiB, WS_SIN = WS_COS + 262144, WS_WR = WS_COS + 524288;
constexpr size_t WS_ASG = 2 * MiB;
constexpr size_t WS_LSE = 3 * MiB;
constexpr size_t WS_RSTD = 3 * MiB;
constexpr size_t WS_SRSTD = 3 * MiB + 262144;
constexpr size_t WS_TOKL = 4 * MiB;
constexpr size_t WS_CNTT = 5 * MiB;
constexpr size_t WS_WIN = 6 * MiB;
constexpr size_t WS_WA = 25 * MiB;
constexpr size_t WS_WB = 26 * MiB;
constexpr size_t WS_WO = 28 * MiB;
constexpr size_t WS_XN = 30 * MiB;
constexpr size_t WS_MERGED = 30 * MiB;
constexpr size_t WS_QA = 94 * MiB, WS_KA = 190 * MiB, WS_VA = 286 * MiB;
constexpr size_t WS_OUTG = 382 * MiB;
constexpr size_t WS_GATE = 350 * MiB;
constexpr size_t WS_QR = 94 * MiB, WS_KR = 126 * MiB;
constexpr size_t WS_VR = 158 * MiB, WS_GR = 222 * MiB;
constexpr size_t WS_SST = 286 * MiB;
constexpr size_t WS_MIX = 417 * MiB;
constexpr size_t WS_W2 = 30 * MiB;
constexpr size_t WS_W13 = 94 * MiB;
constexpr size_t WS_HN = 224 * MiB;
constexpr size_t WS_XS = 288 * MiB;
constexpr size_t WS_HID = 288 * MiB;
constexpr size_t WS_Y = 94 * MiB;
constexpr size_t WS_XN8 = 510 * MiB;
constexpr size_t WS_WIN8 = 542 * MiB;
constexpr size_t WS_WIN8G = 547 * MiB;
constexpr size_t WS_END = 549 * MiB;

constexpr int RING_BYTES = 131072;
constexpr int MISC_OFF = RING_BYTES;
constexpr int ROFF_OFF = MISC_OFF + 2048;
constexpr int ROFF_UNITS = 15;
constexpr int RSC_OFF = ROFF_OFF + ROFF_UNITS * 256 * 4;
constexpr int LDS_BYTES = 163840;

__device__ __forceinline__ unsigned cvt_pk_bf16(float lo, float hi) { unsigned r; asm volatile("v_cvt_pk_bf16_f32 %0, %1, %2" : "=v"(r) : "v"(lo), "v"(hi)); return r; }
__device__ __forceinline__ unsigned pk_fp8x4(float a, float b, float c, float d) { int w = 0; w = __builtin_amdgcn_cvt_pk_fp8_f32(a, b, w, false); w = __builtin_amdgcn_cvt_pk_fp8_f32(c, d, w, true); return (unsigned)w; }
__device__ __forceinline__ float bf_lo(unsigned w) { return __uint_as_float(w << 16); }
__device__ __forceinline__ float bf_hi(unsigned w) { return __uint_as_float(w & 0xffff0000u); }
__device__ __forceinline__ float fast_exp2(float x) { return __builtin_amdgcn_exp2f(x); }
__device__ __forceinline__ float fast_rcp(float x) { return __builtin_amdgcn_rcpf(x); }
__device__ __forceinline__ float sigmoidf_(float x) { return fast_rcp(1.f + fast_exp2(-x * LOG2E)); }
__device__ __forceinline__ float wave_sum(float v) {
#pragma unroll
    for (int o = 1; o < 64; o <<= 1) v += __shfl_xor(v, o);
    return v;
}
__device__ __forceinline__ s16x4 tr_read(const LAS char* p) {
    typedef short v4i16_t __attribute__((ext_vector_type(4)));
    return __builtin_bit_cast(s16x4, __builtin_amdgcn_ds_read_tr16_b64_v4i16((LAS v4i16_t*)p));
}
__device__ __forceinline__ bf16x8 cat4(s16x4 a, s16x4 b) { return (bf16x8){a[0], a[1], a[2], a[3], b[0], b[1], b[2], b[3]}; }
__device__ __forceinline__ int opaque_tid() { int t = threadIdx.x; asm volatile("" : "+v"(t)); return t; }
#define PHASE_IDS const int tid = opaque_tid(), lane = tid & 63, wave = __builtin_amdgcn_readfirstlane(tid >> 6); const int gw = vcu * NWAVES + wave; (void)gw; (void)lane
__device__ __forceinline__ void glds16(const void* gsrc, unsigned lds_dst) { unsigned keep;
    asm volatile("s_mov_b32 %0, m0\n\ts_mov_b32 m0, %2\n\ts_nop 0\n\tglobal_load_lds_dwordx4 %1, off\n\ts_mov_b32 m0, %0" : "=&s"(keep) : "v"(gsrc), "s"(lds_dst) : "memory"); }
#define LDS_WAIT() asm volatile("s_waitcnt lgkmcnt(0)" ::: "memory")
#define VM_WAIT() asm volatile("s_waitcnt vmcnt(0)" ::: "memory")

namespace pg8 {
constexpr int BM = 256, BK = 64, HALF = 128, HTB = HALF * BK * 2, STAGE_BYTES = 8 * HTB, NXCD = 8, WGM = 8;
__host__ __device__ __forceinline__ int lds_byte(int r, int c) { const int st = (r >> 4) * 2 + (c >> 5), rr = r & 15, cc = c & 31, ob = rr * 64 + cc * 2; return st * 1024 + (ob ^ (((ob >> 9) & 1) << 5)); }
__host__ __device__ __forceinline__ void stage_rc(int b, int& R, int& C) { const int st = b / 1024, sb = b % 1024, swz = sb ^ (((sb >> 9) & 1) << 5); R = (st >> 1) * 16 + swz / 64; C = (st & 1) * 32 + (swz % 64) / 2; }
__host__ __device__ __forceinline__ int g8(int r) { return ((r >> 1) & 1) | (((r >> 3) & 1) << 2); }
__host__ __device__ __forceinline__ int g16(int r) { return (r >> 1) & 7; }
__host__ __device__ __forceinline__ int perm32(int rho) { const int n = rho >> 4, i = rho & 15; return 8 * (i >> 2) + 4 * n + (i & 3); }

struct Unit { int pm, pn; const char* a; const char* b; int e, row0, nrows; };

struct StaticOrder {
    const char* A; const char* Bt; int K;
    int nM, nN, nwg, G, c;
    __device__ void init(const void* A_, const void* Bt_, int M, int N, int K_, int G_, int c_) { A = (const char*)A_; Bt = (const char*)Bt_; K = K_; nM = M / BM; nN = N / BM; nwg = nM * nN; G = G_; c = c_; }
    __device__ bool next(int i, Unit& u) const {
        const long L = (long)i * G + c; if (L >= nwg) return false;
        int wgid = (int)L; { const int q = nwg / NXCD, r = nwg % NXCD, xcd = wgid % NXCD, off = wgid / NXCD; wgid = (xcd < r ? xcd * (q + 1) : r * (q + 1) + (xcd - r) * q) + off; }
        const int nig = WGM * nN, gid = wgid / nig, fm = gid * WGM, gsz = (nM - fm) < WGM ? (nM - fm) : WGM;
        u.pm = fm + ((wgid % nig) % gsz); u.pn = (wgid % nig) / gsz;
        u.a = A + (size_t)u.pm * BM * K * 2; u.b = Bt + (size_t)u.pn * BM * K * 2; u.e = 0; u.row0 = u.pm * BM; u.nrows = BM; return true;
    }
};
struct GroupedOrder {
    const char* A; const char* Bt; int K; int G, c;
    const LAS int* cnt; const LAS int* tstart; const LAS int* sstart;
    __device__ bool next(int i, Unit& u) const {
        const int total = tstart[NEXP] * 4; const long L = (long)i * G + c; if (L >= total) return false;
        int wg = (int)L; { const int q = total / NXCD, r = total % NXCD, xcd = wg % NXCD, off = wg / NXCD; wg = (xcd < r ? xcd * (q + 1) : r * (q + 1) + (xcd - r) * q) + off; }
        const int mtg = wg >> 2; u.pn = wg & 3;
        int e = 0; while (e < NEXP - 1 && tstart[e + 1] <= mtg) ++e;
        u.e = e; u.pm = mtg - tstart[e]; u.row0 = sstart[e] + u.pm * BM; int nr = cnt[e] - u.pm * BM; u.nrows = nr < BM ? nr : BM;
        u.a = A + (size_t)u.row0 * K * 2; u.b = Bt + ((size_t)e * 1024 + (size_t)u.pn * BM) * K * 2; return true;
    }
};

struct ExpertOrder {
    const char* A; const char* Bt; int K; int e, pn, cnt, sstart, u0, nb;
    __device__ bool next(int i, Unit& u) const {
        if (i >= nb) return false;
        const int m = u0 + i;
        u.pm = m; u.pn = pn; u.e = e; u.row0 = sstart + m * BM; const int nr = cnt - m * BM; u.nrows = nr < BM ? nr : BM;
        u.a = A + (size_t)u.row0 * K * 2; u.b = Bt + ((size_t)e * 1024 + (size_t)pn * BM) * K * 2; return true;
    }
};

template <class Epi, class Sched, bool ALIGN_EPI, bool SP2, bool GATHER = false, bool FP8 = false>
__device__ __forceinline__ void gemm_phase(LAS unsigned char* lds, const int K, const Sched& S, const Epi& E, const LAS int* roff = nullptr, const char* gA = nullptr) {
    const int tid = opaque_tid(), wid = __builtin_amdgcn_readfirstlane(tid >> 6), lane = tid & 63, wr = wid >> 2, wc = wid & 3, fr = lane & 15, fq = lane >> 4;
    const int nt = K / BK;
    unsigned voffA[2], voffB[2];
#pragma unroll
    for (int i = 0; i < 2; ++i) { const int R = (tid >> 3) + 64 * i, C = 8 * ((tid & 7) ^ (FP8 ? g8(R) : g16(R)));
        const int Rb = Epi::PERM ? ((R & ~31) + perm32(R & 31)) : R;
        voffA[i] = (unsigned)(R * K + C) * 2u; voffB[i] = (unsigned)(Rb * K + C) * 2u; }
    const size_t kstep = (size_t)(BK * 2);
    const size_t hstep = (size_t)HALF * K * 2;
    unsigned vC[2][2], vN[2][2];
#define PG8_GLOAD(dst, ui_) do { _Pragma("unroll") for (int h_ = 0; h_ < 2; ++h_) _Pragma("unroll") for (int i_ = 0; i_ < 2; ++i_) { const int R_ = (tid >> 3) + 64 * i_, C_ = 8 * ((tid & 7) ^ (FP8 ? g8(R_) : g16(R_))); \
        dst[h_][i_] = (unsigned)roff[(ui_) * BM + h_ * HALF + R_] + (unsigned)(C_ * 2); } } while (0)
    const unsigned ldsw = (unsigned)wid * 1024u;
    const int aoff = (wr * 64 + fr) * 128 + (FP8 ? (((2 * fq) ^ g8(fr)) << 4) : ((fq ^ g16(fr)) << 4));
    const int boff = (wc * 32 + fr) * 128 + (FP8 ? (((2 * fq) ^ g8(fr)) << 4) : ((fq ^ g16(fr)) << 4));
    const int aoff2 = aoff ^ (FP8 ? 16 : 64), boff2 = boff ^ (FP8 ? 16 : 64);
    typedef int v8i_ __attribute__((ext_vector_type(8))); typedef int v4i_ __attribute__((ext_vector_type(4)));
#define PG8_SA(b, h) (((b) * 2 + (h)) * HTB)
#define PG8_SB(b, h) ((4 + (b) * 2 + (h)) * HTB)
#define PG8_STAGE(bufoff, gbase, voff) do { _Pragma("unroll") for (int _i = 0; _i < 2; ++_i) \
        __builtin_amdgcn_global_load_lds((const unsigned*)((const char*)(gbase) + (voff)[_i]), (LAS unsigned*)(lds + (bufoff) + ldsw + _i * 8192), 16, 0, 0); } while (0)
#define PG8_LD8_(p_, q_) __builtin_shufflevector(*(const LAS v4i_*)(p_), *(const LAS v4i_*)(q_), 0, 1, 2, 3, 4, 5, 6, 7)
#define PG8_LDA(dst, b, h) do { if constexpr (FP8) { _Pragma("unroll") for (int m = 0; m < 4; ++m) dst##8[m] = PG8_LD8_(lds + PG8_SA(b, h) + aoff + m * 2048, lds + PG8_SA(b, h) + aoff2 + m * 2048); } \
        else { _Pragma("unroll") for (int m = 0; m < 4; ++m) _Pragma("unroll") for (int k = 0; k < 2; ++k) dst[m][k] = *(const LAS bf16x8*)(lds + PG8_SA(b, h) + (k ? aoff2 : aoff) + m * 2048); } } while (0)
#define PG8_LDB(dst, b, h) do { if constexpr (FP8) { _Pragma("unroll") for (int n = 0; n < 2; ++n) dst##8[n] = PG8_LD8_(lds + PG8_SB(b, h) + boff + n * 2048, lds + PG8_SB(b, h) + boff2 + n * 2048); } \
        else { _Pragma("unroll") for (int n = 0; n < 2; ++n) _Pragma("unroll") for (int k = 0; k < 2; ++k) dst[n][k] = *(const LAS bf16x8*)(lds + PG8_SB(b, h) + (k ? boff2 : boff) + n * 2048); } } while (0)
#define PG8_MMA(ai, bj, At, Bt) do { __builtin_amdgcn_s_setprio(1); _Pragma("unroll") for (int m = 0; m < 4; ++m) _Pragma("unroll") for (int n = 0; n < 2; ++n) { \
        if constexpr (FP8) asm volatile("v_mfma_scale_f32_16x16x128_f8f6f4 %0, %1, %2, %0, %3, %3 op_sel_hi:[0,0,0]" : "+v"(acc[ai][bj][m][n]) : "v"(Bt##8[n]), "v"(At##8[m]), "v"(mxscale)); \
        else { _Pragma("unroll") for (int k = 0; k < 2; ++k) acc[ai][bj][m][n] = __builtin_amdgcn_mfma_f32_16x16x32_bf16(Bt[n][k], At[m][k], acc[ai][bj][m][n], 0, 0, 0); } } \
        __builtin_amdgcn_s_setprio(0); } while (0)
#define PG8_WAIT_V(n) asm volatile("s_waitcnt vmcnt(" #n ")" ::: "memory")
#define PG8_WAIT_L(n) asm volatile("s_waitcnt lgkmcnt(" #n ")" ::: "memory")
#define PG8_BAR __builtin_amdgcn_s_barrier()
#define PG8_SCHED __builtin_amdgcn_sched_barrier(0)
    Unit cur, nxt; int ui = 0;
    if (!S.next(0, cur)) return;
    f32x4 acc[2][2][4][2];
#pragma unroll
    for (int a = 0; a < 2; ++a)
#pragma unroll
        for (int b = 0; b < 2; ++b)
#pragma unroll
            for (int m = 0; m < 4; ++m)
#pragma unroll
                for (int n = 0; n < 2; ++n) acc[a][b][m][n] = (f32x4){0.f, 0.f, 0.f, 0.f};
    const int mxscale = 0x7f7f7f7f;
    bf16x8 At[4][2], B0[2][2], B1[2][2]; v8i_ At8[4], B08[2], B18[2];
    const char* cA = GATHER ? gA : cur.a; const char* cB = cur.b;
    if constexpr (GATHER) { PG8_GLOAD(vC, 0); PG8_WAIT_L(0); }
    if constexpr (SP2) {
        PG8_STAGE(PG8_SB(0, 0), cB, voffB); PG8_STAGE(PG8_SB(0, 1), cB + hstep, voffB);
        if constexpr (GATHER) { PG8_STAGE(PG8_SA(0, 0), cA, vC[0]); PG8_STAGE(PG8_SA(0, 1), cA, vC[1]); } else { PG8_STAGE(PG8_SA(0, 0), cA, voffA); PG8_STAGE(PG8_SA(0, 1), cA + hstep, voffA); }
        if (wr == 1) PG8_BAR;
        PG8_WAIT_V(2); PG8_BAR;
        PG8_STAGE(PG8_SB(1, 0), cB + kstep, voffB); if constexpr (GATHER) PG8_STAGE(PG8_SA(1, 0), cA + kstep, vC[0]); else PG8_STAGE(PG8_SA(1, 0), cA + kstep, voffA); PG8_STAGE(PG8_SB(1, 1), cB + hstep + kstep, voffB);
        PG8_WAIT_V(6); PG8_BAR;
    } else {
        PG8_STAGE(PG8_SB(0, 0), cB, voffB); PG8_STAGE(PG8_SA(0, 0), cA, voffA); PG8_STAGE(PG8_SB(0, 1), cB + hstep, voffB); PG8_STAGE(PG8_SA(0, 1), cA + hstep, voffA);
        if (wr == 1) PG8_BAR;
        PG8_WAIT_V(4); PG8_BAR;
        PG8_STAGE(PG8_SB(1, 0), cB + kstep, voffB); PG8_STAGE(PG8_SA(1, 0), cA + kstep, voffA); PG8_STAGE(PG8_SB(1, 1), cB + hstep + kstep, voffB);
        PG8_WAIT_V(6); PG8_BAR;
    }
    for (;;) {
        const bool has_next = S.next(ui + 1, nxt);
        const char* nA = GATHER ? cA : (has_next ? nxt.a : cA); const char* nB = has_next ? nxt.b : cB;
        if constexpr (GATHER) { if (has_next) { PG8_GLOAD(vN, ui + 1); } else { vN[0][0] = vC[0][0]; vN[0][1] = vC[0][1]; vN[1][0] = vC[1][0]; vN[1][1] = vC[1][1]; } }
#pragma unroll 1
        for (int t = 0; t < nt; t += 2) {
            const bool last = (t == nt - 2);
            const char* a1 = cA + (size_t)(t + 1) * kstep;
            const char* a2 = last ? nA : cA + (size_t)(t + 2) * kstep; const char* b2 = last ? nB : cB + (size_t)(t + 2) * kstep;
            const char* a3 = a2 + kstep; const char* b3 = b2 + kstep;
            if constexpr (Epi::MID_T >= 0) { if (t == Epi::MID_T) E.mid(acc, cur, wr, wc, fr, fq); }
            if constexpr (SP2) {
            if constexpr (GATHER) {
            unsigned g0[2] = {last ? vN[0][0] : vC[0][0], last ? vN[0][1] : vC[0][1]}, g1[2] = {last ? vN[1][0] : vC[1][0], last ? vN[1][1] : vC[1][1]};
            PG8_LDB(B0, 0, 0); PG8_LDB(B1, 0, 1); PG8_SCHED; PG8_LDA(At, 0, 0); PG8_STAGE(PG8_SA(1, 1), a1, vC[1]);
            PG8_WAIT_V(8); PG8_WAIT_L(0); PG8_BAR; PG8_MMA(0, 0, At, B0); PG8_MMA(0, 1, At, B1); PG8_BAR; PG8_SCHED;
            PG8_LDA(At, 0, 1); PG8_STAGE(PG8_SB(0, 0), b2, voffB); PG8_STAGE(PG8_SB(0, 1), b2 + hstep, voffB); PG8_STAGE(PG8_SA(0, 0), a2, g0);
            PG8_WAIT_V(8); PG8_WAIT_L(0); PG8_BAR; PG8_MMA(1, 0, At, B0); PG8_MMA(1, 1, At, B1); PG8_BAR; PG8_SCHED;
            PG8_LDB(B0, 1, 0); PG8_LDB(B1, 1, 1); PG8_SCHED; PG8_LDA(At, 1, 0); PG8_STAGE(PG8_SA(0, 1), a2, g1);
            PG8_WAIT_V(8); PG8_WAIT_L(0); PG8_BAR; PG8_MMA(0, 0, At, B0); PG8_MMA(0, 1, At, B1); PG8_BAR; PG8_SCHED;
            PG8_LDA(At, 1, 1); PG8_STAGE(PG8_SB(1, 0), b3, voffB); PG8_STAGE(PG8_SB(1, 1), b3 + hstep, voffB); PG8_STAGE(PG8_SA(1, 0), a3, g0);
            PG8_WAIT_V(8); PG8_WAIT_L(0); PG8_BAR; PG8_MMA(1, 0, At, B0); PG8_MMA(1, 1, At, B1); PG8_BAR; PG8_SCHED;
            } else {
            PG8_LDB(B0, 0, 0); PG8_LDB(B1, 0, 1); PG8_SCHED; PG8_LDA(At, 0, 0); PG8_STAGE(PG8_SA(1, 1), a1 + hstep, voffA);
            PG8_WAIT_V(8); PG8_WAIT_L(0); PG8_BAR; PG8_MMA(0, 0, At, B0); PG8_MMA(0, 1, At, B1); PG8_BAR; PG8_SCHED;
            PG8_LDA(At, 0, 1); PG8_STAGE(PG8_SB(0, 0), b2, voffB); PG8_STAGE(PG8_SB(0, 1), b2 + hstep, voffB); PG8_STAGE(PG8_SA(0, 0), a2, voffA);
            PG8_WAIT_V(8); PG8_WAIT_L(0); PG8_BAR; PG8_MMA(1, 0, At, B0); PG8_MMA(1, 1, At, B1); PG8_BAR; PG8_SCHED;
            PG8_LDB(B0, 1, 0); PG8_LDB(B1, 1, 1); PG8_SCHED; PG8_LDA(At, 1, 0); PG8_STAGE(PG8_SA(0, 1), a2 + hstep, voffA);
            PG8_WAIT_V(8); PG8_WAIT_L(0); PG8_BAR; PG8_MMA(0, 0, At, B0); PG8_MMA(0, 1, At, B1); PG8_BAR; PG8_SCHED;
            PG8_LDA(At, 1, 1); PG8_STAGE(PG8_SB(1, 0), b3, voffB); PG8_STAGE(PG8_SB(1, 1), b3 + hstep, voffB); PG8_STAGE(PG8_SA(1, 0), a3, voffA);
            PG8_WAIT_V(8); PG8_WAIT_L(0); PG8_BAR; PG8_MMA(1, 0, At, B0); PG8_MMA(1, 1, At, B1); PG8_BAR; PG8_SCHED;
            }
            } else {
            PG8_LDB(B0, 0, 0); PG8_SCHED; PG8_LDA(At, 0, 0); PG8_STAGE(PG8_SA(1, 1), a1 + hstep, voffA);
            PG8_WAIT_L(8); PG8_BAR; PG8_WAIT_L(0); PG8_MMA(0, 0, At, B0); PG8_BAR; PG8_SCHED;
            PG8_LDB(B1, 0, 1); PG8_STAGE(PG8_SB(0, 0), b2, voffB);
            PG8_BAR; PG8_WAIT_L(0); PG8_MMA(0, 1, At, B1); PG8_BAR;
            PG8_LDA(At, 0, 1); PG8_STAGE(PG8_SA(0, 0), a2, voffA);
            PG8_BAR; PG8_WAIT_L(0); PG8_MMA(1, 0, At, B0); PG8_BAR; PG8_SCHED;
            PG8_STAGE(PG8_SB(0, 1), b2 + hstep, voffB);
            PG8_WAIT_V(6); PG8_BAR; PG8_MMA(1, 1, At, B1); PG8_BAR;
            PG8_LDB(B0, 1, 0); PG8_SCHED; PG8_LDA(At, 1, 0); PG8_STAGE(PG8_SA(0, 1), a2 + hstep, voffA);
            PG8_WAIT_L(8); PG8_BAR; PG8_WAIT_L(0); PG8_MMA(0, 0, At, B0); PG8_BAR; PG8_SCHED;
            PG8_LDB(B1, 1, 1); PG8_STAGE(PG8_SB(1, 0), b3, voffB);
            PG8_BAR; PG8_WAIT_L(0); PG8_MMA(0, 1, At, B1); PG8_BAR;
            PG8_LDA(At, 1, 1); PG8_STAGE(PG8_SA(1, 0), a3, voffA);
            PG8_BAR; PG8_WAIT_L(0); PG8_MMA(1, 0, At, B0); PG8_BAR; PG8_SCHED;
            PG8_STAGE(PG8_SB(1, 1), b3 + hstep, voffB);
            PG8_WAIT_V(6); PG8_BAR; PG8_MMA(1, 1, At, B1); PG8_BAR;
            }
        }
        if constexpr (ALIGN_EPI) { if (wr == 0) PG8_BAR; }
        if constexpr (FP8) asm volatile("s_nop 15\n\ts_nop 15" ::: "memory");
        E(acc, cur, wr, wc, fr, fq);
        if (!has_next) break;
#pragma unroll
        for (int a = 0; a < 2; ++a)
#pragma unroll
            for (int b = 0; b < 2; ++b)
#pragma unroll
                for (int m = 0; m < 4; ++m)
#pragma unroll
                    for (int n = 0; n < 2; ++n) acc[a][b][m][n] = (f32x4){0.f, 0.f, 0.f, 0.f};
        cur = nxt; cA = nA; cB = nB; ++ui;
        if constexpr (GATHER) { vC[0][0] = vN[0][0]; vC[0][1] = vN[0][1]; vC[1][0] = vN[1][0]; vC[1][1] = vN[1][1]; }
        if constexpr (ALIGN_EPI) { if (wr == 1) PG8_BAR; }
    }
    PG8_WAIT_V(0);
    if constexpr (!ALIGN_EPI) { if (wr == 0) PG8_BAR; }
    PG8_BAR;
#undef PG8_GLOAD
#undef PG8_SA
#undef PG8_SB
#undef PG8_STAGE
#undef PG8_LDA
#undef PG8_LD8_
#undef PG8_LDB
#undef PG8_MMA
#undef PG8_WAIT_V
#undef PG8_WAIT_L
#undef PG8_BAR
#undef PG8_SCHED
}
}

struct RotF { float f[4]; };
__device__ __forceinline__ RotF rot_freqs(int q) { RotF r;
#pragma unroll
    for (int i = 0; i < 4; ++i) r.f[i] = fast_exp2(-(float)(2 * (4 * q + i)) * (13.287712379549449f / 64.f)) * 0.15915494309189535f;
    return r; }
__device__ __forceinline__ void rot_cs(const RotF& rf, int pos, f32x4& c4, f32x4& s4) {
    const float p = (float)pos;
#pragma unroll
    for (int i = 0; i < 4; ++i) { const float r = __builtin_amdgcn_fractf(p * rf.f[i]); c4[i] = __builtin_amdgcn_cosf(r); s4[i] = __builtin_amdgcn_sinf(r); }
}

typedef f32x4 acc_t[2][2][4][2];

struct EpiProj {
    static constexpr bool PERM = true; static constexpr int MID_T = -1;
    unsigned char* ws; bf16_t* gate; const float* bias; int pn_off; float descale;
    __device__ __forceinline__ void operator()(const acc_t& acc, const pg8::Unit& u, int wr, int wc, int fr, int fq) const {
        asm volatile("" : "+v"(fr), "+v"(fq));
        const int pn = u.pn + pn_off;
        const int row0 = u.pm * 256 + wr * 64 + fr;
        int mode, ld, colt; bf16_t* base; float sc = descale;
        if (pn < 6) { mode = 0; base = (bf16_t*)(ws + WS_QA); ld = 1536; colt = pn * 256; sc = QA_SCALE * descale; }
        else if (pn < 12) { mode = 0; base = (bf16_t*)(ws + WS_KA); ld = 1536; colt = (pn - 6) * 256; }
        else if (pn < 18) { mode = 1; base = (bf16_t*)(ws + WS_VA); ld = 1536; colt = (pn - 12) * 256; }
        else if (pn < 20) { mode = 0; base = (bf16_t*)(ws + WS_QR); ld = 512; colt = (pn - 18) * 256; }
        else if (pn < 22) { mode = 0; base = (bf16_t*)(ws + WS_KR); ld = 512; colt = (pn - 20) * 256; sc = 0.125f * descale; }
        else if (pn < 26) { mode = 1; base = (bf16_t*)(ws + WS_VR); ld = 1024; colt = (pn - 22) * 256; }
        else if (pn < 30) { mode = 2; base = (bf16_t*)(ws + WS_GR); ld = 1024; colt = (pn - 26) * 256; }
        else { mode = 3; base = (bf16_t*)(ws + WS_GATE); ld = 2048; colt = (pn - 30) * 256; }
        if (mode == 0) {
            const int q = 4 * (wc & 1) + fq; const RotF rf = rot_freqs(q);
#pragma unroll
            for (int ai = 0; ai < 2; ++ai)
#pragma unroll
                for (int m = 0; m < 4; ++m) {
                    const int row = row0 + ai * 128 + m * 16; const int pos = row & (SEQ - 1);
                    f32x4 c4, s4; rot_cs(rf, pos, c4, s4);
#pragma unroll
                    for (int bj = 0; bj < 2; ++bj) {
                        const f32x4 t1 = acc[ai][bj][m][0], t2 = acc[ai][bj][m][1];
                        const f32x4 o1 = (t1 * c4 - t2 * s4) * sc, o2 = (t1 * s4 + t2 * c4) * sc;
                        bf16_t* p = base + (size_t)row * ld + colt + 128 * bj + 64 * (wc >> 1) + 8 * q;
                        u32x4 w; w.x = cvt_pk_bf16(o1[0], o1[1]); w.y = cvt_pk_bf16(o1[2], o1[3]); w.z = cvt_pk_bf16(o2[0], o2[1]); w.w = cvt_pk_bf16(o2[2], o2[3]);
                        *(u32x4*)p = w;
                    }
                }
        } else {
            const int col0 = colt + wc * 32 + 8 * fq;
            if (mode == 1) {
#pragma unroll
                for (int ai = 0; ai < 2; ++ai)
#pragma unroll
                    for (int m = 0; m < 4; ++m) {
                        bf16_t* rowp = base + (size_t)(row0 + ai * 128 + m * 16) * ld + col0;
#pragma unroll
                        for (int bj = 0; bj < 2; ++bj) { const f32x4 v0 = acc[ai][bj][m][0] * sc, v1 = acc[ai][bj][m][1] * sc;
                            u32x4 w; w.x = cvt_pk_bf16(v0[0], v0[1]); w.y = cvt_pk_bf16(v0[2], v0[3]); w.z = cvt_pk_bf16(v1[0], v1[1]); w.w = cvt_pk_bf16(v1[2], v1[3]);
                            *(u32x4*)(rowp + bj * 128) = w; }
                    }
            } else if (mode == 2) {
                const float ks = -sc * LOG2E;
#pragma unroll
                for (int ai = 0; ai < 2; ++ai)
#pragma unroll
                    for (int m = 0; m < 4; ++m) {
                        bf16_t* rowp = base + (size_t)(row0 + ai * 128 + m * 16) * ld + col0;
#pragma unroll
                        for (int bj = 0; bj < 2; ++bj) {
                            const f32x4 a0 = acc[ai][bj][m][0], a1 = acc[ai][bj][m][1];
                            f32x4 e0 = a0 * ks, e1 = a1 * ks;
#pragma unroll
                            for (int i = 0; i < 4; ++i) { e0[i] = fast_exp2(e0[i]); e1[i] = fast_exp2(e1[i]); }
                            e0 = e0 + 1.f; e1 = e1 + 1.f;
#pragma unroll
                            for (int i = 0; i < 4; ++i) { e0[i] = fast_rcp(e0[i]); e1[i] = fast_rcp(e1[i]); }
                            const f32x4 v0 = (a0 * sc) * e0, v1 = (a1 * sc) * e1;
                            u32x4 w; w.x = cvt_pk_bf16(v0[0], v0[1]); w.y = cvt_pk_bf16(v0[2], v0[3]); w.z = cvt_pk_bf16(v1[0], v1[1]); w.w = cvt_pk_bf16(v1[2], v1[3]);
                            *(u32x4*)(rowp + bj * 128) = w; }
                    }
            } else {
                const float ks = -sc * LOG2E;
                f32x4 nb[2][2];
#pragma unroll
                for (int bj = 0; bj < 2; ++bj)
#pragma unroll
                    for (int n = 0; n < 2; ++n) nb[bj][n] = *(const f32x4*)(bias + col0 + bj * 128 + 4 * n) * (-LOG2E);
#pragma unroll
                for (int ai = 0; ai < 2; ++ai)
#pragma unroll
                    for (int m = 0; m < 4; ++m) {
                        bf16_t* rowp = base + (size_t)(row0 + ai * 128 + m * 16) * ld + col0;
#pragma unroll
                        for (int bj = 0; bj < 2; ++bj) {
                            f32x4 e0 = acc[ai][bj][m][0] * ks + nb[bj][0], e1 = acc[ai][bj][m][1] * ks + nb[bj][1];
#pragma unroll
                            for (int i = 0; i < 4; ++i) { e0[i] = fast_exp2(e0[i]); e1[i] = fast_exp2(e1[i]); }
                            e0 = e0 + 1.f; e1 = e1 + 1.f;
#pragma unroll
                            for (int i = 0; i < 4; ++i) { e0[i] = fast_rcp(e0[i]); e1[i] = fast_rcp(e1[i]); }
                            u32x4 w; w.x = cvt_pk_bf16(e0[0], e0[1]); w.y = cvt_pk_bf16(e0[2], e0[3]); w.z = cvt_pk_bf16(e1[0], e1[1]); w.w = cvt_pk_bf16(e1[2], e1[3]);
                            *(u32x4*)(rowp + bj * 128) = w; }
                    }
            }
        }
    }
};

struct EpiProjAtt {
    static constexpr bool PERM = true; static constexpr int MID_T = -1;
    unsigned char* ws; float descale;
    __device__ __forceinline__ void operator()(const acc_t& acc, const pg8::Unit& u, int wr, int wc, int, int) const {
        const int lane_ = opaque_tid() & 63, fr = lane_ & 15, fq = lane_ >> 4;
        const int pn = u.pn, row0 = u.pm * 256 + wr * 64 + fr;
        bf16_t* base = (bf16_t*)(ws + (pn < 6 ? WS_QA : (pn < 12 ? WS_KA : WS_VA))); const int pt = (pn < 6 ? pn : (pn < 12 ? pn - 6 : pn - 12));
        const float sc = (pn < 6 ? QA_SCALE : 1.f) * descale;
        const int grp = pt >> 1;
        if (pn < 12) {
            const int q = 4 * (wc & 1) + fq; const RotF rf = rot_freqs(q);
#pragma unroll
            for (int ai = 0; ai < 2; ++ai)
#pragma unroll
                for (int m = 0; m < 4; ++m) {
                    const int row = row0 + ai * 128 + m * 16; const int pos = row & (SEQ - 1), b = row >> 11;
                    f32x4 c4, s4; rot_cs(rf, pos, c4, s4);
#pragma unroll
                    for (int bj = 0; bj < 2; ++bj) {
                        const f32x4 t1 = acc[ai][bj][m][0], t2 = acc[ai][bj][m][1];
                        const f32x4 o1 = (t1 * c4 - t2 * s4) * sc, o2 = (t1 * s4 + t2 * c4) * sc;
                        const int hd = 4 * (pt & 1) + 2 * bj + (wc >> 1);
                        bf16_t* p = base + ((size_t)((b * 3 + grp) * 8 + hd) * SEQ + pos) * 64 + 8 * q;
                        u32x4 w; w.x = cvt_pk_bf16(o1[0], o1[1]); w.y = cvt_pk_bf16(o1[2], o1[3]); w.z = cvt_pk_bf16(o2[0], o2[1]); w.w = cvt_pk_bf16(o2[2], o2[3]);
                        *(u32x4*)p = w;
                    }
                }
        } else {
#pragma unroll
            for (int ai = 0; ai < 2; ++ai)
#pragma unroll
                for (int m = 0; m < 4; ++m) {
                    const int row = row0 + ai * 128 + m * 16; const int pos = row & (SEQ - 1), b = row >> 11;
#pragma unroll
                    for (int bj = 0; bj < 2; ++bj) {
                        const f32x4 v0 = acc[ai][bj][m][0] * sc, v1 = acc[ai][bj][m][1] * sc;
                        const int hd = 4 * (pt & 1) + 2 * bj + (wc >> 1);
                        bf16_t* p = base + ((size_t)((b * 3 + grp) * 8 + hd) * SEQ + pos) * 64 + 32 * (wc & 1) + 8 * fq;
                        u32x4 w; w.x = cvt_pk_bf16(v0[0], v0[1]); w.y = cvt_pk_bf16(v0[2], v0[3]); w.z = cvt_pk_bf16(v1[0], v1[1]); w.w = cvt_pk_bf16(v1[2], v1[3]);
                        *(u32x4*)p = w;
                    }
                }
        }
    }
};
struct EpiMerge {
    static constexpr bool PERM = true; static constexpr int MID_T = 8;
    bf16_t* out; const bf16_t* gate;
    __device__ __forceinline__ void mid(acc_t& acc, const pg8::Unit& u, int wr, int wc, int fr, int fq) const {
        int row0 = u.pm * 256 + wr * 64 + fr, col0 = u.pn * 256 + wc * 32 + 8 * fq;
        asm volatile("" : "+v"(row0), "+v"(col0));
#pragma unroll
        for (int ai = 0; ai < 2; ++ai) {
            u32x4 ga[4][2], gb[4][2];
#pragma unroll
            for (int m = 0; m < 4; ++m)
#pragma unroll
                for (int bj = 0; bj < 2; ++bj) { const bf16_t* gp = gate + (size_t)(row0 + ai * 128 + m * 16) * 2048 + col0 + bj * 128; ga[m][bj] = *(const u32x4*)gp; gb[m][bj] = *(const u32x4*)(gp + 1024); }
            asm volatile("" ::: "memory");
#pragma unroll
            for (int m = 0; m < 4; ++m)
#pragma unroll
                for (int bj = 0; bj < 2; ++bj) { const u32x4 a = ga[m][bj], b = gb[m][bj];
                    acc[ai][bj][m][0][0] *= bf_lo(a.x) * fast_rcp(bf_lo(b.x)); acc[ai][bj][m][0][1] *= bf_hi(a.x) * fast_rcp(bf_hi(b.x));
                    acc[ai][bj][m][0][2] *= bf_lo(a.y) * fast_rcp(bf_lo(b.y)); acc[ai][bj][m][0][3] *= bf_hi(a.y) * fast_rcp(bf_hi(b.y));
                    acc[ai][bj][m][1][0] *= bf_lo(a.z) * fast_rcp(bf_lo(b.z)); acc[ai][bj][m][1][1] *= bf_hi(a.z) * fast_rcp(bf_hi(b.z));
                    acc[ai][bj][m][1][2] *= bf_lo(a.w) * fast_rcp(bf_lo(b.w)); acc[ai][bj][m][1][3] *= bf_hi(a.w) * fast_rcp(bf_hi(b.w)); }
            asm volatile("" ::: "memory");
        }
    }
    __device__ __forceinline__ void operator()(const acc_t& acc, const pg8::Unit& u, int wr, int wc, int fr, int fq) const {
        const int row0 = u.pm * 256 + wr * 64 + fr, col0 = u.pn * 256 + wc * 32 + 8 * fq;
        u32x4 g[2][4][2];
#pragma unroll
        for (int ai = 0; ai < 2; ++ai)
#pragma unroll
            for (int m = 0; m < 4; ++m)
#pragma unroll
                for (int bj = 0; bj < 2; ++bj) g[ai][m][bj] = *(const u32x4*)(gate + (size_t)(row0 + ai * 128 + m * 16) * 2048 + 1024 + col0 + bj * 128);
        asm volatile("" ::: "memory");
#pragma unroll
        for (int ai = 0; ai < 2; ++ai)
#pragma unroll
            for (int m = 0; m < 4; ++m) {
                const size_t row = (size_t)(row0 + ai * 128 + m * 16);
#pragma unroll
                for (int bj = 0; bj < 2; ++bj) {
                    const u32x4 gg = g[ai][m][bj];
                    f32x4 v0 = acc[ai][bj][m][0], v1 = acc[ai][bj][m][1];
                    v0[0] *= bf_lo(gg.x); v0[1] *= bf_hi(gg.x); v0[2] *= bf_lo(gg.y); v0[3] *= bf_hi(gg.y);
                    v1[0] *= bf_lo(gg.z); v1[1] *= bf_hi(gg.z); v1[2] *= bf_lo(gg.w); v1[3] *= bf_hi(gg.w);
                    u32x4 w; w.x = cvt_pk_bf16(v0[0], v0[1]); w.y = cvt_pk_bf16(v0[2], v0[3]); w.z = cvt_pk_bf16(v1[0], v1[1]); w.w = cvt_pk_bf16(v1[2], v1[3]);
                    *(u32x4*)(out + row * 1024 + col0 + bj * 128) = w;
                }
            }
    }
};
struct EpiPlain {
    static constexpr bool PERM = true; static constexpr int MID_T = -1;
    bf16_t* O;
    __device__ __forceinline__ void operator()(const acc_t& acc, const pg8::Unit& u, int wr, int wc, int fr, int fq) const {
        const int row0 = u.pm * 256 + wr * 64 + fr, col0 = u.pn * 256 + wc * 32 + 8 * fq;
#pragma unroll
        for (int ai = 0; ai < 2; ++ai)
#pragma unroll
            for (int m = 0; m < 4; ++m) {
                bf16_t* rowp = O + (size_t)(row0 + ai * 128 + m * 16) * 1024 + col0;
#pragma unroll
                for (int bj = 0; bj < 2; ++bj) { const f32x4 v0 = acc[ai][bj][m][0], v1 = acc[ai][bj][m][1];
                    u32x4 w; w.x = cvt_pk_bf16(v0[0], v0[1]); w.y = cvt_pk_bf16(v0[2], v0[3]); w.z = cvt_pk_bf16(v1[0], v1[1]); w.w = cvt_pk_bf16(v1[2], v1[3]);
                    *(u32x4*)(rowp + bj * 128) = w; }
            }
    }
};
struct EpiSwiglu {
    static constexpr bool PERM = true; static constexpr int MID_T = -1;
    unsigned char* hid; const LAS float* rs_tab; int u0;
    __device__ __forceinline__ void operator()(const acc_t& acc, const pg8::Unit& u, int wr, int wc, int, int) const {
        const int lane_ = opaque_tid() & 63, fr = lane_ & 15, fq = lane_ >> 4;
        const int col0 = u.pn * 128 + wc * 32 + 8 * fq;
#pragma unroll
        for (int ai = 0; ai < 2; ++ai)
#pragma unroll
            for (int m = 0; m < 4; ++m) {
                const int rl = ai * 128 + wr * 64 + m * 16 + fr;
                const float rs = rs_tab[(u.pm - u0) * 256 + rl];
                f32x4 v0, v1;
#pragma unroll
                for (int i = 0; i < 4; ++i) { const float a0 = acc[ai][0][m][0][i] * rs, a1 = acc[ai][0][m][1][i] * rs;
                    v0[i] = a0 * sigmoidf_(a0) * (acc[ai][1][m][0][i] * rs); v1[i] = a1 * sigmoidf_(a1) * (acc[ai][1][m][1][i] * rs); }
                u32x2 w; w.x = pk_fp8x4(v0[0], v0[1], v0[2], v0[3]); w.y = pk_fp8x4(v1[0], v1[1], v1[2], v1[3]);
                if (rl < u.nrows) *(u32x2*)(hid + (size_t)(u.row0 + rl) * 512 + col0) = w;
            }
    }
};
struct EpiDown {
    static constexpr bool PERM = true; static constexpr int MID_T = -1;
    bf16_t* Y; float descale;
    __device__ __forceinline__ void operator()(const acc_t& acc, const pg8::Unit& u, int wr, int wc, int fr, int fq) const {
        const int col0 = u.pn * 256 + wc * 32 + 8 * fq;
#pragma unroll
        for (int ai = 0; ai < 2; ++ai)
#pragma unroll
            for (int m = 0; m < 4; ++m) {
                const int rl = ai * 128 + wr * 64 + m * 16 + fr;
#pragma unroll
                for (int bj = 0; bj < 2; ++bj) {
                    const f32x4 v0 = acc[ai][bj][m][0] * descale, v1 = acc[ai][bj][m][1] * descale;
                    u32x4 w; w.x = cvt_pk_bf16(v0[0], v0[1]); w.y = cvt_pk_bf16(v0[2], v0[3]); w.z = cvt_pk_bf16(v1[0], v1[1]); w.w = cvt_pk_bf16(v1[2], v1[3]);
                    if (rl < u.nrows) *(u32x4*)(Y + (size_t)(u.row0 + rl) * 1024 + col0 + bj * 128) = w;
                }
            }
    }
};

struct Args {
    const float* x; const float* norm_mix_w; const float* w_in; const float* b_gate; const float* dec_f; const float* dec_b; const float* gn_w;
    const float* w_a; const float* w_b; const float* w_o; const float* norm_moe_w; const float* wg; const float* bg; const float* we; const float* be;
    const float* w1; const float* w3; const float* w2; const float* norm_final_w;
    float* out; unsigned char* ws;
};

template <int MAP>
__device__ __forceinline__ void transpose_item(const float* W, int K, int N, bf16_t* WT, int row_off, LAS float* scr, int item, int lane, const float* kscale) {
    const int nblk = N / 32, kb = item / nblk, nb = item % nblk, k0 = 64 * kb, n0 = 32 * nb;
#pragma unroll 8
    for (int i = 0; i < 32; ++i) { const int kk = 2 * i + (lane >> 5); float v = W[(size_t)(k0 + kk) * N + n0 + (lane & 31)]; if (kscale) v *= kscale[k0 + kk]; scr[kk * 33 + (lane & 31)] = v; }
    LDS_WAIT(); asm volatile("" ::: "memory");
    const int c = lane & 7;
#pragma unroll
    for (int j = 0; j < 4; ++j) { const int n = (lane >> 3) + 8 * j; const LAS float* s = scr + (8 * c) * 33 + n;
        u32x4 o; o.x = cvt_pk_bf16(s[0 * 33], s[1 * 33]); o.y = cvt_pk_bf16(s[2 * 33], s[3 * 33]); o.z = cvt_pk_bf16(s[4 * 33], s[5 * 33]); o.w = cvt_pk_bf16(s[6 * 33], s[7 * 33]);
        const int lc = n0 + n; int dr;
        if (MAP == 0) dr = row_off + lc;
        else if (MAP == 1) dr = row_off + (lc & ~63) + 8 * ((lc & 31) >> 2) + 4 * ((lc >> 5) & 1) + (lc & 3);
        else dr = (lc >> 7) * 256 + row_off + (lc & 127);
        *(u32x4*)(WT + (size_t)dr * K + k0 + 8 * c) = o; }
    LDS_WAIT(); asm volatile("" ::: "memory");
}

template <int MAP, bool NT>
__device__ __forceinline__ void transpose_tile64(const float* W, int K, int N, bf16_t* WT, int row_off, LAS unsigned* T, int item, int lane, int ldw = 0, int koff = 0) {
    if (ldw == 0) ldw = K;
    const int kblk = K / 64, nb = item / kblk, kb = item % kblk, k0 = 64 * kb, n0 = 64 * nb;
    const int kp = lane >> 4, n4 = lane & 15;
    f32x4 ra[8], rb[8];
    const float* src = W + (size_t)(k0 + 2 * kp) * N + n0 + 4 * n4;
#pragma unroll
    for (int i = 0; i < 8; ++i) {
        const f32x4* pa = (const f32x4*)(src + (size_t)(8 * i) * N); const f32x4* pb = (const f32x4*)(src + (size_t)(8 * i + 1) * N);
        if (NT) { ra[i] = __builtin_nontemporal_load(pa); rb[i] = __builtin_nontemporal_load(pb); } else { ra[i] = *pa; rb[i] = *pb; }
    }
#pragma unroll
    for (int i = 0; i < 8; ++i)
#pragma unroll
        for (int c = 0; c < 4; ++c) { const int n = 4 * n4 + c, kpair = 4 * i + kp; T[n * 32 + (kpair ^ (((n >> 2) & 7) << 2))] = cvt_pk_bf16(ra[i][c], rb[i][c]); }
#pragma unroll
    for (int j = 0; j < 8; ++j) {
        const int row = 8 * j + (lane >> 3), chunk = lane & 7;
        const u32x4 v = *(const LAS u32x4*)(T + row * 32 + 4 * (chunk ^ ((row >> 2) & 7)));
        const int lc = n0 + row; int dr;
        if (MAP == 0) dr = row_off + lc;
        else if (MAP == 1) dr = row_off + (lc & ~63) + 8 * ((lc & 31) >> 2) + 4 * ((lc >> 5) & 1) + (lc & 3);
        else dr = (lc >> 7) * 256 + row_off + (lc & 127);
        *(u32x4*)(WT + (size_t)dr * ldw + koff + k0 + 8 * chunk) = v;
    }
}

template <int MAP, bool NT>
__device__ __forceinline__ void transpose_tile_fp8(const float* W, int K, int N, unsigned char* WT, int row_off, LAS unsigned* T, int item, int lane, float scale) {
    const int kblk = K / 128, nb = item / kblk, kb = item % kblk, k0 = 128 * kb, n0 = 64 * nb;
    const int kp = lane >> 4, n4 = lane & 15;
#pragma unroll
    for (int hh = 0; hh < 2; ++hh) {
        f32x4 r[4][4];
        const float* src = W + (size_t)(k0 + 64 * hh + 4 * kp) * N + n0 + 4 * n4;
#pragma unroll
        for (int i = 0; i < 4; ++i)
#pragma unroll
            for (int q = 0; q < 4; ++q) { const f32x4* p = (const f32x4*)(src + (size_t)(16 * i + q) * N); if (NT) r[i][q] = __builtin_nontemporal_load(p); else r[i][q] = *p; }
#pragma unroll
        for (int i = 0; i < 4; ++i)
#pragma unroll
            for (int c = 0; c < 4; ++c) { const int n = 4 * n4 + c, kq = 16 * hh + 4 * i + kp;
                T[n * 32 + (kq ^ (((n >> 2) & 7) << 2))] = pk_fp8x4(r[i][0][c] * scale, r[i][1][c] * scale, r[i][2][c] * scale, r[i][3][c] * scale); }
    }
#pragma unroll
    for (int j = 0; j < 8; ++j) {
        const int row = 8 * j + (lane >> 3), chunk = lane & 7;
        const u32x4 v = *(const LAS u32x4*)(T + row * 32 + 4 * (chunk ^ ((row >> 2) & 7)));
        const int lc = n0 + row; int dr;
        if (MAP == 0) dr = row_off + lc;
        else if (MAP == 1) dr = row_off + (lc & ~63) + 8 * ((lc & 31) >> 2) + 4 * ((lc >> 5) & 1) + (lc & 3);
        else dr = (lc >> 7) * 256 + row_off + (lc & 127);
        *(u32x4*)(WT + (size_t)dr * K + k0 + 16 * chunk) = v;
    }
}

__device__ __forceinline__ void rms_row_to_bf16(const float* xrow, const float* w, bf16_t* orow, int lane) {
    const f32x4* xr = (const f32x4*)xrow + lane; const f32x4* wr_ = (const f32x4*)w + lane;
    f32x4 v[4]; float s = 0.f;
#pragma unroll
    for (int j = 0; j < 4; ++j) { v[j] = xr[64 * j]; s += (v[j].x * v[j].x + v[j].y * v[j].y) + (v[j].z * v[j].z + v[j].w * v[j].w); }
    const float rstd = 1.f / sqrtf(wave_sum(s) * (1.f / DM) + NORM_EPS);
    u32x2* o8 = (u32x2*)orow + lane;
#pragma unroll
    for (int j = 0; j < 4; ++j) { const f32x4 ww = wr_[64 * j]; u32x2 o; o.x = cvt_pk_bf16(v[j].x * rstd * ww.x, v[j].y * rstd * ww.y); o.y = cvt_pk_bf16(v[j].z * rstd * ww.z, v[j].w * rstd * ww.w); o8[64 * j] = o; }
}

__device__ __forceinline__ float log_sigmoid(float x) { return x >= 0.f ? -log1pf(expf(-x)) : x - log1pf(expf(x)); }


#define XB_TMO      128
#define XB_XCNT(j)  (256  + 64 * (j))
#define XB_XSUB(j)  (1280 + 64 * (j))
#define XB_XGEN(j)  (2304 + 64 * (j))
#define XB_TOP      3328
#define XB_TOPGEN   3392
#define XCD_BAR_WORDS 3456
#define XB_SPIN_CAP (1u << 18)
__device__ __forceinline__ unsigned xb_ld(unsigned* p)              { return __hip_atomic_load(p, __ATOMIC_RELAXED, __HIP_MEMORY_SCOPE_AGENT); }
__device__ __forceinline__ unsigned xb_add(unsigned* p, unsigned v) { return __hip_atomic_fetch_add(p, v, __ATOMIC_RELAXED, __HIP_MEMORY_SCOPE_AGENT); }
__device__ __forceinline__ unsigned xb_xcc_id() { return (unsigned)__builtin_amdgcn_s_getreg((3 << 11) | 20) & 0xFu; }
#define XB_SPIN(cond, bar) do { unsigned _sp = 0; while (cond) { __builtin_amdgcn_s_sleep(1); \
    if ((++_sp & 255u) == 0u) { if (xb_ld(&(bar)[XB_TMO])) break; if (_sp > XB_SPIN_CAP) { atomicAdd(&(bar)[XB_TMO], 1u); break; } } } } while (0)
struct XcdBarrier { unsigned* bar; unsigned x; volatile LAS unsigned* st; };
__device__ __forceinline__ XcdBarrier xcd_barrier_post(unsigned* bar, volatile LAS unsigned* st) {
    XcdBarrier b; b.bar = bar; b.x = xb_xcc_id(); b.st = st;
    if (threadIdx.x == 0) (void)xb_add(&bar[XB_XCNT(b.x)], 1u);
    return b;
}
__device__ __forceinline__ void xcd_barrier_complete(unsigned* bar, unsigned x, unsigned& nloc, unsigned& nx) {
    const unsigned G = gridDim.x * gridDim.y * gridDim.z;
    unsigned sum, cnt, mine, sp = 0u;
    for (;;) {
        sum = 0u; cnt = 0u; mine = 0u;
#pragma unroll
        for (unsigned j = 0; j < 16; ++j) { const unsigned c = xb_ld(&bar[XB_XCNT(j)]); sum += c; cnt += (c > 0u) ? 1u : 0u; mine = (j == x) ? c : mine; }
        if (sum == G) break;
        __builtin_amdgcn_s_sleep(1);
        if ((++sp & 255u) == 0u) { if (xb_ld(&bar[XB_TMO])) break; if (sp > XB_SPIN_CAP) { atomicAdd(&bar[XB_TMO], 1u); break; } }
    }
    nloc = mine > 0u ? mine : 1u; nx = cnt > 0u ? cnt : 1u;
}
__device__ __forceinline__ void xcd_barrier(const XcdBarrier& b) {
    asm volatile("s_waitcnt vmcnt(0)" ::: "memory");
    __syncthreads();
    if (threadIdx.x == 0) {
        unsigned* bar = b.bar;
        __builtin_amdgcn_s_waitcnt(0);
        unsigned nloc = b.st[0], nx = b.st[1];
        if (nloc == 0u) { xcd_barrier_complete(bar, b.x, nloc, nx); b.st[0] = nloc; b.st[1] = nx; }
        const unsigned old = xb_add(&bar[XB_XSUB(b.x)], 1u);
        const unsigned gen = old / nloc;
        if (old + 1u == (gen + 1u) * nloc) {
            __builtin_amdgcn_fence(__ATOMIC_RELEASE, "agent");
            asm volatile("s_waitcnt vmcnt(0)" ::: "memory");
            const unsigned og = xb_add(&bar[XB_TOP], 1u);
            const unsigned tg = og / nx;
            if (og + 1u == (tg + 1u) * nx) xb_add(&bar[XB_TOPGEN], 1u);
            else XB_SPIN(xb_ld(&bar[XB_TOPGEN]) == tg, bar);
            __builtin_amdgcn_fence(__ATOMIC_ACQUIRE, "agent");
            xb_add(&bar[XB_XGEN(b.x)], 1u);
            asm volatile("s_waitcnt vmcnt(0)" ::: "memory");
        } else {
            XB_SPIN(xb_ld(&bar[XB_XGEN(b.x)]) == gen, bar);
            __builtin_amdgcn_fence(__ATOMIC_ACQUIRE, "agent");
            asm volatile("s_waitcnt vmcnt(0)" ::: "memory");
        }
    }
    __syncthreads();
}
#ifndef PROBE_A
#define PROBE_A -1
#endif
#ifndef PROBE_B
#define PROBE_B -1
#endif
#ifndef PROBE_A0
#define PROBE_A0 (PROBE_A - 1)
#endif
#ifndef PROBE_B0
#define PROBE_B0 (PROBE_B - 1)
#endif
#ifndef PROBE_SCALE
#define PROBE_SCALE 0.5e-6f
#endif
constexpr int CW_BAR = 4096, CW_TS = 8192;

typedef const __attribute__((address_space(4))) Args* KArgP;
__device__ __forceinline__ KArgP kargs() { KArgP p = (KArgP)__builtin_amdgcn_kernarg_segment_ptr(); asm volatile("" : "+s"(p)); return p; }
__global__ void __launch_bounds__(NTHREADS, 2) mega_fwd(Args A_) {
    extern __shared__ __attribute__((aligned(16))) unsigned char lds_raw[];
    LAS unsigned char* lds = (LAS unsigned char*)lds_raw;
    cg::grid_group grid = cg::this_grid();
    const int G = gridDim.x; const int bx = blockIdx.x;
    const int vcu = (G % 8 == 0) ? (bx % 8) * (G / 8) + bx / 8 : bx;
    const int NGW = G * NWAVES;
    unsigned char* ws = A_.ws;
    unsigned* ctl = (unsigned*)(ws + WS_CTL);
    LAS int* MISC = (LAS int*)(lds + MISC_OFF);
    LAS int* l_cnt = MISC; LAS int* l_tstart = MISC + 64; LAS int* l_sstart = MISC + 192;
    if (threadIdx.x < 2) MISC[300 + threadIdx.x] = 0;
    __syncthreads();
    (void)xcd_barrier_post(ctl + CW_BAR, (volatile LAS unsigned*)(MISC + 300));
#define STAMP(k) do { if ((PROBE_A >= 0 || PROBE_B >= 0) && blockIdx.x == 0 && threadIdx.x == 0) ((unsigned long long*)((unsigned*)(ws + WS_CTL) + CW_TS))[k] = __builtin_amdgcn_s_memrealtime(); } while (0)
#define GSYNC(k) do { XcdBarrier xb_; xb_.bar = (unsigned*)(ws + WS_CTL) + CW_BAR; xb_.x = xb_xcc_id(); xb_.st = (volatile LAS unsigned*)(lds + MISC_OFF) + 300; xcd_barrier(xb_); STAMP(k); } while (0)
    STAMP(0);

    {
        PHASE_IDS;
        KArgP K_ = kargs();
        const float* a_wg = K_->wg; const float* a_we = K_->we; const float* a_nmoe = K_->norm_moe_w; const float* a_win = K_->w_in; const float* a_wa = K_->w_a; const float* a_wb = K_->w_b; const float* a_wo = K_->w_o;
        const float* a_x = K_->x; const float* a_nmix = K_->norm_mix_w;
        for (int i = gw * 64 + lane; i < 80 * 1024; i += NGW * 64) {
            const int r = i >> 10, k = i & 1023; float v = 0.f;
            if (r < 8) v = a_wg[k * 8 + r]; else if (r >= 16) v = a_we[k * 64 + (r - 16)];
            v *= a_nmoe[k];
            const unsigned hi = cvt_pk_bf16(v, 0.f) & 0xffffu; const float lo = v - __uint_as_float(hi << 16);
            ((bf16_t*)(ws + WS_WR))[i] = (bf16_t)hi; ((bf16_t*)(ws + WS_WR))[80 * 1024 + i] = (bf16_t)(cvt_pk_bf16(lo, 0.f) & 0xffffu);
        }
        {
            LAS unsigned* T = (LAS unsigned*)(lds + wave * 8192);
            constexpr int I_IN8 = (DM / 128) * (4608 / 64), I_G8 = (DM / 128) * (2048 / 64), I_IN = (DM / 64) * ((7680 - 4608) / 64), I_A = (512 / 64) * (DM / 64), I_B = (DM / 64) * (DM / 64), I_O = I_B;
            for (int it = gw; it < I_IN8 + I_G8 + I_IN + I_A + I_B + I_O; it += NGW) {
                int r = it;
                if (r < I_IN8) {
                    const int n0 = (r / (DM / 128)) * 64;
                    if (n0 < 3072) transpose_tile_fp8<1, false>(a_win, DM, IN_W, (unsigned char*)(ws + WS_WIN8), 0, T, r, lane, W8_SCALE);
                    else transpose_tile_fp8<0, false>(a_win, DM, IN_W, (unsigned char*)(ws + WS_WIN8), 0, T, r, lane, W8_SCALE);
                    continue; } r -= I_IN8;
                if (r < I_G8) { transpose_tile_fp8<0, false>(a_win + 7680, DM, IN_W, (unsigned char*)(ws + WS_WIN8G), 0, T, r, lane, W8_SCALE); continue; } r -= I_G8;
                if (r < I_IN) {
                    const int r2 = r + (DM / 64) * (4608 / 64);
                    const int n0 = (r2 / (DM / 64)) * 64;
                    const bool rot = (n0 >= 4608 && n0 < 5632);
                    if (rot) transpose_tile64<1, false>(a_win, DM, IN_W, (bf16_t*)(ws + WS_WIN), 0, T, r2, lane);
                    else transpose_tile64<0, false>(a_win, DM, IN_W, (bf16_t*)(ws + WS_WIN), 0, T, r2, lane);
                    continue; } r -= I_IN;
                if (r < I_A) { transpose_tile64<0, false>(a_wa, 512, DM, (bf16_t*)(ws + WS_WA), 0, T, r, lane, 1536, 0); continue; } r -= I_A;
                if (r < I_B) { transpose_tile64<0, false>(a_wb, DM, DM, (bf16_t*)(ws + WS_WA), 0, T, r, lane, 1536, 512); continue; } r -= I_B;
                transpose_tile64<0, false>(a_wo, DM, DM, (bf16_t*)(ws + WS_WO), 0, T, r, lane);
            }
        }
        f32x4 wn[4];
#pragma unroll
        for (int j = 0; j < 4; ++j) wn[j] = ((const f32x4*)a_nmix + lane)[64 * j];
        for (int m = gw; m < NTOK; m += 2 * NGW) {
            const int m2 = (m + NGW < NTOK) ? m + NGW : m;
            const f32x4* xa = (const f32x4*)(a_x + (size_t)m * DM) + lane; const f32x4* xb = (const f32x4*)(a_x + (size_t)m2 * DM) + lane;
            f32x4 va[4], vb[4]; float sa = 0.f, sb = 0.f;
#pragma unroll
            for (int j = 0; j < 4; ++j) { va[j] = xa[64 * j]; vb[j] = xb[64 * j]; }
#pragma unroll
            for (int j = 0; j < 4; ++j) { sa += (va[j].x * va[j].x + va[j].y * va[j].y) + (va[j].z * va[j].z + va[j].w * va[j].w); sb += (vb[j].x * vb[j].x + vb[j].y * vb[j].y) + (vb[j].z * vb[j].z + vb[j].w * vb[j].w); }
#pragma unroll
            for (int o_ = 1; o_ < 64; o_ <<= 1) { sa += __shfl_xor(sa, o_); sb += __shfl_xor(sb, o_); }
            const float ra = 1.f / sqrtf(sa * (1.f / DM) + NORM_EPS), rb = 1.f / sqrtf(sb * (1.f / DM) + NORM_EPS);
            u32x2* oa = (u32x2*)((bf16_t*)(ws + WS_XN) + (size_t)m * DM) + lane; u32x2* ob = (u32x2*)((bf16_t*)(ws + WS_XN) + (size_t)m2 * DM) + lane;
#pragma unroll
            for (int j = 0; j < 4; ++j) { const f32x4 ww = wn[j];
                const f32x4 ya = va[j] * ra * ww, yb = vb[j] * rb * ww;
                u32x2 o; o.x = cvt_pk_bf16(ya.x, ya.y); o.y = cvt_pk_bf16(ya.z, ya.w); oa[64 * j] = o;
                u32x2 p; p.x = cvt_pk_bf16(yb.x, yb.y); p.y = cvt_pk_bf16(yb.z, yb.w); ob[64 * j] = p;
                ((unsigned*)((unsigned char*)(ws + WS_XN8) + (size_t)m * DM))[lane + 64 * j] = pk_fp8x4(ya.x, ya.y, ya.z, ya.w);
                ((unsigned*)((unsigned char*)(ws + WS_XN8) + (size_t)m2 * DM))[lane + 64 * j] = pk_fp8x4(yb.x, yb.y, yb.z, yb.w); }
        }
    }
    if (G > (1 << 24)) grid.sync();
    GSYNC(1);

    {
        pg8::StaticOrder S; S.init(ws + WS_XN8, ws + WS_WIN8, NTOK, 4608, DM / 2, G, bx);
        EpiProjAtt E{ws, W8_DESCALE};
        pg8::gemm_phase<EpiProjAtt, pg8::StaticOrder, true, true, false, true>(lds, DM / 2, S, E);
    }
    GSYNC(2);

#if EN_ATT
    {
        PHASE_IDS;
        const bf16_t* QA = (const bf16_t*)(ws + WS_QA); const bf16_t* KA = (const bf16_t*)(ws + WS_KA); const bf16_t* VA = (const bf16_t*)(ws + WS_VA);
        float* LSE = (float*)(ws + WS_LSE); bf16_t* YCAT = (bf16_t*)kargs()->out;
        const unsigned lds_base = (unsigned)(size_t)lds;
        const int qi = lane & 15, g4 = lane >> 4;
        const int swk = ((qi >> 1) & 3) << 1;
        const int koff0 = qi * 128 + ((g4 ^ swk) << 4), koff1 = qi * 128 + (((4 + g4) ^ swk) << 4);
        const int vrow_l = 4 * g4 + (qi >> 2), swv = ((vrow_l >> 1) & 3) << 1;
        int voff[4];
#pragma unroll
        for (int dt = 0; dt < 4; ++dt) voff[dt] = vrow_l * 128 + (((2 * dt + ((qi & 3) >> 1)) ^ swv) << 4) + 8 * (qi & 1);
        const int drow = lane >> 3, dchp = lane & 7;
        for (int unit = vcu; unit < 256; unit += G) {
            const int b = unit >> 4, h = (unit >> 1) & 7, half = unit & 1;
            const size_t tokb = (size_t)b * SEQ;
#define ATT_GEOM(s_) const int grp = (s_) >> 3, jj = (s_) & 7; const int dil = (grp == 0) ? 1 : (grp == 1 ? 4 : 16), L = SEQ / dil; \
            const int rr = (grp == 0) ? 0 : (grp == 1 ? (jj >> 1) : 2 * jj); \
            const int bstart = (grp == 0) ? (1024 * half + 128 * jj) : (grp == 1 ? (256 * half + 128 * (jj & 1)) : 64 * half);
#define ATT_DMA(s_, sl_) do { ATT_GEOM(s_) \
            _Pragma("unroll") for (int it = 0; it < 8; ++it) { const int ii = wave + 8 * it, tens = ii >> 5, rg = ii & 31; const int row = 8 * rg + drow; \
                int idx, rsel; if (grp == 2) { idx = row & 127; rsel = rr + (row >> 7); } else { idx = bstart - 64 + row; idx = idx < 0 ? 0 : (idx > L - 1 ? L - 1 : idx); rsel = rr; } \
                const int ch = dchp ^ (((row >> 1) & 3) << 1); \
                const bf16_t* src = (tens ? VA : KA) + ((size_t)((b * 3 + grp) * 8 + h) * SEQ + (size_t)idx * dil + rsel) * 64 + ch * 8; \
                glds16(src, (unsigned)__builtin_amdgcn_readfirstlane((int)(lds_base + (sl_) * 65536 + tens * 32768 + rg * 1024))); } } while (0)
#define ATT_QGEOM(s_) ATT_GEOM(s_) const int sub = wave >> 2; \
            const int qidx0 = (grp == 2) ? (bstart + 16 * (wave & 3)) : (bstart + 16 * wave); const int rq = (grp == 2) ? rr + sub : rr; \
            const int rowbase = (grp == 2) ? (128 * sub + qidx0 - 64) : 16 * wave; \
            const int sq = (qidx0 + qi) * dil + rq; const size_t hmq = ((size_t)((b * 3 + grp) * 8 + h) * SEQ + sq) * 64;        \
            const size_t tokq = tokb + sq;
            bf16x8 qn0, qn1; u32x2 pn[4]; float ln = 0.f;
#pragma unroll
            for (int dt = 0; dt < 4; ++dt) pn[dt] = (u32x2){0u, 0u};
            { ATT_QGEOM(0) const bf16_t* qp = QA + hmq + 8 * g4; qn0 = *(const bf16x8*)qp; qn1 = *(const bf16x8*)(qp + 32); (void)tokq; }
            ATT_DMA(0, 0);
            for (int s = 0; s < 24; ++s) {
                asm volatile("s_waitcnt vmcnt(0)" ::: "memory"); __builtin_amdgcn_s_barrier(); asm volatile("" ::: "memory");
                bf16x8 qf0 = qn0, qf1 = qn1; asm volatile("" : "+v"(qf0), "+v"(qf1));
                u32x2 pc[4]; float lc = ln;
#pragma unroll
                for (int dt = 0; dt < 4; ++dt) pc[dt] = pn[dt];
                asm volatile("" : "+v"(pc[0]), "+v"(pc[1]), "+v"(pc[2]), "+v"(pc[3]), "+v"(lc));
                if (s + 1 < 24) { ATT_DMA(s + 1, (s + 1) & 1); { ATT_QGEOM(s + 1) const bf16_t* qp = QA + hmq + 8 * g4; qn0 = *(const bf16x8*)qp; qn1 = *(const bf16x8*)(qp + 32);
                    if (s + 1 >= 8) { const bf16_t* yp = YCAT + tokq * 1536 + h * 64 + 4 * g4;
#pragma unroll
                        for (int dt = 0; dt < 4; ++dt) pn[dt] = *(const u32x2*)(yp + 16 * dt);
                        ln = LSE[tokq * 8 + h]; } } }
                {
                    ATT_QGEOM(s)
                    const LAS unsigned char* Kt = lds + (s & 1) * 65536; const LAS unsigned char* Vt = Kt + 32768;
                    f32x4 sc[9]; float mx = -INFINITY; int trow[9];
#pragma unroll
                    for (int kt = 0; kt < 9; ++kt) {
                        const int kidx0 = qidx0 - 64 + 16 * kt; const bool inr = (kidx0 >= 0) && (kidx0 < L);
                        const int tr_ = inr ? rowbase + 16 * kt : rowbase + 64; trow[kt] = tr_;
                        const LAS unsigned char* kp = Kt + tr_ * 128;
                        const bf16x8 k0 = *(const LAS bf16x8*)(kp + koff0), k1 = *(const LAS bf16x8*)(kp + koff1);
                        f32x4 sv = (f32x4){0.f, 0.f, 0.f, 0.f};
                        sv = __builtin_amdgcn_mfma_f32_16x16x32_bf16(k0, qf0, sv, 0, 0, 0);
                        sv = __builtin_amdgcn_mfma_f32_16x16x32_bf16(k1, qf1, sv, 0, 0, 0);
#pragma unroll
                        for (int i = 0; i < 4; ++i) { const int kr = 4 * g4 + i; bool ok = inr; if (kt == 0) ok = ok && (kr >= qi); if (kt == 8) ok = ok && (kr <= qi);
                            sv[i] = ok ? sv[i] : -INFINITY; mx = fmaxf(mx, sv[i]); }
                        sc[kt] = sv;
                    }
                    mx = fmaxf(mx, __shfl_xor(mx, 16)); mx = fmaxf(mx, __shfl_xor(mx, 32));
                    float lsum = 0.f;
#pragma unroll
                    for (int kt = 0; kt < 9; ++kt)
#pragma unroll
                        for (int i = 0; i < 4; ++i) { const float p = fast_exp2(sc[kt][i] - mx); sc[kt][i] = p; lsum += p; }
                    lsum += __shfl_xor(lsum, 16); lsum += __shfl_xor(lsum, 32);
                    f32x4 o[4];
#pragma unroll
                    for (int dt = 0; dt < 4; ++dt) o[dt] = (f32x4){0.f, 0.f, 0.f, 0.f};
#pragma unroll
                    for (int kk = 0; kk < 5; ++kk) {
                        const int t0 = 2 * kk, t1 = (kk == 4) ? 8 : 2 * kk + 1;
                        u32x4 pw; pw.x = cvt_pk_bf16(sc[t0][0], sc[t0][1]); pw.y = cvt_pk_bf16(sc[t0][2], sc[t0][3]);
                        if (kk == 4) { pw.z = 0u; pw.w = 0u; } else { pw.z = cvt_pk_bf16(sc[t1][0], sc[t1][1]); pw.w = cvt_pk_bf16(sc[t1][2], sc[t1][3]); }
                        const bf16x8 pf = __builtin_bit_cast(bf16x8, pw);
                        const LAS unsigned char* v0p = Vt + trow[t0] * 128; const LAS unsigned char* v1p = Vt + trow[t1] * 128;
#pragma unroll
                        for (int dt = 0; dt < 4; ++dt) {
                            const bf16x8 vf = cat4(tr_read((const LAS char*)(v0p + voff[dt])), tr_read((const LAS char*)(v1p + voff[dt])));
                            o[dt] = __builtin_amdgcn_mfma_f32_16x16x32_bf16(vf, pf, o[dt], 0, 0, 0);
                        }
                    }
                    const float rl = 1.f / lsum, lse2 = mx + log2f(lsum);
                    float fa = 0.f, fb = rl, lnew = lse2;
                    if (grp > 0) { const float m = fmaxf(lc, lse2), wa = fast_exp2(lc - m), wb = fast_exp2(lse2 - m), inv = 1.f / (wa + wb); fa = wa * inv; fb = wb * inv * rl; lnew = m + log2f(wa + wb); }
                    bf16_t* op = YCAT + tokq * 1536 + h * 64 + 4 * g4;
#pragma unroll
                    for (int dt = 0; dt < 4; ++dt) { u32x2 w;
                        w.x = cvt_pk_bf16(fa * bf_lo(pc[dt].x) + fb * o[dt][0], fa * bf_hi(pc[dt].x) + fb * o[dt][1]); w.y = cvt_pk_bf16(fa * bf_lo(pc[dt].y) + fb * o[dt][2], fa * bf_hi(pc[dt].y) + fb * o[dt][3]);
                        *(u32x2*)(op + 16 * dt) = w; }
                    if (g4 == 0 && grp < 2) LSE[tokq * 8 + h] = lnew;
                }
            }
#undef ATT_GEOM
#undef ATT_DMA
#undef ATT_QGEOM
            VM_WAIT();
            __syncthreads();
        }
    }
#else
    { PHASE_IDS; bf16_t* yc = (bf16_t*)kargs()->out; for (size_t i = (size_t)bx * NTHREADS + tid; i < (size_t)NTOK * 64; i += (size_t)G * NTHREADS) *(u32x4*)(yc + (i >> 6) * 1536 + (i & 63) * 8) = (u32x4){0u, 0u, 0u, 0u}; }
#endif
    GSYNC(3);

    {
        KArgP K_ = kargs();
        {
            pg8::StaticOrder S; S.init(ws + WS_XN, ws + WS_WIN + (size_t)4608 * DM * 2, NTOK, 3072, DM, G, bx);
            EpiProj E{ws, (bf16_t*)K_->out, K_->b_gate, 18, 1.f};
            pg8::gemm_phase<EpiProj, pg8::StaticOrder, true, true>(lds, DM, S, E);
        }
        {
            pg8::StaticOrder S; S.init(ws + WS_XN8, ws + WS_WIN8G, NTOK, 2048, DM / 2, G, bx);
            EpiProj E{ws, (bf16_t*)K_->out, K_->b_gate, 30, W8_DESCALE};
            pg8::gemm_phase<EpiProj, pg8::StaticOrder, true, true, false, true>(lds, DM / 2, S, E);
        }
    }
    GSYNC(4);

#if EN_RET
    {
        PHASE_IDS;
        const bf16_t* KR = (const bf16_t*)(ws + WS_KR); const bf16_t* VR = (const bf16_t*)(ws + WS_VR); bf16_t* SST = (bf16_t*)(ws + WS_SST);
        constexpr int RSK = 160, RSV = 288; constexpr int KT_OFF = 0, VT_OFF = 128 * RSK;
        const int dcol = lane & 15, g4 = lane >> 4;
        for (int unit = vcu; unit < 256; unit += G) {
            const int b = unit >> 4, h = (unit >> 1) & 7, dir = unit & 1;
            KArgP K_ = kargs(); const float lg = log_sigmoid(dir ? K_->dec_b[h] : K_->dec_f[h]); const float lg2 = lg * LOG2E; const float cd = exp2f(128.f * lg2);
            f32x4 st[4];
#pragma unroll
            for (int dt = 0; dt < 4; ++dt) st[dt] = (f32x4){0.f, 0.f, 0.f, 0.f};
            constexpr int BUFB = 128 * RSK + 128 * RSV;
            u32x4 kA[2], vA[4], kB[2], vB[4];
            float zk[2];
#pragma unroll
            for (int it = 0; it < 2; ++it) { const int row = (tid + NTHREADS * it) >> 3; zk[it] = exp2f(lg2 * (float)(dir ? row : 127 - row)); }
#define P3A_LOAD(kr_, vr_, s_) do { const size_t tk_ = (size_t)b * SEQ + (dir ? 15 - (s_) : (s_)) * 128; \
                _Pragma("unroll") for (int it = 0; it < 2; ++it) { const int p = tid + NTHREADS * it, row = p >> 3, ch = p & 7; kr_[it] = *(const u32x4*)(KR + (tk_ + row) * 512 + h * 64 + ch * 8); } \
                _Pragma("unroll") for (int it = 0; it < 4; ++it) { const int p = tid + NTHREADS * it, row = p >> 4, ch = p & 15; vr_[it] = *(const u32x4*)(VR + (tk_ + row) * 1024 + h * 128 + ch * 8); } } while (0)
#define P3A_STAGE(kr_, vr_, buf_) do { \
                _Pragma("unroll") for (int it = 0; it < 2; ++it) { const int p = tid + NTHREADS * it, row = p >> 3, ch = p & 7; const u32x4 v = kr_[it]; const float z = zk[it]; \
                    u32x4 o; o.x = cvt_pk_bf16(bf_lo(v.x) * z, bf_hi(v.x) * z); o.y = cvt_pk_bf16(bf_lo(v.y) * z, bf_hi(v.y) * z); o.z = cvt_pk_bf16(bf_lo(v.z) * z, bf_hi(v.z) * z); o.w = cvt_pk_bf16(bf_lo(v.w) * z, bf_hi(v.w) * z); \
                    *(LAS u32x4*)(lds + (buf_) * BUFB + KT_OFF + row * RSK + ch * 16) = o; } \
                _Pragma("unroll") for (int it = 0; it < 4; ++it) { const int p = tid + NTHREADS * it, row = p >> 4, ch = p & 15; *(LAS u32x4*)(lds + (buf_) * BUFB + VT_OFF + row * RSV + ch * 16) = vr_[it]; } } while (0)
#define P3A_STEP(s_, kr_, vr_) do { const int n = dir ? 15 - (s_) : (s_); const int buf = (s_) & 1; \
                bf16_t* sp = SST + ((size_t)((b * 8 + h) * 2 + dir) * 16 + n) * 8192;        \
                _Pragma("unroll") for (int dt = 0; dt < 4; ++dt) { u32x2 w; w.x = cvt_pk_bf16(st[dt][0], st[dt][1]); w.y = cvt_pk_bf16(st[dt][2], st[dt][3]); *(u32x2*)(sp + (16 * dt + dcol) * 128 + 16 * wave + 4 * g4) = w; } \
                if ((s_) + 1 < 16) { P3A_STAGE(kr_, vr_, buf ^ 1); if ((s_) + 3 < 16) P3A_LOAD(kr_, vr_, (s_) + 3); } \
                _Pragma("unroll") for (int dt = 0; dt < 4; ++dt) st[dt] = st[dt] * cd; \
                _Pragma("unroll") for (int kk = 0; kk < 4; ++kk) { \
                    const int r0 = 32 * kk + 4 * g4 + (dcol >> 2), r1 = r0 + 16; \
                    const LAS unsigned char* vb = lds + buf * BUFB + VT_OFF + (16 * wave + 4 * (dcol & 3)) * 2; \
                    const bf16x8 af = cat4(tr_read((const LAS char*)(vb + r0 * RSV)), tr_read((const LAS char*)(vb + r1 * RSV))); \
                    _Pragma("unroll") for (int dt = 0; dt < 4; ++dt) { \
                        const LAS unsigned char* kb = lds + buf * BUFB + KT_OFF + (16 * dt + 4 * (dcol & 3)) * 2; \
                        const bf16x8 bfr = cat4(tr_read((const LAS char*)(kb + r0 * RSK)), tr_read((const LAS char*)(kb + r1 * RSK))); \
                        st[dt] = __builtin_amdgcn_mfma_f32_16x16x32_bf16(af, bfr, st[dt], 0, 0, 0); } } \
                __syncthreads(); } while (0)
            P3A_LOAD(kA, vA, 0); P3A_LOAD(kB, vB, 1);
            P3A_STAGE(kA, vA, 0); P3A_LOAD(kA, vA, 2);
            __syncthreads();
#pragma unroll 1
            for (int step = 0; step < 16; step += 2) {
                P3A_STEP(step, kB, vB);
                P3A_STEP(step + 1, kA, vA);
            }
#undef P3A_LOAD
#undef P3A_STAGE
#undef P3A_STEP
        }
    }
    GSYNC(5);
    {
        PHASE_IDS;
        const bf16_t* QR = (const bf16_t*)(ws + WS_QR); const bf16_t* KR = (const bf16_t*)(ws + WS_KR); const bf16_t* VR = (const bf16_t*)(ws + WS_VR);
        const bf16_t* GR = (const bf16_t*)(ws + WS_GR); const bf16_t* SST = (const bf16_t*)(ws + WS_SST); bf16_t* YCAT = (bf16_t*)kargs()->out;
        constexpr int RSK = 160, RSV = 288; constexpr int QT = 0, KT = 20480, VT = 40960, SF = 77824, SB = 96256, GNW = 114688, GT = 118784;
        const int qi = lane & 15, g4 = lane >> 4;
        { const float* a_gnw0 = kargs()->gn_w; ((LAS float*)(lds + GNW))[tid] = a_gnw0[tid]; ((LAS float*)(lds + GNW))[tid + 512] = a_gnw0[tid + 512]; }
        u32x4 pre[12];
#define P3B_LOAD(unit_) do { const int bh_ = (unit_) >> 4, n_ = (unit_) & 15, b_ = bh_ >> 3, h_ = bh_ & 7; const size_t tk_ = (size_t)b_ * SEQ + n_ * 128; \
            _Pragma("unroll") for (int it = 0; it < 2; ++it) { const int p = tid + NTHREADS * it, row = p >> 3, ch = p & 7; \
                pre[it] = *(const u32x4*)(QR + (tk_ + row) * 512 + h_ * 64 + ch * 8); pre[2 + it] = *(const u32x4*)(KR + (tk_ + row) * 512 + h_ * 64 + ch * 8); } \
            _Pragma("unroll") for (int it = 0; it < 4; ++it) { const int p = tid + NTHREADS * it, row = p >> 4, ch = p & 15; pre[4 + it] = *(const u32x4*)(VR + (tk_ + row) * 1024 + h_ * 128 + ch * 8); } \
            _Pragma("unroll") for (int it = 0; it < 2; ++it) { const int p = tid + NTHREADS * it, row = p >> 4, ch = p & 15; \
                pre[8 + it] = *(const u32x4*)(SST + ((size_t)(bh_ * 2 + 0) * 16 + n_) * 8192 + row * 128 + ch * 8); pre[10 + it] = *(const u32x4*)(SST + ((size_t)(bh_ * 2 + 1) * 16 + n_) * 8192 + row * 128 + ch * 8); } } while (0)
        if (vcu < 2048) P3B_LOAD(vcu);
        constexpr int DW = ROFF_OFF + 20480;
        int h_cur = -1; float lgf2 = 0.f, lgb2 = 0.f, xif = 0.f, xib = 0.f;
        for (int unit = vcu; unit < 2048; unit += G) {
            const int bh = unit >> 4, n = unit & 15, b = bh >> 3, h = bh & 7;
            if (h != h_cur) {
                h_cur = h;
                KArgP K_ = kargs(); lgf2 = log_sigmoid(K_->dec_f[h]) * LOG2E; lgb2 = log_sigmoid(K_->dec_b[h]) * LOG2E;
                const int qa_ = 16 * wave + qi;
                xif = fast_exp2(lgf2 * (float)(qa_ + 1)); xib = fast_exp2(lgb2 * (float)(128 - qa_));
                if (tid < 255) { const int dl = 127 - tid; ((LAS float*)(lds + DW))[tid] = dl > 0 ? fast_exp2(lgf2 * (float)dl) : (dl < 0 ? fast_exp2(lgb2 * (float)(-dl)) : 2.f); }
            }
            const size_t tok0 = (size_t)b * SEQ + n * 128;
#pragma unroll
            for (int it = 0; it < 2; ++it) { const int p = tid + NTHREADS * it, row = p >> 3, ch = p & 7;
                *(LAS u32x4*)(lds + QT + row * RSK + ch * 16) = pre[it]; *(LAS u32x4*)(lds + KT + row * RSK + ch * 16) = pre[2 + it]; }
#pragma unroll
            for (int it = 0; it < 4; ++it) { const int p = tid + NTHREADS * it, row = p >> 4, ch = p & 15; *(LAS u32x4*)(lds + VT + row * RSV + ch * 16) = pre[4 + it]; }
#pragma unroll
            for (int it = 0; it < 2; ++it) { const int p = tid + NTHREADS * it, row = p >> 4, ch = p & 15;
                *(LAS u32x4*)(lds + SF + row * RSV + ch * 16) = pre[8 + it]; *(LAS u32x4*)(lds + SB + row * RSV + ch * 16) = pre[10 + it]; }
            __syncthreads();
            {
                const unsigned gdst = (unsigned)(size_t)lds + (unsigned)(wave < 3 ? GT + wave * 4096 : ROFF_OFF + (wave - 3) * 4096);
#pragma unroll
                for (int j = 0; j < 4; ++j) { const int row = 4 * j + (lane >> 4), c = (lane & 15) ^ row;
                    glds16(GR + (tok0 + 16 * wave + row) * 1024 + h * 128 + c * 8, (unsigned)__builtin_amdgcn_readfirstlane((int)(gdst + j * 1024))); }
            }
            if (unit + G < 2048) P3B_LOAD(unit + G);
            {
                const int qa = 16 * wave + qi;
                const LAS unsigned char* qrow = lds + QT + qa * RSK;
                const bf16x8 qf0 = *(const LAS bf16x8*)(qrow + g4 * 16), qf1 = *(const LAS bf16x8*)(qrow + 64 + g4 * 16);
                bf16x8 pf[4];
#pragma unroll
                for (int kk = 0; kk < 4; ++kk) {
                    u32x4 pw;
#pragma unroll
                    for (int tt = 0; tt < 2; ++tt) {
                        const int kt = 2 * kk + tt;
                        const LAS unsigned char* kp = lds + KT + (16 * kt + qi) * RSK + g4 * 16;
                        const bf16x8 k0 = *(const LAS bf16x8*)kp, k1 = *(const LAS bf16x8*)(kp + 64);
                        f32x4 s = (f32x4){0.f, 0.f, 0.f, 0.f};
                        s = __builtin_amdgcn_mfma_f32_16x16x32_bf16(k0, qf0, s, 0, 0, 0);
                        s = __builtin_amdgcn_mfma_f32_16x16x32_bf16(k1, qf1, s, 0, 0, 0);
#pragma unroll
                        for (int i = 0; i < 4; ++i) s[i] *= ((const LAS float*)(lds + DW))[127 - qa + 16 * kt + 4 * g4 + i];
                        if (tt == 0) { pw.x = cvt_pk_bf16(s[0], s[1]); pw.y = cvt_pk_bf16(s[2], s[3]); } else { pw.z = cvt_pk_bf16(s[0], s[1]); pw.w = cvt_pk_bf16(s[2], s[3]); }
                    }
                    pf[kk] = __builtin_bit_cast(bf16x8, pw);
                }
                bf16x8 qxf[2], qxb[2];
#pragma unroll
                for (int kk = 0; kk < 2; ++kk) {
                    const u32x2 a = *(const LAS u32x2*)(qrow + (32 * kk + 4 * g4) * 2), c = *(const LAS u32x2*)(qrow + (32 * kk + 16 + 4 * g4) * 2);
                    u32x4 f, bq;
                    f.x = cvt_pk_bf16(bf_lo(a.x) * xif, bf_hi(a.x) * xif); f.y = cvt_pk_bf16(bf_lo(a.y) * xif, bf_hi(a.y) * xif); f.z = cvt_pk_bf16(bf_lo(c.x) * xif, bf_hi(c.x) * xif); f.w = cvt_pk_bf16(bf_lo(c.y) * xif, bf_hi(c.y) * xif);
                    bq.x = cvt_pk_bf16(bf_lo(a.x) * xib, bf_hi(a.x) * xib); bq.y = cvt_pk_bf16(bf_lo(a.y) * xib, bf_hi(a.y) * xib); bq.z = cvt_pk_bf16(bf_lo(c.x) * xib, bf_hi(c.x) * xib); bq.w = cvt_pk_bf16(bf_lo(c.y) * xib, bf_hi(c.y) * xib);
                    qxf[kk] = __builtin_bit_cast(bf16x8, f); qxb[kk] = __builtin_bit_cast(bf16x8, bq);
                }
                f32x4 o[8];
                const int trow = 4 * g4 + (qi >> 2), tcol = (qi & 3) * 8;
#pragma unroll
                for (int vt = 0; vt < 8; ++vt) {
                    f32x4 acc = (f32x4){0.f, 0.f, 0.f, 0.f};
#pragma unroll
                    for (int kk = 0; kk < 4; ++kk) {
                        const LAS unsigned char* vb = lds + VT + (32 * kk + trow) * RSV + vt * 32 + tcol;
                        const bf16x8 af = cat4(tr_read((const LAS char*)vb), tr_read((const LAS char*)(vb + 16 * RSV)));
                        acc = __builtin_amdgcn_mfma_f32_16x16x32_bf16(af, pf[kk], acc, 0, 0, 0);
                    }
#pragma unroll
                    for (int kk = 0; kk < 2; ++kk) {
                        const LAS unsigned char* sfp = lds + SF + (32 * kk + trow) * RSV + vt * 32 + tcol;
                        const bf16x8 af = cat4(tr_read((const LAS char*)sfp), tr_read((const LAS char*)(sfp + 16 * RSV)));
                        acc = __builtin_amdgcn_mfma_f32_16x16x32_bf16(af, qxf[kk], acc, 0, 0, 0);
                        const LAS unsigned char* sbp = lds + SB + (32 * kk + trow) * RSV + vt * 32 + tcol;
                        const bf16x8 ab = cat4(tr_read((const LAS char*)sbp), tr_read((const LAS char*)(sbp + 16 * RSV)));
                        acc = __builtin_amdgcn_mfma_f32_16x16x32_bf16(ab, qxb[kk], acc, 0, 0, 0);
                    }
                    o[vt] = acc;
                }
                float s = 0.f;
#pragma unroll
                for (int vt = 0; vt < 8; ++vt) s += (o[vt][0] + o[vt][1]) + (o[vt][2] + o[vt][3]);
                s += __shfl_xor(s, 16); s += __shfl_xor(s, 32);
                const float mu = s * (1.f / 128.f); float q2 = 0.f;
#pragma unroll
                for (int vt = 0; vt < 8; ++vt) { const f32x4 d = o[vt] - mu; q2 += (d[0] * d[0] + d[1] * d[1]) + (d[2] * d[2] + d[3] * d[3]); }
                q2 += __shfl_xor(q2, 16); q2 += __shfl_xor(q2, 32);
                const float rstd = 1.f / sqrtf(q2 * (1.f / 128.f) + NORM_EPS);
                const size_t tok = tok0 + qa;
                asm volatile("s_waitcnt vmcnt(0)" ::: "memory");
#pragma unroll
                for (int vt = 0; vt < 8; ++vt) {
                    const int col = h * 128 + 16 * vt + 4 * g4;
                    const f32x4 gw4 = *(const LAS f32x4*)(lds + GNW + col * 4); const u32x2 sg = *(const LAS u32x2*)(lds + (wave < 3 ? GT + wave * 4096 : ROFF_OFF + (wave - 3) * 4096) + qi * 256 + (((2 * vt + (g4 >> 1)) ^ qi) << 4) + 8 * (g4 & 1));
                    const f32x4 d = (o[vt] - mu) * rstd;
                    u32x2 w; w.x = cvt_pk_bf16(d[0] * gw4[0] * bf_lo(sg.x), d[1] * gw4[1] * bf_hi(sg.x)); w.y = cvt_pk_bf16(d[2] * gw4[2] * bf_lo(sg.y), d[3] * gw4[3] * bf_hi(sg.y));
                    *(u32x2*)(YCAT + tok * 1536 + 512 + col) = w;
                }
            }
            __syncthreads();
        }
    }
#else
    { PHASE_IDS; bf16_t* yc = (bf16_t*)kargs()->out; for (size_t i = (size_t)bx * NTHREADS + tid; i < (size_t)NTOK * 128; i += (size_t)G * NTHREADS) *(u32x4*)(yc + (i >> 7) * 1536 + 512 + (i & 127) * 8) = (u32x4){0u, 0u, 0u, 0u}; }
#endif
    GSYNC(6);

    {
        pg8::StaticOrder S; S.init(kargs()->out, ws + WS_WA, NTOK, DM, 1536, G, bx);
        EpiMerge E{(bf16_t*)(ws + WS_MERGED), (const bf16_t*)(ws + WS_GATE)};
        pg8::gemm_phase<EpiMerge, pg8::StaticOrder, true, true>(lds, 1536, S, E);
    }
    GSYNC(7);

    {
        pg8::StaticOrder S; S.init(ws + WS_MERGED, ws + WS_WO, NTOK, DM, DM, G, bx);
        EpiPlain E{(bf16_t*)(ws + WS_MIX)};
        pg8::gemm_phase<EpiPlain, pg8::StaticOrder, true, true>(lds, DM, S, E);
    }
    GSYNC(8);

#if EN_MOE
#ifndef NO_P6
    {
        PHASE_IDS;
        const float* H = kargs()->x; const bf16_t* MIX = (const bf16_t*)(ws + WS_MIX); const bf16_t* WRh = (const bf16_t*)(ws + WS_WR); unsigned char* HN = (unsigned char*)(ws + WS_HN);
        unsigned* ASG = (unsigned*)(ws + WS_ASG); float* RSTD = (float*)(ws + WS_RSTD);
        LAS float* NM = (LAS float*)(lds + 98304);
        { KArgP K0 = kargs(); const float* a_nmoe = K0->norm_moe_w; NM[tid] = a_nmoe[tid]; NM[tid + 512] = a_nmoe[tid + 512]; }
        if (tid < 2) MISC[310 + tid] = 0;
        if (tid < 64) MISC[320 + tid] = 0;
        __syncthreads();
        const int ntc = (NTOK / 16 - vcu * NWAVES + NGW - 1) / NGW * NWAVES;
        for (;;) {
            int kind = -1, widx = 0;
            if (lane == 0) {
                if (wave < 4) { widx = __hip_atomic_fetch_add(&MISC[311], 1, __ATOMIC_RELAXED, __HIP_MEMORY_SCOPE_WORKGROUP); if (widx < ntc) kind = 0;
                    else { widx = __hip_atomic_fetch_add(&MISC[310], 1, __ATOMIC_RELAXED, __HIP_MEMORY_SCOPE_WORKGROUP); if (vcu + G * widx < NEXP * 192) kind = 1; } }
                else { widx = __hip_atomic_fetch_add(&MISC[310], 1, __ATOMIC_RELAXED, __HIP_MEMORY_SCOPE_WORKGROUP); if (vcu + G * widx < NEXP * 192) kind = 1;
                    else { widx = __hip_atomic_fetch_add(&MISC[311], 1, __ATOMIC_RELAXED, __HIP_MEMORY_SCOPE_WORKGROUP); if (widx < ntc) kind = 0; } }
            }
            kind = __builtin_amdgcn_readfirstlane(kind); widx = __builtin_amdgcn_readfirstlane(widx);
            if (kind < 0) break;
            if (kind == 0) {
                KArgP K_ = kargs(); const float* a_bg = K_->bg; const float* a_be = K_->be;
                LAS float* LG = (LAS float*)(lds + wave * 8192);
                int lane_r = lane; asm volatile("" : "+v"(lane_r));
                const int tk = lane_r & 15, g4 = lane_r >> 4;
                const int tile = vcu * NWAVES + (widx & 7) + (widx >> 3) * NGW;
                const int t0 = tile * 16;
                f32x4 acc[5];
#pragma unroll
                for (int nt = 0; nt < 5; ++nt) acc[nt] = (f32x4){0.f, 0.f, 0.f, 0.f};
                float ss = 0.f;
                const float* hp = H + (size_t)(t0 + tk) * DM + 8 * g4; const bf16_t* mp = MIX + (size_t)(t0 + tk) * DM + 8 * g4;
                unsigned char* hnp = HN + (size_t)(t0 + tk) * DM + 8 * g4;
                const bf16_t* whp = WRh + (size_t)tk * DM + 8 * g4;
                f32x4 hA[2], hB[2], hC[2], hD[2]; bf16x8 wA[5], wB[5], wC[5], wD[5]; u32x4 mA, mB, mC, mD;
#define RT_LOAD(hS, wS, mS, ks_) do { hS[0] = *(const f32x4*)(hp + 32 * (ks_)); hS[1] = *(const f32x4*)(hp + 32 * (ks_) + 4); mS = *(const u32x4*)(mp + 32 * (ks_)); \
                    _Pragma("unroll") for (int nt = 0; nt < 5; ++nt) wS[nt] = *(const bf16x8*)(whp + (size_t)nt * 16 * DM + 32 * (ks_)); } while (0)
#define RT_COMP(hS, wS, mS, ks_) do { const f32x4 x0 = hS[0] + (f32x4){bf_lo(mS.x), bf_hi(mS.x), bf_lo(mS.y), bf_hi(mS.y)}, x1 = hS[1] + (f32x4){bf_lo(mS.z), bf_hi(mS.z), bf_lo(mS.w), bf_hi(mS.w)}; \
                    const f32x4 n0 = *(const LAS f32x4*)(NM + 32 * (ks_) + 8 * g4), n1 = *(const LAS f32x4*)(NM + 32 * (ks_) + 8 * g4 + 4); \
                    ss += (x0[0] * x0[0] + x0[1] * x0[1]) + (x0[2] * x0[2] + x0[3] * x0[3]) + (x1[0] * x1[0] + x1[1] * x1[1]) + (x1[2] * x1[2] + x1[3] * x1[3]); \
                    u32x2 hw; hw.x = pk_fp8x4(x0[0] * n0[0], x0[1] * n0[1], x0[2] * n0[2], x0[3] * n0[3]); hw.y = pk_fp8x4(x1[0] * n1[0], x1[1] * n1[1], x1[2] * n1[2], x1[3] * n1[3]); \
                    *(u32x2*)(hnp + 32 * (ks_)) = hw; \
                    u32x4 hi; hi.x = cvt_pk_bf16(x0[0], x0[1]); hi.y = cvt_pk_bf16(x0[2], x0[3]); hi.z = cvt_pk_bf16(x1[0], x1[1]); hi.w = cvt_pk_bf16(x1[2], x1[3]); \
                    u32x4 lo; lo.x = cvt_pk_bf16(x0[0] - bf_lo(hi.x), x0[1] - bf_hi(hi.x)); lo.y = cvt_pk_bf16(x0[2] - bf_lo(hi.y), x0[3] - bf_hi(hi.y)); \
                    lo.z = cvt_pk_bf16(x1[0] - bf_lo(hi.z), x1[1] - bf_hi(hi.z)); lo.w = cvt_pk_bf16(x1[2] - bf_lo(hi.w), x1[3] - bf_hi(hi.w)); \
                    const bf16x8 bh = __builtin_bit_cast(bf16x8, hi), bl = __builtin_bit_cast(bf16x8, lo); \
                    _Pragma("unroll") for (int nt = 0; nt < 5; ++nt) { acc[nt] = __builtin_amdgcn_mfma_f32_16x16x32_bf16(wS[nt], bh, acc[nt], 0, 0, 0); acc[nt] = __builtin_amdgcn_mfma_f32_16x16x32_bf16(wS[nt], bl, acc[nt], 0, 0, 0); } } while (0)
                RT_LOAD(hA, wA, mA, 0); RT_LOAD(hB, wB, mB, 1); RT_LOAD(hC, wC, mC, 2);
#pragma unroll 1
                for (int ks = 0; ks < 32; ks += 4) {
                    RT_LOAD(hD, wD, mD, ks + 3); RT_COMP(hA, wA, mA, ks);
                    if (ks + 4 < 32) RT_LOAD(hA, wA, mA, ks + 4); RT_COMP(hB, wB, mB, ks + 1);
                    if (ks + 5 < 32) RT_LOAD(hB, wB, mB, ks + 5); RT_COMP(hC, wC, mC, ks + 2);
                    if (ks + 6 < 32) RT_LOAD(hC, wC, mC, ks + 6); RT_COMP(hD, wD, mD, ks + 3);
                }
#undef RT_LOAD
#undef RT_COMP
                ss += __shfl_xor(ss, 16); ss += __shfl_xor(ss, 32);
                const float rstd = 1.f / sqrtf(ss * (1.f / DM) + NORM_EPS);
#pragma unroll
                for (int nt = 0; nt < 5; ++nt)
#pragma unroll
                    for (int i = 0; i < 4; ++i) LG[tk * 81 + 16 * nt + 4 * g4 + i] = acc[nt][i];
                LDS_WAIT(); asm volatile("" ::: "memory");
                int lane_t = lane; asm volatile("" : "+v"(lane_t));
                if (lane_t < 16) {
                    const int lane = lane_t;
                    const LAS float* lr = LG + lane * 81;
                    float gl[8]; float gmax = -INFINITY; int gi = 0;
#pragma unroll
                    for (int j = 0; j < 8; ++j) { gl[j] = lr[j] * rstd + a_bg[j]; if (gl[j] > gmax) { gmax = gl[j]; gi = j; } }
                    float gs = 0.f;
#pragma unroll
                    for (int j = 0; j < 8; ++j) gs += expf(gl[j] - gmax);
                    const float g_w = 1.f / gs;
                    float l1 = -INFINITY, l2 = -INFINITY; int i1 = 0, i2 = 0;
#pragma unroll
                    for (int j = 0; j < 8; ++j) { const float v = lr[16 + 8 * gi + j] * rstd + a_be[8 * gi + j];
                        if (v > l1) { l2 = l1; i2 = i1; l1 = v; i1 = j; } else if (v > l2) { l2 = v; i2 = j; } }
                    const float e1 = 1.f / (1.f + expf(l2 - l1)), e2 = 1.f - e1;
                    const int eid1 = gi * 8 + i1, eid2 = gi * 8 + i2;
                    const unsigned p1 = (unsigned)__hip_atomic_fetch_add(&MISC[320 + eid1], 1, __ATOMIC_RELAXED, __HIP_MEMORY_SCOPE_WORKGROUP), p2 = (unsigned)__hip_atomic_fetch_add(&MISC[320 + eid2], 1, __ATOMIC_RELAXED, __HIP_MEMORY_SCOPE_WORKGROUP);
                    u32x4 r0, r1; r0.x = (unsigned)eid1; r0.y = p1; r0.z = __float_as_uint(g_w * e1); r0.w = (unsigned)eid2; r1.x = p2; r1.y = __float_as_uint(g_w * e2); r1.z = 0u; r1.w = 0u;
                    *(u32x4*)(ASG + (size_t)(t0 + lane) * 8) = r0; *(u32x4*)(ASG + (size_t)(t0 + lane) * 8 + 4) = r1;
                    RSTD[t0 + lane] = rstd;
                }
                LDS_WAIT(); asm volatile("" ::: "memory");
            } else {
                LAS unsigned* T = (LAS unsigned*)(lds + wave * 8192);
                KArgP K2 = kargs(); const float* a_w1 = K2->w1; const float* a_w3 = K2->w3; const float* a_w2 = K2->w2;
                const int it = vcu + G * widx;
                int lane_c = lane; asm volatile("" : "+v"(lane_c));
                const int e = it / 192, r = it % 192;
                if (r < 64) transpose_tile_fp8<2, true>(a_w1 + (size_t)e * 1024 * 512, 1024, 512, (unsigned char*)(ws + WS_W13) + (size_t)e * 1024 * 1024, 0, T, r, lane_c, W8_SCALE);
                else if (r < 128) transpose_tile_fp8<2, true>(a_w3 + (size_t)e * 1024 * 512, 1024, 512, (unsigned char*)(ws + WS_W13) + (size_t)e * 1024 * 1024, 128, T, r - 64, lane_c, W8_SCALE);
                else transpose_tile_fp8<0, true>(a_w2 + (size_t)e * 512 * 1024, 512, 1024, (unsigned char*)(ws + WS_W2) + (size_t)e * 1024 * 512, 0, T, r - 128, lane_c, W8_SCALE);
                LDS_WAIT(); asm volatile("" ::: "memory");
            }
        }
        __syncthreads();
        if (tid < 64) ((int*)(ws + WS_CNTT))[vcu * 64 + tid] = MISC[320 + tid];
    }
#endif
    GSYNC(9);
    {
        PHASE_IDS;
        const int* CNTT = (const int*)(ws + WS_CNTT); LAS int* PS = (LAS int*)lds;
        {
            const int e = tid & 63; int tot = 0, bas = 0;
            for (int w = wave; w < G; w += NWAVES) { const int c = CNTT[w * 64 + e]; tot += c; bas += (w < vcu) ? c : 0; }
            PS[wave * 64 + e] = tot; PS[512 + wave * 64 + e] = bas;
        }
        __syncthreads();
        if (tid < 64) { int tot = 0, bas = 0;
#pragma unroll
            for (int q = 0; q < NWAVES; ++q) { tot += PS[q * 64 + tid]; bas += PS[512 + q * 64 + tid]; }
            l_cnt[tid] = tot; MISC[384 + tid] = bas; }
        __syncthreads();
        if (tid == 0) { int ts = 0, ss = 0; for (int e = 0; e < NEXP; ++e) { l_tstart[e] = ts; l_sstart[e] = ss; ts += (l_cnt[e] + 255) >> 8; ss += l_cnt[e]; } l_tstart[NEXP] = ts; l_sstart[NEXP] = ss; }
        __syncthreads();
        unsigned* ASG = (unsigned*)(ws + WS_ASG); int* TOKL = (int*)(ws + WS_TOKL);
        for (int tb = vcu * NWAVES; tb < NTOK / 16; tb += NGW) {
            if (tid < 256) {
                const int tok = tb * 16 + (tid >> 1), k = tid & 1;
                const unsigned eid = ASG[(size_t)tok * 8 + (k ? 3 : 0)], pos = ASG[(size_t)tok * 8 + (k ? 4 : 1)];
                const int slot = l_sstart[eid] + MISC[384 + eid] + (int)pos;
                TOKL[slot] = tok; ASG[(size_t)tok * 8 + 6 + k] = (unsigned)slot;
            }
        }
    }
    GSYNC(10);
#ifndef NO_P7
    {
        for (int pair = vcu; pair < NEXP * 4; pair += G) {
            const int e = pair >> 2, pn = pair & 3;
            const int cnt = l_cnt[e], sst = l_sstart[e], ntile = (cnt + 255) >> 8;
            for (int u0 = 0; u0 < ntile; u0 += ROFF_UNITS) {
                const int nb = (ntile - u0) < ROFF_UNITS ? (ntile - u0) : ROFF_UNITS;
                {
                    const int tid = opaque_tid(); const int* TOKL = (const int*)(ws + WS_TOKL); const float* RSTD = (const float*)(ws + WS_RSTD); LAS int* RO = (LAS int*)(lds + ROFF_OFF); LAS float* RS = (LAS float*)(lds + RSC_OFF);
                    for (int idx = tid; idx < nb * 256; idx += NTHREADS) { int row = u0 * 256 + idx; row = row < cnt ? row : cnt - 1; const int tok = TOKL[sst + row]; RO[idx] = tok * DM; RS[idx] = RSTD[tok] * W8_DESCALE; }
                }
                __syncthreads();
                pg8::ExpertOrder S{(const char*)(ws + WS_HN), (const char*)(ws + WS_W13), DM / 2, e, pn, cnt, sst, u0, nb};
                EpiSwiglu E{(unsigned char*)(ws + WS_HID), (const LAS float*)(lds + RSC_OFF), u0};
                pg8::gemm_phase<EpiSwiglu, pg8::ExpertOrder, true, true, true, true>(lds, DM / 2, S, E, (const LAS int*)(lds + ROFF_OFF), (const char*)(ws + WS_HN));
                __syncthreads();
            }
        }
    }
#endif
    GSYNC(11);
#ifndef NO_P8
    {
        for (int pair = vcu; pair < NEXP * 4; pair += G) {
            const int e = pair >> 2, pn = pair & 3;
            pg8::ExpertOrder S{(const char*)(ws + WS_HID), (const char*)(ws + WS_W2), 256, e, pn, l_cnt[e], l_sstart[e], 0, (l_cnt[e] + 255) >> 8};
            EpiDown E{(bf16_t*)(ws + WS_Y), W8_DESCALE};
            pg8::gemm_phase<EpiDown, pg8::ExpertOrder, true, true, false, true>(lds, 256, S, E);
            __syncthreads();
        }
    }
#endif
    GSYNC(12);
#endif
    {
        PHASE_IDS;
        const unsigned* ASG = (const unsigned*)(ws + WS_ASG); const bf16_t* Y = (const bf16_t*)(ws + WS_Y); const bf16_t* MIX = (const bf16_t*)(ws + WS_MIX);
        KArgP K_ = kargs(); const float* a_nf = K_->norm_final_w; float* a_out = K_->out; const float* H = K_->x;
        const f32x4* wf = (const f32x4*)a_nf + lane; f32x4 wfv[4];
#pragma unroll
        for (int j = 0; j < 4; ++j) wfv[j] = wf[64 * j];
        u32x4 ra0 = (u32x4){0u, 0u, 0u, 0u}, ra1 = ra0, rb0 = ra0, rb1 = ra0;
        if (gw < NTOK) { ra0 = *(const u32x4*)(ASG + (size_t)gw * 8); ra1 = *(const u32x4*)(ASG + (size_t)gw * 8 + 4); }
        if (gw + NGW < NTOK) { rb0 = *(const u32x4*)(ASG + (size_t)(gw + NGW) * 8); rb1 = *(const u32x4*)(ASG + (size_t)(gw + NGW) * 8 + 4); }
        for (int m = gw; m < NTOK; m += 2 * NGW) {
            const int m2 = m + NGW; const bool has2 = m2 < NTOK; const int mb = has2 ? m2 : m;
            const u32x4 a0 = ra0, a1 = ra1, b0 = rb0, b1 = rb1;
            { const int n1 = m + 2 * NGW, n2 = m + 3 * NGW;
              if (n1 < NTOK) { ra0 = *(const u32x4*)(ASG + (size_t)n1 * 8); ra1 = *(const u32x4*)(ASG + (size_t)n1 * 8 + 4); }
              if (n2 < NTOK) { rb0 = *(const u32x4*)(ASG + (size_t)n2 * 8); rb1 = *(const u32x4*)(ASG + (size_t)n2 * 8 + 4); } }
            const f32x4* xrA = (const f32x4*)(H + (size_t)m * DM) + lane; const u32x2* mrA = (const u32x2*)(MIX + (size_t)m * DM) + lane;
            const f32x4* xrB = (const f32x4*)(H + (size_t)mb * DM) + lane; const u32x2* mrB = (const u32x2*)(MIX + (size_t)mb * DM) + lane;
            f32x4 vA[4], vB[4];
#if EN_MOE
            const float gA1 = __uint_as_float(a0.z), gA2 = __uint_as_float(a1.y), gB1 = __uint_as_float(b0.z), gB2 = __uint_as_float(b1.y);
            const u32x2* yA1 = (const u32x2*)(Y + (size_t)a1.z * DM) + lane; const u32x2* yA2 = (const u32x2*)(Y + (size_t)a1.w * DM) + lane;
            const u32x2* yB1 = (const u32x2*)(Y + (size_t)(has2 ? b1.z : a1.z) * DM) + lane; const u32x2* yB2 = (const u32x2*)(Y + (size_t)(has2 ? b1.w : a1.w) * DM) + lane;
            u32x2 pA1[4], pA2[4], pB1[4], pB2[4];
#pragma unroll
            for (int j = 0; j < 4; ++j) { pA1[j] = yA1[64 * j]; pA2[j] = yA2[64 * j]; pB1[j] = yB1[64 * j]; pB2[j] = yB2[64 * j]; }
#endif
#pragma unroll
            for (int j = 0; j < 4; ++j) { const u32x2 mm = mrA[64 * j]; vA[j] = xrA[64 * j] + (f32x4){bf_lo(mm.x), bf_hi(mm.x), bf_lo(mm.y), bf_hi(mm.y)};
                                          const u32x2 mn = mrB[64 * j]; vB[j] = xrB[64 * j] + (f32x4){bf_lo(mn.x), bf_hi(mn.x), bf_lo(mn.y), bf_hi(mn.y)}; }
#if EN_MOE
#pragma unroll
            for (int j = 0; j < 4; ++j) {
                vA[j].x += gA1 * bf_lo(pA1[j].x) + gA2 * bf_lo(pA2[j].x); vA[j].y += gA1 * bf_hi(pA1[j].x) + gA2 * bf_hi(pA2[j].x); vA[j].z += gA1 * bf_lo(pA1[j].y) + gA2 * bf_lo(pA2[j].y); vA[j].w += gA1 * bf_hi(pA1[j].y) + gA2 * bf_hi(pA2[j].y);
                vB[j].x += gB1 * bf_lo(pB1[j].x) + gB2 * bf_lo(pB2[j].x); vB[j].y += gB1 * bf_hi(pB1[j].x) + gB2 * bf_hi(pB2[j].x); vB[j].z += gB1 * bf_lo(pB1[j].y) + gB2 * bf_lo(pB2[j].y); vB[j].w += gB1 * bf_hi(pB1[j].y) + gB2 * bf_hi(pB2[j].y); }
#endif
            float sA = 0.f, sB = 0.f;
#pragma unroll
            for (int j = 0; j < 4; ++j) { sA += (vA[j].x * vA[j].x + vA[j].y * vA[j].y) + (vA[j].z * vA[j].z + vA[j].w * vA[j].w); sB += (vB[j].x * vB[j].x + vB[j].y * vB[j].y) + (vB[j].z * vB[j].z + vB[j].w * vB[j].w); }
#pragma unroll
            for (int o_ = 1; o_ < 64; o_ <<= 1) { sA += __shfl_xor(sA, o_); sB += __shfl_xor(sB, o_); }
            const float rA = 1.f / sqrtf(sA * (1.f / DM) + NORM_EPS), rB = 1.f / sqrtf(sB * (1.f / DM) + NORM_EPS);
            float pscale = 1.f, padd = 0.f;
            if (PROBE_A >= 1) { const unsigned long long* ts = (const unsigned long long*)(ctl + CW_TS); const float us = (float)(ts[PROBE_A] - ts[PROBE_A0]) * 0.01f; pscale = 1.f + sqrtf(us * PROBE_SCALE); }
            if (PROBE_B >= 1) { const unsigned long long* ts = (const unsigned long long*)(ctl + CW_TS); const float us = (float)(ts[PROBE_B] - ts[PROBE_B0]) * 0.01f; if (m == 0 && lane == 0) padd = us * 0.01f; }
            f32x4* oA = (f32x4*)(a_out + (size_t)m * DM) + lane; f32x4* oB = (f32x4*)(a_out + (size_t)mb * DM) + lane;
#pragma unroll
            for (int j = 0; j < 4; ++j) { f32x4 r = vA[j] * (rA * pscale) * wfv[j]; if (j == 0) r.x += padd; oA[64 * j] = r; }
            if (has2) {
#pragma unroll
                for (int j = 0; j < 4; ++j) oB[64 * j] = vB[j] * (rB * pscale) * wfv[j];
            }
        }
    }
}

extern "C" void kernel_launch(void* const* d_in, const int* in_sizes, int n_in, void* d_out, int out_size, void* d_ws, size_t ws_size, hipStream_t stream) {
    static int grid = 0;
    if (grid == 0) {
        if (n_in != 19 || in_sizes[0] != NTOK * DM || out_size != NTOK * DM || ws_size < WS_END) { fprintf(stderr, "kernel_launch: unexpected problem (n_in %d, ws %zu)\n", n_in, ws_size); grid = -1; return; }
        int dev = 0, cus = 0, per_cu = 0;
        (void)hipGetDevice(&dev); (void)hipDeviceGetAttribute(&cus, hipDeviceAttributeMultiprocessorCount, dev);
        (void)hipFuncSetAttribute((const void*)mega_fwd, hipFuncAttributeMaxDynamicSharedMemorySize, LDS_BYTES);
        (void)hipOccupancyMaxActiveBlocksPerMultiprocessor(&per_cu, (const void*)mega_fwd, NTHREADS, LDS_BYTES);
        (void)hipGetLastError();
        if (per_cu < 1) { fprintf(stderr, "kernel_launch: occupancy query says %d blocks per CU\n", per_cu); per_cu = 1; }
        grid = cus;
    }
    if (grid < 0) return;
    (void)hipMemsetAsync((char*)d_ws + WS_CTL, 0, CTL_ZERO_BYTES, stream);
    Args a{};
    a.x = (const float*)d_in[0]; a.norm_mix_w = (const float*)d_in[1]; a.w_in = (const float*)d_in[2]; a.b_gate = (const float*)d_in[3]; a.dec_f = (const float*)d_in[4]; a.dec_b = (const float*)d_in[5];
    a.gn_w = (const float*)d_in[6]; a.w_a = (const float*)d_in[7]; a.w_b = (const float*)d_in[8]; a.w_o = (const float*)d_in[9]; a.norm_moe_w = (const float*)d_in[10]; a.wg = (const float*)d_in[11];
    a.bg = (const float*)d_in[12]; a.we = (const float*)d_in[13]; a.be = (const float*)d_in[14]; a.w1 = (const float*)d_in[15]; a.w3 = (const float*)d_in[16]; a.w2 = (const float*)d_in[17];
    a.norm_final_w = (const float*)d_in[18]; a.out = (float*)d_out; a.ws = (unsigned char*)d_ws;
    void* args[] = {&a};
    hipError_t e = hipLaunchCooperativeKernel((const void*)mega_fwd, dim3(grid), dim3(NTHREADS), args, LDS_BYTES, stream);
    if (e != hipSuccess) fprintf(stderr, "cooperative launch failed: %s (grid %d)\n", hipGetErrorString(e), grid);
}
```

```cpp
#include <hip/hip_runtime.h>
#include <hip/hip_cooperative_groups.h>
#include <cstdio>
#include <cstdint>
namespace cg = cooperative_groups;

#ifndef EN_ATT
#define EN_ATT 1
#endif
#ifndef EN_RET
#define EN_RET 1
#endif
#ifndef EN_MOE
#define EN_MOE 1
#endif

#define LAS __attribute__((address_space(3)))
#define GAS __attribute__((address_space(1)))
typedef unsigned short bf16_t;
typedef short bf16x8 __attribute__((ext_vector_type(8)));
typedef short s16x4 __attribute__((ext_vector_type(4)));
typedef float f32x4 __attribute__((ext_vector_type(4)));
typedef float f32x2 __attribute__((ext_vector_type(2)));
typedef unsigned u32x4 __attribute__((ext_vector_type(4)));
typedef unsigned u32x2 __attribute__((ext_vector_type(2)));

constexpr int NTOK = 32768, DM = 1024, SEQ = 2048, NBATCH = 16;
constexpr int IN_W = 9728;
constexpr int NEXP = 64;
constexpr float NORM_EPS = 1e-6f;
constexpr float LOG2E = 1.4426950408889634f, LN2 = 0.6931471805599453f;
constexpr float W8_SCALE = 32.f, W8_DESCALE = 1.f / 32.f;
constexpr float Y8_SCALE = 8.f, Y8_DESCALE = 1.f / 8.f;
constexpr float QA_SCALE = 0.125f * LOG2E;
constexpr int NWAVES = 8, NTHREADS = 512;

constexpr size_t MiB = (size_t)1 << 20;
constexpr size_t WS_CTL = 0, CTL_ZERO_BYTES = 65536;
constexpr size_t WS_COS = 1 * MiB, WS_SIN = WS_COS + 262144, WS_WR = WS_COS + 524288;
constexpr size_t WS_ASG = 2 * MiB;
constexpr size_t WS_LSE = 3 * MiB;
constexpr size_t WS_RSTD = 3 * MiB;
constexpr size_t WS_SRSTD = 3 * MiB + 262144;
constexpr size_t WS_TOKL = 4 * MiB;
constexpr size_t WS_RSTD0 = 5 * MiB + 262144;
constexpr size_t WS_CNTT = 5 * MiB;
constexpr size_t WS_WIN = 6 * MiB;
constexpr size_t WS_WA = 25 * MiB;
constexpr size_t WS_WB = 26 * MiB;
constexpr size_t WS_WO = 28 * MiB;
constexpr size_t WS_XN = 30 * MiB;
constexpr size_t WS_MERGED = 94 * MiB;
constexpr size_t WS_QA = 94 * MiB, WS_KA = 190 * MiB, WS_VA = 286 * MiB;
constexpr size_t WS_OUTG = 382 * MiB;
constexpr size_t WS_GATE = 350 * MiB;
constexpr size_t WS_QR = 94 * MiB, WS_KR = 126 * MiB;
constexpr size_t WS_VR = 158 * MiB, WS_GR = 222 * MiB;
constexpr size_t WS_SST = 286 * MiB;
constexpr size_t WS_MIX = 417 * MiB;
constexpr size_t WS_W2 = 158 * MiB;
constexpr size_t WS_W13 = 94 * MiB;
constexpr size_t WS_HN = 224 * MiB;
constexpr size_t WS_XS = 288 * MiB;
constexpr size_t WS_HID = 288 * MiB;
constexpr size_t WS_Y = 94 * MiB;
constexpr size_t WS_XN8 = 510 * MiB;
constexpr size_t WS_WIN8 = 542 * MiB;
constexpr size_t WS_WIN8G = 547 * MiB;
constexpr size_t WS_END = 549 * MiB;

constexpr int RING_BYTES = 131072;
constexpr int MISC_OFF = RING_BYTES;
constexpr int ROFF_OFF = MISC_OFF + 2048;
constexpr int ROFF_UNITS = 15;
constexpr int RSC_OFF = ROFF_OFF + ROFF_UNITS * 256 * 4;
constexpr int LDS_BYTES = 163840;

__device__ __forceinline__ unsigned cvt_pk_bf16(float lo, float hi) { unsigned r; asm volatile("v_cvt_pk_bf16_f32 %0, %1, %2" : "=v"(r) : "v"(lo), "v"(hi)); return r; }
__device__ __forceinline__ unsigned pk_fp8x4(float a, float b, float c, float d) { int w = 0; w = __builtin_amdgcn_cvt_pk_fp8_f32(a, b, w, false); w = __builtin_amdgcn_cvt_pk_fp8_f32(c, d, w, true); return (unsigned)w; }
__device__ __forceinline__ float bf_lo(unsigned w) { return __uint_as_float(w << 16); }
__device__ __forceinline__ float bf_hi(unsigned w) { return __uint_as_float(w & 0xffff0000u); }
__device__ __forceinline__ float fast_exp2(float x) { return __builtin_amdgcn_exp2f(x); }
__device__ __forceinline__ float fast_rcp(float x) { return __builtin_amdgcn_rcpf(x); }
__device__ __forceinline__ float sigmoidf_(float x) { return fast_rcp(1.f + fast_exp2(-x * LOG2E)); }
__device__ __forceinline__ float wave_sum(float v) {
#pragma unroll
    for (int o = 1; o < 64; o <<= 1) v += __shfl_xor(v, o);
    return v;
}
__device__ __forceinline__ s16x4 tr_read(const LAS char* p) {
    typedef short v4i16_t __attribute__((ext_vector_type(4)));
    return __builtin_bit_cast(s16x4, __builtin_amdgcn_ds_read_tr16_b64_v4i16((LAS v4i16_t*)p));
}
__device__ __forceinline__ bf16x8 cat4(s16x4 a, s16x4 b) { return (bf16x8){a[0], a[1], a[2], a[3], b[0], b[1], b[2], b[3]}; }
__device__ __forceinline__ int opaque_tid() { int t = threadIdx.x; asm volatile("" : "+v"(t)); return t; }
#define PHASE_IDS const int tid = opaque_tid(), lane = tid & 63, wave = __builtin_amdgcn_readfirstlane(tid >> 6); const int gw = vcu * NWAVES + wave; (void)gw; (void)lane
__device__ __forceinline__ void glds16(const void* gsrc, unsigned lds_dst) { unsigned keep;
    asm volatile("s_mov_b32 %0, m0\n\ts_mov_b32 m0, %2\n\ts_nop 0\n\tglobal_load_lds_dwordx4 %1, off\n\ts_mov_b32 m0, %0" : "=&s"(keep) : "v"(gsrc), "s"(lds_dst) : "memory"); }
#define LDS_WAIT() asm volatile("s_waitcnt lgkmcnt(0)" ::: "memory")
#define VM_WAIT() asm volatile("s_waitcnt vmcnt(0)" ::: "memory")

namespace pg8 {
constexpr int BM = 256, BK = 64, HALF = 128, HTB = HALF * BK * 2, STAGE_BYTES = 8 * HTB, NXCD = 8, WGM = 8;
__host__ __device__ __forceinline__ int lds_byte(int r, int c) { const int st = (r >> 4) * 2 + (c >> 5), rr = r & 15, cc = c & 31, ob = rr * 64 + cc * 2; return st * 1024 + (ob ^ (((ob >> 9) & 1) << 5)); }
__host__ __device__ __forceinline__ void stage_rc(int b, int& R, int& C) { const int st = b / 1024, sb = b % 1024, swz = sb ^ (((sb >> 9) & 1) << 5); R = (st >> 1) * 16 + swz / 64; C = (st & 1) * 32 + (swz % 64) / 2; }
__host__ __device__ __forceinline__ int g8(int r) { return ((r >> 1) & 1) | (((r >> 3) & 1) << 2); }
__host__ __device__ __forceinline__ int g16(int r) { return (r >> 1) & 7; }
__host__ __device__ __forceinline__ int perm32(int rho) { const int n = rho >> 4, i = rho & 15; return 8 * (i >> 2) + 4 * n + (i & 3); }

struct Unit { int pm, pn; const char* a; const char* b; int e, row0, nrows, tix; };

struct StaticOrder {
    const char* A; const char* Bt; int K;
    int nM, nN, nwg, G, c;
    __device__ void init(const void* A_, const void* Bt_, int M, int N, int K_, int G_, int c_) { A = (const char*)A_; Bt = (const char*)Bt_; K = K_; nM = M / BM; nN = N / BM; nwg = nM * nN; G = G_; c = c_; }
    __device__ bool next(int i, Unit& u) const {
        const long L = (long)i * G + c; if (L >= nwg) return false;
        int wgid = (int)L; { const int q = nwg / NXCD, r = nwg % NXCD, xcd = wgid % NXCD, off = wgid / NXCD; wgid = (xcd < r ? xcd * (q + 1) : r * (q + 1) + (xcd - r) * q) + off; }
        const int nig = WGM * nN, gid = wgid / nig, fm = gid * WGM, gsz = (nM - fm) < WGM ? (nM - fm) : WGM;
        u.pm = fm + ((wgid % nig) % gsz); u.pn = (wgid % nig) / gsz;
        u.a = A + (size_t)u.pm * BM * K * 2; u.b = Bt + (size_t)u.pn * BM * K * 2; u.e = 0; u.row0 = u.pm * BM; u.nrows = BM; u.tix = 0; return true;
    }
};
struct GroupedOrder {
    const char* A; const char* Bt; int K; int G, c;
    const LAS int* cnt; const LAS int* tstart; const LAS int* sstart;
    __device__ bool next(int i, Unit& u) const {
        const int total = tstart[NEXP] * 4; const long L = (long)i * G + c; if (L >= total) return false;
        int wg = (int)L; { const int q = total / NXCD, r = total % NXCD, xcd = wg % NXCD, off = wg / NXCD; wg = (xcd < r ? xcd * (q + 1) : r * (q + 1) + (xcd - r) * q) + off; }
        const int mtg = wg >> 2; u.pn = wg & 3;
        int e = 0; while (e < NEXP - 1 && tstart[e + 1] <= mtg) ++e;
        u.e = e; u.pm = mtg - tstart[e]; u.row0 = sstart[e] + u.pm * BM; int nr = cnt[e] - u.pm * BM; u.nrows = nr < BM ? nr : BM;
        u.tix = 0; u.a = A + (size_t)u.row0 * K * 2; u.b = Bt + ((size_t)e * 1024 + (size_t)u.pn * BM) * K * 2; return true;
    }
};

struct ExpertOrder {
    const char* A; const char* Bt; int K; int e, pn, cnt, sstart, u0, nb;
    __device__ bool next(int i, Unit& u) const {
        if (i >= nb) return false;
        const int m = u0 + i;
        u.pm = m; u.pn = pn; u.e = e; u.tix = i; u.row0 = sstart + m * BM; const int nr = cnt - m * BM; u.nrows = nr < BM ? nr : BM;
        u.a = A + (size_t)u.row0 * K * 2; u.b = Bt + ((size_t)e * 1024 + (size_t)pn * BM) * K * 2; return true;
    }
};

struct ListOrder {
    const char* A; const char* Bt; int K; const LAS int* list; int nb; const LAS int* cnt; const LAS int* sstart;
    __device__ bool next(int i, Unit& u) const {
        if (i >= nb) return false;
        const int e = list[3 * i], pn = list[3 * i + 1], m = list[3 * i + 2];
        u.pm = m; u.pn = pn; u.e = e; u.tix = i; u.row0 = sstart[e] + m * BM; const int nr = cnt[e] - m * BM; u.nrows = nr < BM ? nr : BM;
        u.a = A + (size_t)u.row0 * K * 2; u.b = Bt + ((size_t)e * 1024 + (size_t)pn * BM) * K * 2; return true;
    }
};

template <class Epi, class Sched, bool ALIGN_EPI, bool SP2, bool GATHER = false, bool FP8 = false>
__device__ __forceinline__ void gemm_phase(LAS unsigned char* lds, const int K, const Sched& S, const Epi& E, const LAS int* roff = nullptr, const char* gA = nullptr) {
    const int tid = opaque_tid(), wid = __builtin_amdgcn_readfirstlane(tid >> 6), lane = tid & 63, wr = wid >> 2, wc = wid & 3, fr = lane & 15, fq = lane >> 4;
    const int nt = K / BK;
    unsigned voffA[2], voffB[2];
#pragma unroll
    for (int i = 0; i < 2; ++i) { const int R = (tid >> 3) + 64 * i, C = 8 * ((tid & 7) ^ (FP8 ? g8(R) : g16(R)));
        const int Rb = Epi::PERM ? ((R & ~31) + perm32(R & 31)) : R;
        voffA[i] = (unsigned)(R * K + C) * 2u; voffB[i] = (unsigned)(Rb * K + C) * 2u; }
    const size_t kstep = (size_t)(BK * 2);
    const size_t hstep = (size_t)HALF * K * 2;
    unsigned vC[2][2], vN[2][2];
#define PG8_GLOAD(dst, ui_) do { _Pragma("unroll") for (int h_ = 0; h_ < 2; ++h_) _Pragma("unroll") for (int i_ = 0; i_ < 2; ++i_) { const int R_ = (tid >> 3) + 64 * i_, C_ = 8 * ((tid & 7) ^ (FP8 ? g8(R_) : g16(R_))); \
        dst[h_][i_] = (unsigned)roff[(ui_) * BM + h_ * HALF + R_] + (unsigned)(C_ * 2); } } while (0)
    const unsigned ldsw = (unsigned)wid * 1024u;
    const int aoff = (wr * 64 + fr) * 128 + (FP8 ? (((2 * fq) ^ g8(fr)) << 4) : ((fq ^ g16(fr)) << 4));
    const int boff = (wc * 32 + fr) * 128 + (FP8 ? (((2 * fq) ^ g8(fr)) << 4) : ((fq ^ g16(fr)) << 4));
    const int aoff2 = aoff ^ (FP8 ? 16 : 64), boff2 = boff ^ (FP8 ? 16 : 64);
    typedef int v8i_ __attribute__((ext_vector_type(8))); typedef int v4i_ __attribute__((ext_vector_type(4)));
#define PG8_SA(b, h) (((b) * 2 + (h)) * HTB)
#define PG8_SB(b, h) ((4 + (b) * 2 + (h)) * HTB)
#define PG8_STAGE(bufoff, gbase, voff) do { _Pragma("unroll") for (int _i = 0; _i < 2; ++_i) \
        __builtin_amdgcn_global_load_lds((const unsigned*)((const char*)(gbase) + (voff)[_i]), (LAS unsigned*)(lds + (bufoff) + ldsw + _i * 8192), 16, 0, 0); } while (0)
#define PG8_LD8_(p_, q_) __builtin_shufflevector(*(const LAS v4i_*)(p_), *(const LAS v4i_*)(q_), 0, 1, 2, 3, 4, 5, 6, 7)
#define PG8_LDA(dst, b, h) do { if constexpr (FP8) { _Pragma("unroll") for (int m = 0; m < 4; ++m) dst##8[m] = PG8_LD8_(lds + PG8_SA(b, h) + aoff + m * 2048, lds + PG8_SA(b, h) + aoff2 + m * 2048); } \
        else { _Pragma("unroll") for (int m = 0; m < 4; ++m) _Pragma("unroll") for (int k = 0; k < 2; ++k) dst[m][k] = *(const LAS bf16x8*)(lds + PG8_SA(b, h) + (k ? aoff2 : aoff) + m * 2048); } } while (0)
#define PG8_LDB(dst, b, h) do { if constexpr (FP8) { _Pragma("unroll") for (int n = 0; n < 2; ++n) dst##8[n] = PG8_LD8_(lds + PG8_SB(b, h) + boff + n * 2048, lds + PG8_SB(b, h) + boff2 + n * 2048); } \
        else { _Pragma("unroll") for (int n = 0; n < 2; ++n) _Pragma("unroll") for (int k = 0; k < 2; ++k) dst[n][k] = *(const LAS bf16x8*)(lds + PG8_SB(b, h) + (k ? boff2 : boff) + n * 2048); } } while (0)
#define PG8_MMA(ai, bj, At, Bt) do { __builtin_amdgcn_s_setprio(1); _Pragma("unroll") for (int m = 0; m < 4; ++m) _Pragma("unroll") for (int n = 0; n < 2; ++n) { \
        if constexpr (FP8) asm volatile("v_mfma_scale_f32_16x16x128_f8f6f4 %0, %1, %2, %0, %3, %3 op_sel_hi:[0,0,0]" : "+v"(acc[ai][bj][m][n]) : "v"(Bt##8[n]), "v"(At##8[m]), "v"(mxscale)); \
        else { _Pragma("unroll") for (int k = 0; k < 2; ++k) acc[ai][bj][m][n] = __builtin_amdgcn_mfma_f32_16x16x32_bf16(Bt[n][k], At[m][k], acc[ai][bj][m][n], 0, 0, 0); } } \
        __builtin_amdgcn_s_setprio(0); } while (0)
#define PG8_WAIT_V(n) asm volatile("s_waitcnt vmcnt(" #n ")" ::: "memory")
#define PG8_WAIT_L(n) asm volatile("s_waitcnt lgkmcnt(" #n ")" ::: "memory")
#define PG8_BAR __builtin_amdgcn_s_barrier()
#define PG8_SCHED __builtin_amdgcn_sched_barrier(0)
    Unit cur, nxt; int ui = 0;
    if (!S.next(0, cur)) return;
    f32x4 acc[2][2][4][2];
#pragma unroll
    for (int a = 0; a < 2; ++a)
#pragma unroll
        for (int b = 0; b < 2; ++b)
#pragma unroll
            for (int m = 0; m < 4; ++m)
#pragma unroll
                for (int n = 0; n < 2; ++n) acc[a][b][m][n] = (f32x4){0.f, 0.f, 0.f, 0.f};
    const int mxscale = 0x7f7f7f7f;
    bf16x8 At[4][2], B0[2][2], B1[2][2]; v8i_ At8[4], B08[2], B18[2];
    const char* cA = GATHER ? gA : cur.a; const char* cB = cur.b;
    if constexpr (GATHER) { PG8_GLOAD(vC, 0); PG8_WAIT_L(0); }
    if constexpr (SP2) {
        PG8_STAGE(PG8_SB(0, 0), cB, voffB); PG8_STAGE(PG8_SB(0, 1), cB + hstep, voffB);
        if constexpr (GATHER) { PG8_STAGE(PG8_SA(0, 0), cA, vC[0]); PG8_STAGE(PG8_SA(0, 1), cA, vC[1]); } else { PG8_STAGE(PG8_SA(0, 0), cA, voffA); PG8_STAGE(PG8_SA(0, 1), cA + hstep, voffA); }
        if (wr == 1) PG8_BAR;
        PG8_WAIT_V(2); PG8_BAR;
        PG8_STAGE(PG8_SB(1, 0), cB + kstep, voffB); if constexpr (GATHER) PG8_STAGE(PG8_SA(1, 0), cA + kstep, vC[0]); else PG8_STAGE(PG8_SA(1, 0), cA + kstep, voffA); PG8_STAGE(PG8_SB(1, 1), cB + hstep + kstep, voffB);
        PG8_WAIT_V(6); PG8_BAR;
    } else {
        PG8_STAGE(PG8_SB(0, 0), cB, voffB); PG8_STAGE(PG8_SA(0, 0), cA, voffA); PG8_STAGE(PG8_SB(0, 1), cB + hstep, voffB); PG8_STAGE(PG8_SA(0, 1), cA + hstep, voffA);
        if (wr == 1) PG8_BAR;
        PG8_WAIT_V(4); PG8_BAR;
        PG8_STAGE(PG8_SB(1, 0), cB + kstep, voffB); PG8_STAGE(PG8_SA(1, 0), cA + kstep, voffA); PG8_STAGE(PG8_SB(1, 1), cB + hstep + kstep, voffB);
        PG8_WAIT_V(6); PG8_BAR;
    }
    for (;;) {
        const bool has_next = S.next(ui + 1, nxt);
        const char* nA = GATHER ? cA : (has_next ? nxt.a : cA); const char* nB = has_next ? nxt.b : cB;
        if constexpr (GATHER) { if (has_next) { PG8_GLOAD(vN, ui + 1); } else { vN[0][0] = vC[0][0]; vN[0][1] = vC[0][1]; vN[1][0] = vC[1][0]; vN[1][1] = vC[1][1]; } }
#pragma unroll 1
        for (int t = 0; t < nt; t += 2) {
            const bool last = (t == nt - 2);
            const char* a1 = cA + (size_t)(t + 1) * kstep;
            const char* a2 = last ? nA : cA + (size_t)(t + 2) * kstep; const char* b2 = last ? nB : cB + (size_t)(t + 2) * kstep;
            const char* a3 = a2 + kstep; const char* b3 = b2 + kstep;
            if constexpr (Epi::MID_T >= 0) { if (t == Epi::MID_T) E.mid(acc, cur, wr, wc, fr, fq); }
            if constexpr (SP2) {
            if constexpr (GATHER) {
            unsigned g0[2] = {last ? vN[0][0] : vC[0][0], last ? vN[0][1] : vC[0][1]}, g1[2] = {last ? vN[1][0] : vC[1][0], last ? vN[1][1] : vC[1][1]};
            PG8_LDB(B0, 0, 0); PG8_LDB(B1, 0, 1); PG8_SCHED; PG8_LDA(At, 0, 0); PG8_STAGE(PG8_SA(1, 1), a1, vC[1]);
            PG8_WAIT_V(8); PG8_WAIT_L(0); PG8_BAR; PG8_MMA(0, 0, At, B0); PG8_MMA(0, 1, At, B1); PG8_BAR; PG8_SCHED;
            PG8_LDA(At, 0, 1); PG8_STAGE(PG8_SB(0, 0), b2, voffB); PG8_STAGE(PG8_SB(0, 1), b2 + hstep, voffB); PG8_STAGE(PG8_SA(0, 0), a2, g0);
            PG8_WAIT_V(8); PG8_WAIT_L(0); PG8_BAR; PG8_MMA(1, 0, At, B0); PG8_MMA(1, 1, At, B1); PG8_BAR; PG8_SCHED;
            PG8_LDB(B0, 1, 0); PG8_LDB(B1, 1, 1); PG8_SCHED; PG8_LDA(At, 1, 0); PG8_STAGE(PG8_SA(0, 1), a2, g1);
            PG8_WAIT_V(8); PG8_WAIT_L(0); PG8_BAR; PG8_MMA(0, 0, At, B0); PG8_MMA(0, 1, At, B1); PG8_BAR; PG8_SCHED;
            PG8_LDA(At, 1, 1); PG8_STAGE(PG8_SB(1, 0), b3, voffB); PG8_STAGE(PG8_SB(1, 1), b3 + hstep, voffB); PG8_STAGE(PG8_SA(1, 0), a3, g0);
            PG8_WAIT_V(8); PG8_WAIT_L(0); PG8_BAR; PG8_MMA(1, 0, At, B0); PG8_MMA(1, 1, At, B1); PG8_BAR; PG8_SCHED;
            } else {
            PG8_LDB(B0, 0, 0); PG8_LDB(B1, 0, 1); PG8_SCHED; PG8_LDA(At, 0, 0); PG8_STAGE(PG8_SA(1, 1), a1 + hstep, voffA);
            PG8_WAIT_V(8); PG8_WAIT_L(0); PG8_BAR; PG8_MMA(0, 0, At, B0); PG8_MMA(0, 1, At, B1); PG8_BAR; PG8_SCHED;
            PG8_LDA(At, 0, 1); PG8_STAGE(PG8_SB(0, 0), b2, voffB); PG8_STAGE(PG8_SB(0, 1), b2 + hstep, voffB); PG8_STAGE(PG8_SA(0, 0), a2, voffA);
            PG8_WAIT_V(8); PG8_WAIT_L(0); PG8_BAR; PG8_MMA(1, 0, At, B0); PG8_MMA(1, 1, At, B1); PG8_BAR; PG8_SCHED;
            PG8_LDB(B0, 1, 0); PG8_LDB(B1, 1, 1); PG8_SCHED; PG8_LDA(At, 1, 0); PG8_STAGE(PG8_SA(0, 1), a2 + hstep, voffA);
            PG8_WAIT_V(8); PG8_WAIT_L(0); PG8_BAR; PG8_MMA(0, 0, At, B0); PG8_MMA(0, 1, At, B1); PG8_BAR; PG8_SCHED;
            PG8_LDA(At, 1, 1); PG8_STAGE(PG8_SB(1, 0), b3, voffB); PG8_STAGE(PG8_SB(1, 1), b3 + hstep, voffB); PG8_STAGE(PG8_SA(1, 0), a3, voffA);
            PG8_WAIT_V(8); PG8_WAIT_L(0); PG8_BAR; PG8_MMA(1, 0, At, B0); PG8_MMA(1, 1, At, B1); PG8_BAR; PG8_SCHED;
            }
            } else {
            PG8_LDB(B0, 0, 0); PG8_SCHED; PG8_LDA(At, 0, 0); PG8_STAGE(PG8_SA(1, 1), a1 + hstep, voffA);
            PG8_WAIT_L(8); PG8_BAR; PG8_WAIT_L(0); PG8_MMA(0, 0, At, B0); PG8_BAR; PG8_SCHED;
            PG8_LDB(B1, 0, 1); PG8_STAGE(PG8_SB(0, 0), b2, voffB);
            PG8_BAR; PG8_WAIT_L(0); PG8_MMA(0, 1, At, B1); PG8_BAR;
            PG8_LDA(At, 0, 1); PG8_STAGE(PG8_SA(0, 0), a2, voffA);
            PG8_BAR; PG8_WAIT_L(0); PG8_MMA(1, 0, At, B0); PG8_BAR; PG8_SCHED;
            PG8_STAGE(PG8_SB(0, 1), b2 + hstep, voffB);
            PG8_WAIT_V(6); PG8_BAR; PG8_MMA(1, 1, At, B1); PG8_BAR;
            PG8_LDB(B0, 1, 0); PG8_SCHED; PG8_LDA(At, 1, 0); PG8_STAGE(PG8_SA(0, 1), a2 + hstep, voffA);
            PG8_WAIT_L(8); PG8_BAR; PG8_WAIT_L(0); PG8_MMA(0, 0, At, B0); PG8_BAR; PG8_SCHED;
            PG8_LDB(B1, 1, 1); PG8_STAGE(PG8_SB(1, 0), b3, voffB);
            PG8_BAR; PG8_WAIT_L(0); PG8_MMA(0, 1, At, B1); PG8_BAR;
            PG8_LDA(At, 1, 1); PG8_STAGE(PG8_SA(1, 0), a3, voffA);
            PG8_BAR; PG8_WAIT_L(0); PG8_MMA(1, 0, At, B0); PG8_BAR; PG8_SCHED;
            PG8_STAGE(PG8_SB(1, 1), b3 + hstep, voffB);
            PG8_WAIT_V(6); PG8_BAR; PG8_MMA(1, 1, At, B1); PG8_BAR;
            }
        }
        if constexpr (ALIGN_EPI) { if (wr == 0) PG8_BAR; }
        if constexpr (FP8) asm volatile("s_nop 15\n\ts_nop 15" ::: "memory");
        E(acc, cur, wr, wc, fr, fq);
        if (!has_next) break;
#pragma unroll
        for (int a = 0; a < 2; ++a)
#pragma unroll
            for (int b = 0; b < 2; ++b)
#pragma unroll
                for (int m = 0; m < 4; ++m)
#pragma unroll
                    for (int n = 0; n < 2; ++n) acc[a][b][m][n] = (f32x4){0.f, 0.f, 0.f, 0.f};
        cur = nxt; cA = nA; cB = nB; ++ui;
        if constexpr (GATHER) { vC[0][0] = vN[0][0]; vC[0][1] = vN[0][1]; vC[1][0] = vN[1][0]; vC[1][1] = vN[1][1]; }
        if constexpr (ALIGN_EPI) { if (wr == 1) PG8_BAR; }
    }
    PG8_WAIT_V(0);
    if constexpr (!ALIGN_EPI) { if (wr == 0) PG8_BAR; }
    PG8_BAR;
#undef PG8_GLOAD
#undef PG8_SA
#undef PG8_SB
#undef PG8_STAGE
#undef PG8_LDA
#undef PG8_LD8_
#undef PG8_LDB
#undef PG8_MMA
#undef PG8_WAIT_V
#undef PG8_WAIT_L
#undef PG8_BAR
#undef PG8_SCHED
}
}

struct RotF { float f[4]; };
__device__ __forceinline__ RotF rot_freqs(int q) { RotF r;
#pragma unroll
    for (int i = 0; i < 4; ++i) r.f[i] = fast_exp2(-(float)(2 * (4 * q + i)) * (13.287712379549449f / 64.f)) * 0.15915494309189535f;
    return r; }
__device__ __forceinline__ void rot_cs(const RotF& rf, int pos, f32x4& c4, f32x4& s4) {
    const float p = (float)pos;
#pragma unroll
    for (int i = 0; i < 4; ++i) { const float r = __builtin_amdgcn_fractf(p * rf.f[i]); c4[i] = __builtin_amdgcn_cosf(r); s4[i] = __builtin_amdgcn_sinf(r); }
}

__device__ __forceinline__ unsigned gate_pk4(const f32x4 g) { unsigned w = 0u;
    w = __builtin_amdgcn_cvt_pk_u8_f32(floorf(g[0] * 256.f), 0, w); w = __builtin_amdgcn_cvt_pk_u8_f32(floorf(g[1] * 256.f), 1, w); w = __builtin_amdgcn_cvt_pk_u8_f32(floorf(g[2] * 256.f), 2, w); w = __builtin_amdgcn_cvt_pk_u8_f32(floorf(g[3] * 256.f), 3, w); return w; }
__device__ __forceinline__ f32x4 gate_up4(unsigned w) { return (f32x4){(float)(w & 0xffu), (float)((w >> 8) & 0xffu), (float)((w >> 16) & 0xffu), (float)(w >> 24)} * (1.f / 256.f) + (0.5f / 256.f); }

typedef f32x4 acc_t[2][2][4][2];

struct EpiProj {
    static constexpr bool PERM = true; static constexpr int MID_T = -1;
    unsigned char* ws; bf16_t* gate; const float* bias; int pn_off; float descale;
    __device__ __forceinline__ void operator()(const acc_t& acc, const pg8::Unit& u, int wr, int wc, int fr, int fq) const {
        asm volatile("" : "+v"(fr), "+v"(fq));
        const int pn = u.pn + pn_off;
        const int row0 = u.pm * 256 + wr * 64 + fr;
        int mode, ld, colt; bf16_t* base; float sc = descale;
        if (pn < 6) { mode = 0; base = (bf16_t*)(ws + WS_QA); ld = 1536; colt = pn * 256; sc = QA_SCALE * descale; }
        else if (pn < 12) { mode = 0; base = (bf16_t*)(ws + WS_KA); ld = 1536; colt = (pn - 6) * 256; }
        else if (pn < 18) { mode = 1; base = (bf16_t*)(ws + WS_VA); ld = 1536; colt = (pn - 12) * 256; }
        else if (pn < 20) { mode = 0; base = (bf16_t*)(ws + WS_QR); ld = 512; colt = (pn - 18) * 256; }
        else if (pn < 22) { mode = 0; base = (bf16_t*)(ws + WS_KR); ld = 512; colt = (pn - 20) * 256; sc = 0.125f * descale; }
        else if (pn < 26) { mode = 1; base = (bf16_t*)(ws + WS_VR); ld = 1024; colt = (pn - 22) * 256; }
        else if (pn < 30) { mode = 2; base = (bf16_t*)(ws + WS_GR); ld = 1024; colt = (pn - 26) * 256; }
        else { mode = 3; base = (bf16_t*)(ws + WS_GATE); ld = 2048; colt = (pn - 30) * 256; }
        if (mode == 0) {
            const int q = 4 * (wc & 1) + fq; const RotF rf = rot_freqs(q);
#pragma unroll
            for (int ai = 0; ai < 2; ++ai)
#pragma unroll
                for (int m = 0; m < 4; ++m) {
                    const int row = row0 + ai * 128 + m * 16; const int pos = row & (SEQ - 1);
                    f32x4 c4, s4; rot_cs(rf, pos, c4, s4);
#pragma unroll
                    for (int bj = 0; bj < 2; ++bj) {
                        const f32x4 t1 = acc[ai][bj][m][0], t2 = acc[ai][bj][m][1];
                        const f32x4 o1 = (t1 * c4 - t2 * s4) * sc, o2 = (t1 * s4 + t2 * c4) * sc;
                        bf16_t* p = base + (size_t)row * ld + colt + 128 * bj + 64 * (wc >> 1) + 8 * q;
                        u32x4 w; w.x = cvt_pk_bf16(o1[0], o1[1]); w.y = cvt_pk_bf16(o1[2], o1[3]); w.z = cvt_pk_bf16(o2[0], o2[1]); w.w = cvt_pk_bf16(o2[2], o2[3]);
                        *(u32x4*)p = w;
                    }
                }
        } else {
            const int col0 = colt + wc * 32 + 8 * fq;
            if (mode == 1) {
#pragma unroll
                for (int ai = 0; ai < 2; ++ai)
#pragma unroll
                    for (int m = 0; m < 4; ++m) {
                        bf16_t* rowp = base + (size_t)(row0 + ai * 128 + m * 16) * ld + col0;
#pragma unroll
                        for (int bj = 0; bj < 2; ++bj) { const f32x4 v0 = acc[ai][bj][m][0] * sc, v1 = acc[ai][bj][m][1] * sc;
                            u32x4 w; w.x = cvt_pk_bf16(v0[0], v0[1]); w.y = cvt_pk_bf16(v0[2], v0[3]); w.z = cvt_pk_bf16(v1[0], v1[1]); w.w = cvt_pk_bf16(v1[2], v1[3]);
                            *(u32x4*)(rowp + bj * 128) = w; }
                    }
            } else if (mode == 2) {
                const float ks = -sc * LOG2E;
#pragma unroll
                for (int ai = 0; ai < 2; ++ai)
#pragma unroll
                    for (int m = 0; m < 4; ++m) {
                        bf16_t* rowp = base + (size_t)(row0 + ai * 128 + m * 16) * ld + col0;
#pragma unroll
                        for (int bj = 0; bj < 2; ++bj) {
                            const f32x4 a0 = acc[ai][bj][m][0], a1 = acc[ai][bj][m][1];
                            f32x4 e0 = a0 * ks, e1 = a1 * ks;
#pragma unroll
                            for (int i = 0; i < 4; ++i) { e0[i] = fast_exp2(e0[i]); e1[i] = fast_exp2(e1[i]); }
                            e0 = e0 + 1.f; e1 = e1 + 1.f;
#pragma unroll
                            for (int i = 0; i < 4; ++i) { e0[i] = fast_rcp(e0[i]); e1[i] = fast_rcp(e1[i]); }
                            const f32x4 v0 = (a0 * sc) * e0, v1 = (a1 * sc) * e1;
                            u32x4 w; w.x = cvt_pk_bf16(v0[0], v0[1]); w.y = cvt_pk_bf16(v0[2], v0[3]); w.z = cvt_pk_bf16(v1[0], v1[1]); w.w = cvt_pk_bf16(v1[2], v1[3]);
                            *(u32x4*)(rowp + bj * 128) = w; }
                    }
            } else {
                const float ks = -sc * LOG2E;
                f32x4 nb[2][2];
#pragma unroll
                for (int bj = 0; bj < 2; ++bj)
#pragma unroll
                    for (int n = 0; n < 2; ++n) nb[bj][n] = *(const f32x4*)(bias + col0 + bj * 128 + 4 * n) * (-LOG2E);
#pragma unroll
                for (int ai = 0; ai < 2; ++ai)
#pragma unroll
                    for (int m = 0; m < 4; ++m) {
                        unsigned char* rowp = (unsigned char*)base + (size_t)(row0 + ai * 128 + m * 16) * 2048 + col0;
#pragma unroll
                        for (int bj = 0; bj < 2; ++bj) {
                            f32x4 e0 = acc[ai][bj][m][0] * ks + nb[bj][0], e1 = acc[ai][bj][m][1] * ks + nb[bj][1];
#pragma unroll
                            for (int i = 0; i < 4; ++i) { e0[i] = fast_exp2(e0[i]); e1[i] = fast_exp2(e1[i]); }
                            e0 = e0 + 1.f; e1 = e1 + 1.f;
#pragma unroll
                            for (int i = 0; i < 4; ++i) { e0[i] = fast_rcp(e0[i]); e1[i] = fast_rcp(e1[i]); }
                            u32x2 w; w.x = gate_pk4(e0); w.y = gate_pk4(e1);
                            *(u32x2*)(rowp + bj * 128) = w; }
                    }
            }
        }
    }
};

struct EpiProjAtt {
    static constexpr bool PERM = true; static constexpr int MID_T = -1;
    unsigned char* ws; float descale;
    __device__ __forceinline__ void operator()(const acc_t& acc, const pg8::Unit& u, int wr, int wc, int, int) const {
        const int lane_ = opaque_tid() & 63, fr = lane_ & 15, fq = lane_ >> 4;
        const int pn = u.pn, row0 = u.pm * 256 + wr * 64 + fr;
        bf16_t* base = (bf16_t*)(ws + (pn < 6 ? WS_QA : (pn < 12 ? WS_KA : WS_VA))); const int pt = (pn < 6 ? pn : (pn < 12 ? pn - 6 : pn - 12));
        const float sc = (pn < 6 ? QA_SCALE : 1.f) * descale;
        const int grp = pt >> 1;
        if (pn < 12) {
            const int q = 4 * (wc & 1) + fq; const RotF rf = rot_freqs(q);
#pragma unroll
            for (int ai = 0; ai < 2; ++ai)
#pragma unroll
                for (int m = 0; m < 4; ++m) {
                    const int row = row0 + ai * 128 + m * 16; const int pos = row & (SEQ - 1), b = row >> 11;
                    f32x4 c4, s4; rot_cs(rf, pos, c4, s4);
#pragma unroll
                    for (int bj = 0; bj < 2; ++bj) {
                        const f32x4 t1 = acc[ai][bj][m][0], t2 = acc[ai][bj][m][1];
                        const f32x4 o1 = (t1 * c4 - t2 * s4) * sc, o2 = (t1 * s4 + t2 * c4) * sc;
                        const int hd = 4 * (pt & 1) + 2 * bj + (wc >> 1);
                        bf16_t* p = base + ((size_t)((b * 3 + grp) * 8 + hd) * SEQ + pos) * 64 + 8 * q;
                        u32x4 w; w.x = cvt_pk_bf16(o1[0], o1[1]); w.y = cvt_pk_bf16(o1[2], o1[3]); w.z = cvt_pk_bf16(o2[0], o2[1]); w.w = cvt_pk_bf16(o2[2], o2[3]);
                        *(u32x4*)p = w;
                    }
                }
        } else {
#pragma unroll
            for (int ai = 0; ai < 2; ++ai)
#pragma unroll
                for (int m = 0; m < 4; ++m) {
                    const int row = row0 + ai * 128 + m * 16; const int pos = row & (SEQ - 1), b = row >> 11;
#pragma unroll
                    for (int bj = 0; bj < 2; ++bj) {
                        const f32x4 v0 = acc[ai][bj][m][0] * sc, v1 = acc[ai][bj][m][1] * sc;
                        const int hd = 4 * (pt & 1) + 2 * bj + (wc >> 1);
                        bf16_t* p = base + ((size_t)((b * 3 + grp) * 8 + hd) * SEQ + pos) * 64 + 32 * (wc & 1) + 8 * fq;
                        u32x4 w; w.x = cvt_pk_bf16(v0[0], v0[1]); w.y = cvt_pk_bf16(v0[2], v0[3]); w.z = cvt_pk_bf16(v1[0], v1[1]); w.w = cvt_pk_bf16(v1[2], v1[3]);
                        *(u32x4*)p = w;
                    }
                }
        }
    }
};
struct EpiMerge {
    static constexpr bool PERM = true; static constexpr int MID_T = 8;
    bf16_t* out; const bf16_t* gate;
    __device__ __forceinline__ void mid(acc_t& acc, const pg8::Unit& u, int wr, int wc, int fr, int fq) const {
        int row0 = u.pm * 256 + wr * 64 + fr, col0 = u.pn * 256 + wc * 32 + 8 * fq;
        asm volatile("" : "+v"(row0), "+v"(col0));
        u32x2 ga[2][4][2], gb[2][4][2];
#pragma unroll
        for (int ai = 0; ai < 2; ++ai)
#pragma unroll
            for (int m = 0; m < 4; ++m)
#pragma unroll
                for (int bj = 0; bj < 2; ++bj) { const unsigned char* gp = (const unsigned char*)gate + (size_t)(row0 + ai * 128 + m * 16) * 2048 + col0 + bj * 128; ga[ai][m][bj] = *(const u32x2*)gp; gb[ai][m][bj] = *(const u32x2*)(gp + 1024); }
        asm volatile("" ::: "memory");
#pragma unroll
        for (int ai = 0; ai < 2; ++ai)
#pragma unroll
            for (int m = 0; m < 4; ++m)
#pragma unroll
                for (int bj = 0; bj < 2; ++bj) { const f32x4 a0 = gate_up4(ga[ai][m][bj].x), a1 = gate_up4(ga[ai][m][bj].y), b0 = gate_up4(gb[ai][m][bj].x), b1 = gate_up4(gb[ai][m][bj].y);
#pragma unroll
                    for (int i = 0; i < 4; ++i) { acc[ai][bj][m][0][i] *= a0[i] * fast_rcp(b0[i]); acc[ai][bj][m][1][i] *= a1[i] * fast_rcp(b1[i]); } }
        asm volatile("" ::: "memory");
    }
    __device__ __forceinline__ void operator()(const acc_t& acc, const pg8::Unit& u, int wr, int wc, int fr, int fq) const {
        const int row0 = u.pm * 256 + wr * 64 + fr, col0 = u.pn * 256 + wc * 32 + 8 * fq;
        u32x2 g[2][4][2];
#pragma unroll
        for (int ai = 0; ai < 2; ++ai)
#pragma unroll
            for (int m = 0; m < 4; ++m)
#pragma unroll
                for (int bj = 0; bj < 2; ++bj) g[ai][m][bj] = *(const u32x2*)((const unsigned char*)gate + (size_t)(row0 + ai * 128 + m * 16) * 2048 + 1024 + col0 + bj * 128);
        asm volatile("" ::: "memory");
#pragma unroll
        for (int ai = 0; ai < 2; ++ai)
#pragma unroll
            for (int m = 0; m < 4; ++m) {
                const size_t row = (size_t)(row0 + ai * 128 + m * 16);
#pragma unroll
                for (int bj = 0; bj < 2; ++bj) {
                    const u32x2 gg = g[ai][m][bj];
                    const f32x4 v0 = acc[ai][bj][m][0] * gate_up4(gg.x), v1 = acc[ai][bj][m][1] * gate_up4(gg.y);
                    u32x4 w; w.x = cvt_pk_bf16(v0[0], v0[1]); w.y = cvt_pk_bf16(v0[2], v0[3]); w.z = cvt_pk_bf16(v1[0], v1[1]); w.w = cvt_pk_bf16(v1[2], v1[3]);
                    *(u32x4*)(out + row * 1024 + col0 + bj * 128) = w;
                }
            }
    }
};
struct EpiPlain {
    static constexpr bool PERM = true; static constexpr int MID_T = -1;
    bf16_t* O;
    __device__ __forceinline__ void operator()(const acc_t& acc, const pg8::Unit& u, int wr, int wc, int fr, int fq) const {
        const int row0 = u.pm * 256 + wr * 64 + fr, col0 = u.pn * 256 + wc * 32 + 8 * fq;
#pragma unroll
        for (int ai = 0; ai < 2; ++ai)
#pragma unroll
            for (int m = 0; m < 4; ++m) {
                bf16_t* rowp = O + (size_t)(row0 + ai * 128 + m * 16) * 1024 + col0;
#pragma unroll
                for (int bj = 0; bj < 2; ++bj) { const f32x4 v0 = acc[ai][bj][m][0], v1 = acc[ai][bj][m][1];
                    u32x4 w; w.x = cvt_pk_bf16(v0[0], v0[1]); w.y = cvt_pk_bf16(v0[2], v0[3]); w.z = cvt_pk_bf16(v1[0], v1[1]); w.w = cvt_pk_bf16(v1[2], v1[3]);
                    *(u32x4*)(rowp + bj * 128) = w; }
            }
    }
};
struct EpiSwiglu {
    static constexpr bool PERM = true; static constexpr int MID_T = -1;
    unsigned char* hid; const LAS float* rs_tab;
    __device__ __forceinline__ void operator()(const acc_t& acc, const pg8::Unit& u, int wr, int wc, int, int) const {
        const int lane_ = opaque_tid() & 63, fr = lane_ & 15, fq = lane_ >> 4;
        const int col0 = u.pn * 128 + wc * 32 + 8 * fq;
#pragma unroll
        for (int ai = 0; ai < 2; ++ai)
#pragma unroll
            for (int m = 0; m < 4; ++m) {
                const int rl = ai * 128 + wr * 64 + m * 16 + fr;
                const float rs = rs_tab[u.tix * 256 + rl];
                f32x4 v0, v1;
#pragma unroll
                for (int i = 0; i < 4; ++i) { const float a0 = acc[ai][0][m][0][i] * rs, a1 = acc[ai][0][m][1][i] * rs;
                    v0[i] = a0 * sigmoidf_(a0) * (acc[ai][1][m][0][i] * rs); v1[i] = a1 * sigmoidf_(a1) * (acc[ai][1][m][1][i] * rs); }
                u32x2 w; w.x = pk_fp8x4(v0[0], v0[1], v0[2], v0[3]); w.y = pk_fp8x4(v1[0], v1[1], v1[2], v1[3]);
                if (rl < u.nrows) *(u32x2*)(hid + (size_t)(u.row0 + rl) * 512 + col0) = w;
            }
    }
};
struct EpiDown {
    static constexpr bool PERM = true; static constexpr int MID_T = -1;
    unsigned char* Y; float descale;
    __device__ __forceinline__ void operator()(const acc_t& acc, const pg8::Unit& u, int wr, int wc, int fr, int fq) const {
        const int col0 = u.pn * 256 + wc * 32 + 8 * fq;
#pragma unroll
        for (int ai = 0; ai < 2; ++ai)
#pragma unroll
            for (int m = 0; m < 4; ++m) {
                const int rl = ai * 128 + wr * 64 + m * 16 + fr;
#pragma unroll
                for (int bj = 0; bj < 2; ++bj) {
                    const f32x4 v0 = acc[ai][bj][m][0] * descale, v1 = acc[ai][bj][m][1] * descale;
                    u32x2 w; w.x = pk_fp8x4(v0[0], v0[1], v0[2], v0[3]); w.y = pk_fp8x4(v1[0], v1[1], v1[2], v1[3]);
                    if (rl < u.nrows) *(u32x2*)(Y + (size_t)(u.row0 + rl) * 1024 + col0 + bj * 128) = w;
                }
            }
    }
};

struct Args {
    const float* x; const float* norm_mix_w; const float* w_in; const float* b_gate; const float* dec_f; const float* dec_b; const float* gn_w;
    const float* w_a; const float* w_b; const float* w_o; const float* norm_moe_w; const float* wg; const float* bg; const float* we; const float* be;
    const float* w1; const float* w3; const float* w2; const float* norm_final_w;
    float* out; unsigned char* ws;
};

template <int MAP>
__device__ __forceinline__ void transpose_item(const float* W, int K, int N, bf16_t* WT, int row_off, LAS float* scr, int item, int lane, const float* kscale) {
    const int nblk = N / 32, kb = item / nblk, nb = item % nblk, k0 = 64 * kb, n0 = 32 * nb;
#pragma unroll 8
    for (int i = 0; i < 32; ++i) { const int kk = 2 * i + (lane >> 5); float v = W[(size_t)(k0 + kk) * N + n0 + (lane & 31)]; if (kscale) v *= kscale[k0 + kk]; scr[kk * 33 + (lane & 31)] = v; }
    LDS_WAIT(); asm volatile("" ::: "memory");
    const int c = lane & 7;
#pragma unroll
    for (int j = 0; j < 4; ++j) { const int n = (lane >> 3) + 8 * j; const LAS float* s = scr + (8 * c) * 33 + n;
        u32x4 o; o.x = cvt_pk_bf16(s[0 * 33], s[1 * 33]); o.y = cvt_pk_bf16(s[2 * 33], s[3 * 33]); o.z = cvt_pk_bf16(s[4 * 33], s[5 * 33]); o.w = cvt_pk_bf16(s[6 * 33], s[7 * 33]);
        const int lc = n0 + n; int dr;
        if (MAP == 0) dr = row_off + lc;
        else if (MAP == 1) dr = row_off + (lc & ~63) + 8 * ((lc & 31) >> 2) + 4 * ((lc >> 5) & 1) + (lc & 3);
        else dr = (lc >> 7) * 256 + row_off + (lc & 127);
        *(u32x4*)(WT + (size_t)dr * K + k0 + 8 * c) = o; }
    LDS_WAIT(); asm volatile("" ::: "memory");
}

template <int MAP, bool NT>
__device__ __forceinline__ void transpose_tile64(const float* W, int K, int N, bf16_t* WT, int row_off, LAS unsigned* T, int item, int lane, int ldw = 0, int koff = 0, const float* kscale = nullptr) {
    if (ldw == 0) ldw = K;
    const int kblk = K / 64, nb = item / kblk, kb = item % kblk, k0 = 64 * kb, n0 = 64 * nb;
    const int kp = lane >> 4, n4 = lane & 15;
    f32x4 ra[8], rb[8];
    const float* src = W + (size_t)(k0 + 2 * kp) * N + n0 + 4 * n4;
#pragma unroll
    for (int i = 0; i < 8; ++i) {
        const f32x4* pa = (const f32x4*)(src + (size_t)(8 * i) * N); const f32x4* pb = (const f32x4*)(src + (size_t)(8 * i + 1) * N);
        if (NT) { ra[i] = __builtin_nontemporal_load(pa); rb[i] = __builtin_nontemporal_load(pb); } else { ra[i] = *pa; rb[i] = *pb; }
    }
#pragma unroll
    for (int i = 0; i < 8; ++i)
#pragma unroll
        for (int c = 0; c < 4; ++c) { const int n = 4 * n4 + c, kpair = 4 * i + kp; const float sa_ = kscale ? kscale[k0 + 2 * kp + 8 * i] : 1.f, sb_ = kscale ? kscale[k0 + 2 * kp + 8 * i + 1] : 1.f;
            T[n * 32 + (kpair ^ (((n >> 2) & 7) << 2))] = cvt_pk_bf16(ra[i][c] * sa_, rb[i][c] * sb_); }
#pragma unroll
    for (int j = 0; j < 8; ++j) {
        const int row = 8 * j + (lane >> 3), chunk = lane & 7;
        const u32x4 v = *(const LAS u32x4*)(T + row * 32 + 4 * (chunk ^ ((row >> 2) & 7)));
        const int lc = n0 + row; int dr;
        if (MAP == 0) dr = row_off + lc;
        else if (MAP == 1) dr = row_off + (lc & ~63) + 8 * ((lc & 31) >> 2) + 4 * ((lc >> 5) & 1) + (lc & 3);
        else dr = (lc >> 7) * 256 + row_off + (lc & 127);
        *(u32x4*)(WT + (size_t)dr * ldw + koff + k0 + 8 * chunk) = v;
    }
}

template <int MAP, bool NT>
__device__ __forceinline__ void transpose_tile_fp8(const float* W, int K, int N, unsigned char* WT, int row_off, LAS unsigned* T, int item, int lane, float scale) {
    const int kblk = K / 128, nb = item / kblk, kb = item % kblk, k0 = 128 * kb, n0 = 64 * nb;
    const int kp = lane >> 4, n4 = lane & 15;
#pragma unroll
    for (int hh = 0; hh < 2; ++hh) {
        f32x4 r[4][4];
        const float* src = W + (size_t)(k0 + 64 * hh + 4 * kp) * N + n0 + 4 * n4;
#pragma unroll
        for (int i = 0; i < 4; ++i)
#pragma unroll
            for (int q = 0; q < 4; ++q) { const f32x4* p = (const f32x4*)(src + (size_t)(16 * i + q) * N); if (NT) r[i][q] = __builtin_nontemporal_load(p); else r[i][q] = *p; }
#pragma unroll
        for (int i = 0; i < 4; ++i)
#pragma unroll
            for (int c = 0; c < 4; ++c) { const int n = 4 * n4 + c, kq = 16 * hh + 4 * i + kp;
                T[n * 32 + (kq ^ (((n >> 2) & 7) << 2))] = pk_fp8x4(r[i][0][c] * scale, r[i][1][c] * scale, r[i][2][c] * scale, r[i][3][c] * scale); }
    }
#pragma unroll
    for (int j = 0; j < 8; ++j) {
        const int row = 8 * j + (lane >> 3), chunk = lane & 7;
        const u32x4 v = *(const LAS u32x4*)(T + row * 32 + 4 * (chunk ^ ((row >> 2) & 7)));
        const int lc = n0 + row; int dr;
        if (MAP == 0) dr = row_off + lc;
        else if (MAP == 1) dr = row_off + (lc & ~63) + 8 * ((lc & 31) >> 2) + 4 * ((lc >> 5) & 1) + (lc & 3);
        else dr = (lc >> 7) * 256 + row_off + (lc & 127);
        *(u32x4*)(WT + (size_t)dr * K + k0 + 16 * chunk) = v;
    }
}

__device__ __forceinline__ void rms_row_to_bf16(const float* xrow, const float* w, bf16_t* orow, int lane) {
    const f32x4* xr = (const f32x4*)xrow + lane; const f32x4* wr_ = (const f32x4*)w + lane;
    f32x4 v[4]; float s = 0.f;
#pragma unroll
    for (int j = 0; j < 4; ++j) { v[j] = xr[64 * j]; s += (v[j].x * v[j].x + v[j].y * v[j].y) + (v[j].z * v[j].z + v[j].w * v[j].w); }
    const float rstd = 1.f / sqrtf(wave_sum(s) * (1.f / DM) + NORM_EPS);
    u32x2* o8 = (u32x2*)orow + lane;
#pragma unroll
    for (int j = 0; j < 4; ++j) { const f32x4 ww = wr_[64 * j]; u32x2 o; o.x = cvt_pk_bf16(v[j].x * rstd * ww.x, v[j].y * rstd * ww.y); o.y = cvt_pk_bf16(v[j].z * rstd * ww.z, v[j].w * rstd * ww.w); o8[64 * j] = o; }
}

__device__ __forceinline__ float log_sigmoid(float x) { return x >= 0.f ? -log1pf(expf(-x)) : x - log1pf(expf(x)); }


#define XB_TMO      128
#define XB_XCNT(j)  (256  + 64 * (j))
#define XB_XSUB(j)  (1280 + 64 * (j))
#define XB_XGEN(j)  (2304 + 64 * (j))
#define XB_TOP      3328
#define XB_TOPGEN   3392
#define XCD_BAR_WORDS 3456
#define XB_SPIN_CAP (1u << 18)
__device__ __forceinline__ unsigned xb_ld(unsigned* p)              { return __hip_atomic_load(p, __ATOMIC_RELAXED, __HIP_MEMORY_SCOPE_AGENT); }
__device__ __forceinline__ unsigned xb_add(unsigned* p, unsigned v) { return __hip_atomic_fetch_add(p, v, __ATOMIC_RELAXED, __HIP_MEMORY_SCOPE_AGENT); }
__device__ __forceinline__ unsigned xb_xcc_id() { return (unsigned)__builtin_amdgcn_s_getreg((3 << 11) | 20) & 0xFu; }
#define XB_SPIN(cond, bar) do { unsigned _sp = 0; while (cond) { __builtin_amdgcn_s_sleep(1); \
    if ((++_sp & 255u) == 0u) { if (xb_ld(&(bar)[XB_TMO])) break; if (_sp > XB_SPIN_CAP) { atomicAdd(&(bar)[XB_TMO], 1u); break; } } } } while (0)
struct XcdBarrier { unsigned* bar; unsigned x; volatile LAS unsigned* st; };
__device__ __forceinline__ XcdBarrier xcd_barrier_post(unsigned* bar, volatile LAS unsigned* st) {
    XcdBarrier b; b.bar = bar; b.x = xb_xcc_id(); b.st = st;
    if (threadIdx.x == 0) (void)xb_add(&bar[XB_XCNT(b.x)], 1u);
    return b;
}
__device__ __forceinline__ void xcd_barrier_complete(unsigned* bar, unsigned x, unsigned& nloc, unsigned& nx) {
    const unsigned G = gridDim.x * gridDim.y * gridDim.z;
    unsigned sum, cnt, mine, sp = 0u;
    for (;;) {
        sum = 0u; cnt = 0u; mine = 0u;
#pragma unroll
        for (unsigned j = 0; j < 16; ++j) { const unsigned c = xb_ld(&bar[XB_XCNT(j)]); sum += c; cnt += (c > 0u) ? 1u : 0u; mine = (j == x) ? c : mine; }
        if (sum == G) break;
        __builtin_amdgcn_s_sleep(1);
        if ((++sp & 255u) == 0u) { if (xb_ld(&bar[XB_TMO])) break; if (sp > XB_SPIN_CAP) { atomicAdd(&bar[XB_TMO], 1u); break; } }
    }
    nloc = mine > 0u ? mine : 1u; nx = cnt > 0u ? cnt : 1u;
}
__device__ __forceinline__ void xcd_barrier(const XcdBarrier& b) {
    asm volatile("s_waitcnt vmcnt(0)" ::: "memory");
    __syncthreads();
    if (threadIdx.x == 0) {
        unsigned* bar = b.bar;
        __builtin_amdgcn_s_waitcnt(0);
        unsigned nloc = b.st[0], nx = b.st[1]; const unsigned k = b.st[2];
        if (nloc == 0u) { xcd_barrier_complete(bar, b.x, nloc, nx); b.st[0] = nloc; b.st[1] = nx; }
        const unsigned old = xb_add(&bar[XB_XSUB(b.x)], 1u);
        if (old + 1u == (k + 1u) * nloc) {
            __builtin_amdgcn_fence(__ATOMIC_RELEASE, "agent");
            asm volatile("s_waitcnt vmcnt(0)" ::: "memory");
            (void)xb_add(&bar[XB_TOP], 1u);
        }
        const unsigned target = nx * (k + 1u);
        XB_SPIN(xb_ld(&bar[XB_TOP]) < target, bar);
        __builtin_amdgcn_fence(__ATOMIC_ACQUIRE, "agent");
        asm volatile("s_waitcnt vmcnt(0)" ::: "memory");
        b.st[2] = k + 1u;
    }
    __syncthreads();
}
#ifndef PROBE_A
#define PROBE_A -1
#endif
#ifndef PROBE_B
#define PROBE_B -1
#endif
#ifndef PROBE_A0
#define PROBE_A0 (PROBE_A - 1)
#endif
#ifndef PROBE_B0
#define PROBE_B0 (PROBE_B - 1)
#endif
#ifndef PROBE_SCALE
#define PROBE_SCALE 0.5e-6f
#endif
constexpr int CW_BAR = 4096, CW_TS = 8192;

typedef const __attribute__((address_space(4))) Args* KArgP;
__device__ __forceinline__ KArgP kargs() { KArgP p = (KArgP)__builtin_amdgcn_kernarg_segment_ptr(); asm volatile("" : "+s"(p)); return p; }
__global__ void __launch_bounds__(NTHREADS, 2) mega_fwd(Args A_) {
    extern __shared__ __attribute__((aligned(16))) unsigned char lds_raw[];
    LAS unsigned char* lds = (LAS unsigned char*)lds_raw;
    cg::grid_group grid = cg::this_grid();
    const int G = gridDim.x; const int bx = blockIdx.x;
    const int vcu = (G % 8 == 0) ? (bx % 8) * (G / 8) + bx / 8 : bx;
    const int NGW = G * NWAVES;
    unsigned char* ws = A_.ws;
    unsigned* ctl = (unsigned*)(ws + WS_CTL);
    LAS int* MISC = (LAS int*)(lds + MISC_OFF);
    LAS int* l_cnt = MISC; LAS int* l_tstart = MISC + 64; LAS int* l_sstart = MISC + 192;
    if (threadIdx.x < 3) MISC[300 + threadIdx.x] = 0;
    __syncthreads();
    (void)xcd_barrier_post(ctl + CW_BAR, (volatile LAS unsigned*)(MISC + 300));
#define STAMP(k) do { if ((PROBE_A >= 0 || PROBE_B >= 0) && blockIdx.x == 0 && threadIdx.x == 0) ((unsigned long long*)((unsigned*)(ws + WS_CTL) + CW_TS))[k] = __builtin_amdgcn_s_memrealtime(); } while (0)
#define GSYNC(k) do { XcdBarrier xb_; xb_.bar = (unsigned*)(ws + WS_CTL) + CW_BAR; xb_.x = xb_xcc_id(); xb_.st = (volatile LAS unsigned*)(lds + MISC_OFF) + 300; xcd_barrier(xb_); STAMP(k); } while (0)
    STAMP(0);

    {
        PHASE_IDS;
        KArgP K_ = kargs();
        const float* a_wg = K_->wg; const float* a_we = K_->we; const float* a_nmoe = K_->norm_moe_w; const float* a_win = K_->w_in; const float* a_wa = K_->w_a; const float* a_wb = K_->w_b; const float* a_wo = K_->w_o;
        const float* a_x = K_->x; const float* a_nmix = K_->norm_mix_w;
        for (int i = gw * 64 + lane; i < 80 * 1024; i += NGW * 64) {
            const int r = i >> 10, k = i & 1023; float v = 0.f;
            if (r < 8) v = a_wg[k * 8 + r]; else if (r >= 16) v = a_we[k * 64 + (r - 16)];
            v *= a_nmoe[k];
            const unsigned hi = cvt_pk_bf16(v, 0.f) & 0xffffu; const float lo = v - __uint_as_float(hi << 16);
            ((bf16_t*)(ws + WS_WR))[i] = (bf16_t)hi; ((bf16_t*)(ws + WS_WR))[80 * 1024 + i] = (bf16_t)(cvt_pk_bf16(lo, 0.f) & 0xffffu);
        }
        {
            LAS unsigned* T = (LAS unsigned*)(lds + wave * 8192);
            constexpr int I_IN8 = (DM / 128) * (4608 / 64), I_G8 = (DM / 128) * (2048 / 64), I_IN = (DM / 64) * ((7680 - 4608) / 64), I_A = (512 / 64) * (DM / 64), I_B = (DM / 64) * (DM / 64), I_O = I_B;
            for (int it = gw; it < I_IN8 + I_G8 + I_IN + I_A + I_B + I_O; it += NGW) {
                int r = it;
                if (r < I_IN8) {
                    const int n0 = (r / (DM / 128)) * 64;
                    if (n0 < 3072) transpose_tile_fp8<1, true>(a_win, DM, IN_W, (unsigned char*)(ws + WS_WIN8), 0, T, r, lane, W8_SCALE);
                    else transpose_tile_fp8<0, true>(a_win, DM, IN_W, (unsigned char*)(ws + WS_WIN8), 0, T, r, lane, W8_SCALE);
                    continue; } r -= I_IN8;
                if (r < I_G8) { transpose_tile_fp8<0, true>(a_win + 7680, DM, IN_W, (unsigned char*)(ws + WS_WIN8G), 0, T, r, lane, W8_SCALE); continue; } r -= I_G8;
                if (r < I_IN) {
                    const int r2 = r + (DM / 64) * (4608 / 64);
                    const int n0 = (r2 / (DM / 64)) * 64;
                    const bool rot = (n0 >= 4608 && n0 < 5632);
                    if (rot) transpose_tile64<1, true>(a_win, DM, IN_W, (bf16_t*)(ws + WS_WIN), 0, T, r2, lane, 0, 0, a_nmix);
                    else transpose_tile64<0, true>(a_win, DM, IN_W, (bf16_t*)(ws + WS_WIN), 0, T, r2, lane, 0, 0, a_nmix);
                    continue; } r -= I_IN;
                if (r < I_A) { transpose_tile64<0, true>(a_wa, 512, DM, (bf16_t*)(ws + WS_WA), 0, T, r, lane, 1536, 0); continue; } r -= I_A;
                if (r < I_B) { transpose_tile64<0, true>(a_wb, DM, DM, (bf16_t*)(ws + WS_WA), 0, T, r, lane, 1536, 512); continue; } r -= I_B;
                transpose_tile64<0, true>(a_wo, DM, DM, (bf16_t*)(ws + WS_WO), 0, T, r, lane);
            }
        }
        f32x4 wn[4];
#pragma unroll
        for (int j = 0; j < 4; ++j) wn[j] = ((const f32x4*)a_nmix + lane)[64 * j];
        for (int m = gw; m < NTOK; m += 2 * NGW) {
            const int m2 = (m + NGW < NTOK) ? m + NGW : m;
            const f32x4* xa = (const f32x4*)(a_x + (size_t)m * DM) + lane; const f32x4* xb = (const f32x4*)(a_x + (size_t)m2 * DM) + lane;
            f32x4 va[4], vb[4]; float sa = 0.f, sb = 0.f;
#pragma unroll
            for (int j = 0; j < 4; ++j) { va[j] = __builtin_nontemporal_load(xa + 64 * j); vb[j] = __builtin_nontemporal_load(xb + 64 * j); }
#pragma unroll
            for (int j = 0; j < 4; ++j) { sa += (va[j].x * va[j].x + va[j].y * va[j].y) + (va[j].z * va[j].z + va[j].w * va[j].w); sb += (vb[j].x * vb[j].x + vb[j].y * vb[j].y) + (vb[j].z * vb[j].z + vb[j].w * vb[j].w); }
#pragma unroll
            for (int o_ = 1; o_ < 64; o_ <<= 1) { sa += __shfl_xor(sa, o_); sb += __shfl_xor(sb, o_); }
            const float ra = 1.f / sqrtf(sa * (1.f / DM) + NORM_EPS), rb = 1.f / sqrtf(sb * (1.f / DM) + NORM_EPS);
            u32x2* oa = (u32x2*)((bf16_t*)(ws + WS_XN) + (size_t)m * DM) + lane; u32x2* ob = (u32x2*)((bf16_t*)(ws + WS_XN) + (size_t)m2 * DM) + lane;
            if (lane == 0) { ((float*)(ws + WS_RSTD0))[m] = ra; ((float*)(ws + WS_RSTD0))[m2] = rb; }
#pragma unroll
            for (int j = 0; j < 4; ++j) { const f32x4 ww = wn[j];
                const f32x4 na = va[j] * ra, nb = vb[j] * rb; const f32x4 ya = na * ww, yb = nb * ww;
                u32x2 o; o.x = cvt_pk_bf16(na.x, na.y); o.y = cvt_pk_bf16(na.z, na.w); oa[64 * j] = o;
                u32x2 p; p.x = cvt_pk_bf16(nb.x, nb.y); p.y = cvt_pk_bf16(nb.z, nb.w); ob[64 * j] = p;
                ((unsigned*)((unsigned char*)(ws + WS_XN8) + (size_t)m * DM))[lane + 64 * j] = pk_fp8x4(ya.x, ya.y, ya.z, ya.w);
                ((unsigned*)((unsigned char*)(ws + WS_XN8) + (size_t)m2 * DM))[lane + 64 * j] = pk_fp8x4(yb.x, yb.y, yb.z, yb.w); }
        }
    }
    if (G > (1 << 24)) grid.sync();
    GSYNC(1);

    {
        pg8::StaticOrder S; S.init(ws + WS_XN8, ws + WS_WIN8, NTOK, 4608, DM / 2, G, bx);
        EpiProjAtt E{ws, W8_DESCALE};
        pg8::gemm_phase<EpiProjAtt, pg8::StaticOrder, true, true, false, true>(lds, DM / 2, S, E);
    }
    GSYNC(2);

#if EN_ATT
    {
        PHASE_IDS;
        const bf16_t* QA = (const bf16_t*)(ws + WS_QA); const bf16_t* KA = (const bf16_t*)(ws + WS_KA); const bf16_t* VA = (const bf16_t*)(ws + WS_VA);
        float* LSE = (float*)(ws + WS_LSE); bf16_t* YCAT = (bf16_t*)kargs()->out;
        const unsigned lds_base = (unsigned)(size_t)lds;
        const int qi = lane & 15, g4 = lane >> 4;
        const int swk = ((qi >> 1) & 3) << 1;
        const int koff0 = qi * 128 + ((g4 ^ swk) << 4), koff1 = qi * 128 + (((4 + g4) ^ swk) << 4);
        const int vrow_l = 4 * g4 + (qi >> 2), swv = ((vrow_l >> 1) & 3) << 1;
        int voff[4];
#pragma unroll
        for (int dt = 0; dt < 4; ++dt) voff[dt] = vrow_l * 128 + (((2 * dt + ((qi & 3) >> 1)) ^ swv) << 4) + 8 * (qi & 1);
        const int drow = lane >> 3, dchp = lane & 7;
        for (int unit = vcu; unit < 256; unit += G) {
            const int b = unit >> 4, h = (unit >> 1) & 7, half = unit & 1;
            const size_t tokb = (size_t)b * SEQ;
#define ATT_GEOM(s_) const int grp = (s_) >> 3, jj = (s_) & 7; const int dil = (grp == 0) ? 1 : (grp == 1 ? 4 : 16), L = SEQ / dil; \
            const int rr = (grp == 0) ? 0 : (grp == 1 ? (jj >> 1) : 2 * jj); \
            const int bstart = (grp == 0) ? (1024 * half + 128 * jj) : (grp == 1 ? (256 * half + 128 * (jj & 1)) : 64 * half);
#define ATT_DMA(s_, sl_) do { ATT_GEOM(s_) \
            _Pragma("unroll") for (int it = 0; it < 8; ++it) { const int ii = wave + 8 * it, tens = ii >> 5, rg = ii & 31; const int row = 8 * rg + drow; \
                int idx, rsel; if (grp == 2) { idx = row & 127; rsel = rr + (row >> 7); } else { idx = bstart - 64 + row; idx = idx < 0 ? 0 : (idx > L - 1 ? L - 1 : idx); rsel = rr; } \
                const int ch = dchp ^ (((row >> 1) & 3) << 1); \
                const bf16_t* src = (tens ? VA : KA) + ((size_t)((b * 3 + grp) * 8 + h) * SEQ + (size_t)idx * dil + rsel) * 64 + ch * 8; \
                glds16(src, (unsigned)__builtin_amdgcn_readfirstlane((int)(lds_base + (sl_) * 65536 + tens * 32768 + rg * 1024))); } } while (0)
#define ATT_QGEOM(s_) ATT_GEOM(s_) const int sub = wave >> 2; \
            const int qidx0 = (grp == 2) ? (bstart + 16 * (wave & 3)) : (bstart + 16 * wave); const int rq = (grp == 2) ? rr + sub : rr; \
            const int rowbase = (grp == 2) ? (128 * sub + qidx0 - 64) : 16 * wave; \
            const int sq = (qidx0 + qi) * dil + rq; const size_t hmq = ((size_t)((b * 3 + grp) * 8 + h) * SEQ + sq) * 64;        \
            const size_t tokq = tokb + sq;
            bf16x8 qn0, qn1; u32x2 pn[4]; float ln = 0.f;
#pragma unroll
            for (int dt = 0; dt < 4; ++dt) pn[dt] = (u32x2){0u, 0u};
            { ATT_QGEOM(0) const bf16_t* qp = QA + hmq + 8 * g4; qn0 = *(const bf16x8*)qp; qn1 = *(const bf16x8*)(qp + 32); (void)tokq; }
            ATT_DMA(0, 0);
            for (int s = 0; s < 24; ++s) {
                asm volatile("s_waitcnt vmcnt(0)" ::: "memory"); __builtin_amdgcn_s_barrier(); asm volatile("" ::: "memory");
                bf16x8 qf0 = qn0, qf1 = qn1; asm volatile("" : "+v"(qf0), "+v"(qf1));
                u32x2 pc[4]; float lc = ln;
#pragma unroll
                for (int dt = 0; dt < 4; ++dt) pc[dt] = pn[dt];
                asm volatile("" : "+v"(pc[0]), "+v"(pc[1]), "+v"(pc[2]), "+v"(pc[3]), "+v"(lc));
                if (s + 1 < 24) { ATT_DMA(s + 1, (s + 1) & 1); { ATT_QGEOM(s + 1) const bf16_t* qp = QA + hmq + 8 * g4; qn0 = *(const bf16x8*)qp; qn1 = *(const bf16x8*)(qp + 32);
                    if (s + 1 >= 8) { const bf16_t* yp = YCAT + tokq * 1536 + h * 64 + 4 * g4;
#pragma unroll
                        for (int dt = 0; dt < 4; ++dt) pn[dt] = *(const u32x2*)(yp + 16 * dt);
                        ln = LSE[tokq * 8 + h]; } } }
                {
                    ATT_QGEOM(s)
                    const LAS unsigned char* Kt = lds + (s & 1) * 65536; const LAS unsigned char* Vt = Kt + 32768;
                    f32x4 sc[9]; float mx = -INFINITY; int trow[9];
#pragma unroll
                    for (int kt = 0; kt < 9; ++kt) {
                        const int kidx0 = qidx0 - 64 + 16 * kt; const bool inr = (kidx0 >= 0) && (kidx0 < L);
                        const int tr_ = inr ? rowbase + 16 * kt : rowbase + 64; trow[kt] = tr_;
                        const LAS unsigned char* kp = Kt + tr_ * 128;
                        const bf16x8 k0 = *(const LAS bf16x8*)(kp + koff0), k1 = *(const LAS bf16x8*)(kp + koff1);
                        f32x4 sv = (f32x4){0.f, 0.f, 0.f, 0.f};
                        sv = __builtin_amdgcn_mfma_f32_16x16x32_bf16(k0, qf0, sv, 0, 0, 0);
                        sv = __builtin_amdgcn_mfma_f32_16x16x32_bf16(k1, qf1, sv, 0, 0, 0);
#pragma unroll
                        for (int i = 0; i < 4; ++i) { const int kr = 4 * g4 + i; bool ok = inr; if (kt == 0) ok = ok && (kr >= qi); if (kt == 8) ok = ok && (kr <= qi);
                            sv[i] = ok ? sv[i] : -INFINITY; mx = fmaxf(mx, sv[i]); }
                        sc[kt] = sv;
                    }
                    mx = fmaxf(mx, __shfl_xor(mx, 16)); mx = fmaxf(mx, __shfl_xor(mx, 32));
                    float lsum = 0.f;
#pragma unroll
                    for (int kt = 0; kt < 9; ++kt)
#pragma unroll
                        for (int i = 0; i < 4; ++i) { const float p = fast_exp2(sc[kt][i] - mx); sc[kt][i] = p; lsum += p; }
                    lsum += __shfl_xor(lsum, 16); lsum += __shfl_xor(lsum, 32);
                    f32x4 o[4];
#pragma unroll
                    for (int dt = 0; dt < 4; ++dt) o[dt] = (f32x4){0.f, 0.f, 0.f, 0.f};
#pragma unroll
                    for (int kk = 0; kk < 5; ++kk) {
                        const int t0 = 2 * kk, t1 = (kk == 4) ? 8 : 2 * kk + 1;
                        u32x4 pw; pw.x = cvt_pk_bf16(sc[t0][0], sc[t0][1]); pw.y = cvt_pk_bf16(sc[t0][2], sc[t0][3]);
                        if (kk == 4) { pw.z = 0u; pw.w = 0u; } else { pw.z = cvt_pk_bf16(sc[t1][0], sc[t1][1]); pw.w = cvt_pk_bf16(sc[t1][2], sc[t1][3]); }
                        const bf16x8 pf = __builtin_bit_cast(bf16x8, pw);
                        const LAS unsigned char* v0p = Vt + trow[t0] * 128; const LAS unsigned char* v1p = Vt + trow[t1] * 128;
#pragma unroll
                        for (int dt = 0; dt < 4; ++dt) {
                            const bf16x8 vf = cat4(tr_read((const LAS char*)(v0p + voff[dt])), tr_read((const LAS char*)(v1p + voff[dt])));
                            o[dt] = __builtin_amdgcn_mfma_f32_16x16x32_bf16(vf, pf, o[dt], 0, 0, 0);
                        }
                    }
                    const float rl = 1.f / lsum, lse2 = mx + log2f(lsum);
                    float fa = 0.f, fb = rl, lnew = lse2;
                    if (grp > 0) { const float m = fmaxf(lc, lse2), wa = fast_exp2(lc - m), wb = fast_exp2(lse2 - m), inv = 1.f / (wa + wb); fa = wa * inv; fb = wb * inv * rl; lnew = m + log2f(wa + wb); }
                    bf16_t* op = YCAT + tokq * 1536 + h * 64 + 4 * g4;
#pragma unroll
                    for (int dt = 0; dt < 4; ++dt) { u32x2 w;
                        w.x = cvt_pk_bf16(fa * bf_lo(pc[dt].x) + fb * o[dt][0], fa * bf_hi(pc[dt].x) + fb * o[dt][1]); w.y = cvt_pk_bf16(fa * bf_lo(pc[dt].y) + fb * o[dt][2], fa * bf_hi(pc[dt].y) + fb * o[dt][3]);
                        *(u32x2*)(op + 16 * dt) = w; }
                    if (g4 == 0 && grp < 2) LSE[tokq * 8 + h] = lnew;
                }
            }
#undef ATT_GEOM
#undef ATT_DMA
#undef ATT_QGEOM
            VM_WAIT();
            __syncthreads();
        }
    }
#else
    { PHASE_IDS; bf16_t* yc = (bf16_t*)kargs()->out; for (size_t i = (size_t)bx * NTHREADS + tid; i < (size_t)NTOK * 64; i += (size_t)G * NTHREADS) *(u32x4*)(yc + (i >> 6) * 1536 + (i & 63) * 8) = (u32x4){0u, 0u, 0u, 0u}; }
#endif
    GSYNC(3);

    {
        KArgP K_ = kargs();
        {
            pg8::StaticOrder S; S.init(ws + WS_XN, ws + WS_WIN + (size_t)4608 * DM * 2, NTOK, 3072, DM, G, bx);
            EpiProj E{ws, (bf16_t*)K_->out, K_->b_gate, 18, 1.f};
            pg8::gemm_phase<EpiProj, pg8::StaticOrder, true, true>(lds, DM, S, E);
        }
        {
            pg8::StaticOrder S; S.init(ws + WS_XN8, ws + WS_WIN8G, NTOK, 2048, DM / 2, G, bx);
            EpiProj E{ws, (bf16_t*)K_->out, K_->b_gate, 30, W8_DESCALE};
            pg8::gemm_phase<EpiProj, pg8::StaticOrder, true, true, false, true>(lds, DM / 2, S, E);
        }
    }
    GSYNC(4);

#if EN_RET
    {
        PHASE_IDS;
        const bf16_t* KR = (const bf16_t*)(ws + WS_KR); const bf16_t* VR = (const bf16_t*)(ws + WS_VR); bf16_t* SST = (bf16_t*)(ws + WS_SST);
        constexpr int RSK = 160, RSV = 288; constexpr int KT_OFF = 0, VT_OFF = 128 * RSK;
        const int dcol = lane & 15, g4 = lane >> 4;
        for (int unit = vcu; unit < 256; unit += G) {
            const int b = unit >> 4, h = (unit >> 1) & 7, dir = unit & 1;
            KArgP K_ = kargs(); const float lg = log_sigmoid(dir ? K_->dec_b[h] : K_->dec_f[h]); const float lg2 = lg * LOG2E; const float cd = exp2f(128.f * lg2);
            f32x4 st[4];
#pragma unroll
            for (int dt = 0; dt < 4; ++dt) st[dt] = (f32x4){0.f, 0.f, 0.f, 0.f};
            constexpr int BUFB = 128 * RSK + 128 * RSV;
            u32x4 kA[2], vA[4], kB[2], vB[4];
            float zk[2];
#pragma unroll
            for (int it = 0; it < 2; ++it) { const int row = (tid + NTHREADS * it) >> 3; zk[it] = exp2f(lg2 * (float)(dir ? row : 127 - row)); }
#define P3A_LOAD(kr_, vr_, s_) do { const size_t tk_ = (size_t)b * SEQ + (dir ? 15 - (s_) : (s_)) * 128; \
                _Pragma("unroll") for (int it = 0; it < 2; ++it) { const int p = tid + NTHREADS * it, row = p >> 3, ch = p & 7; kr_[it] = *(const u32x4*)(KR + (tk_ + row) * 512 + h * 64 + ch * 8); } \
                _Pragma("unroll") for (int it = 0; it < 4; ++it) { const int p = tid + NTHREADS * it, row = p >> 4, ch = p & 15; vr_[it] = *(const u32x4*)(VR + (tk_ + row) * 1024 + h * 128 + ch * 8); } } while (0)
#define P3A_STAGE(kr_, vr_, buf_) do { \
                _Pragma("unroll") for (int it = 0; it < 2; ++it) { const int p = tid + NTHREADS * it, row = p >> 3, ch = p & 7; const u32x4 v = kr_[it]; const float z = zk[it]; \
                    u32x4 o; o.x = cvt_pk_bf16(bf_lo(v.x) * z, bf_hi(v.x) * z); o.y = cvt_pk_bf16(bf_lo(v.y) * z, bf_hi(v.y) * z); o.z = cvt_pk_bf16(bf_lo(v.z) * z, bf_hi(v.z) * z); o.w = cvt_pk_bf16(bf_lo(v.w) * z, bf_hi(v.w) * z); \
                    *(LAS u32x4*)(lds + (buf_) * BUFB + KT_OFF + row * RSK + ch * 16) = o; } \
                _Pragma("unroll") for (int it = 0; it < 4; ++it) { const int p = tid + NTHREADS * it, row = p >> 4, ch = p & 15; *(LAS u32x4*)(lds + (buf_) * BUFB + VT_OFF + row * RSV + ch * 16) = vr_[it]; } } while (0)
#define P3A_STEP(s_, kr_, vr_) do { const int n = dir ? 15 - (s_) : (s_); const int buf = (s_) & 1; \
                bf16_t* sp = SST + ((size_t)((b * 8 + h) * 2 + dir) * 16 + n) * 8192;        \
                _Pragma("unroll") for (int dt = 0; dt < 4; ++dt) { u32x2 w; w.x = cvt_pk_bf16(st[dt][0], st[dt][1]); w.y = cvt_pk_bf16(st[dt][2], st[dt][3]); *(u32x2*)(sp + (16 * dt + dcol) * 128 + 16 * wave + 4 * g4) = w; } \
                if ((s_) + 1 < 16) { P3A_STAGE(kr_, vr_, buf ^ 1); if ((s_) + 3 < 16) P3A_LOAD(kr_, vr_, (s_) + 3); } \
                _Pragma("unroll") for (int dt = 0; dt < 4; ++dt) st[dt] = st[dt] * cd; \
                _Pragma("unroll") for (int kk = 0; kk < 4; ++kk) { \
                    const int r0 = 32 * kk + 4 * g4 + (dcol >> 2), r1 = r0 + 16; \
                    const LAS unsigned char* vb = lds + buf * BUFB + VT_OFF + (16 * wave + 4 * (dcol & 3)) * 2; \
                    const bf16x8 af = cat4(tr_read((const LAS char*)(vb + r0 * RSV)), tr_read((const LAS char*)(vb + r1 * RSV))); \
                    _Pragma("unroll") for (int dt = 0; dt < 4; ++dt) { \
                        const LAS unsigned char* kb = lds + buf * BUFB + KT_OFF + (16 * dt + 4 * (dcol & 3)) * 2; \
                        const bf16x8 bfr = cat4(tr_read((const LAS char*)(kb + r0 * RSK)), tr_read((const LAS char*)(kb + r1 * RSK))); \
                        st[dt] = __builtin_amdgcn_mfma_f32_16x16x32_bf16(af, bfr, st[dt], 0, 0, 0); } } \
                __syncthreads(); } while (0)
            P3A_LOAD(kA, vA, 0); P3A_LOAD(kB, vB, 1);
            P3A_STAGE(kA, vA, 0); P3A_LOAD(kA, vA, 2);
            __syncthreads();
#pragma unroll 1
            for (int step = 0; step < 16; step += 2) {
                P3A_STEP(step, kB, vB);
                P3A_STEP(step + 1, kA, vA);
            }
#undef P3A_LOAD
#undef P3A_STAGE
#undef P3A_STEP
        }
    }
    GSYNC(5);
    {
        PHASE_IDS;
        const bf16_t* QR = (const bf16_t*)(ws + WS_QR); const bf16_t* KR = (const bf16_t*)(ws + WS_KR); const bf16_t* VR = (const bf16_t*)(ws + WS_VR);
        const bf16_t* GR = (const bf16_t*)(ws + WS_GR); const bf16_t* SST = (const bf16_t*)(ws + WS_SST); bf16_t* YCAT = (bf16_t*)kargs()->out;
        constexpr int RSK = 160, RSV = 288; constexpr int QT = 0, KT = 20480, VT = 40960, SF = 77824, SB = 96256, GNW = 114688, GT = 118784;
        const int qi = lane & 15, g4 = lane >> 4;
        { const float* a_gnw0 = kargs()->gn_w; ((LAS float*)(lds + GNW))[tid] = a_gnw0[tid]; ((LAS float*)(lds + GNW))[tid + 512] = a_gnw0[tid + 512]; }
        u32x4 pre[12];
#define P3B_LOAD(unit_) do { const int bh_ = (unit_) >> 4, n_ = (unit_) & 15, b_ = bh_ >> 3, h_ = bh_ & 7; const size_t tk_ = (size_t)b_ * SEQ + n_ * 128; \
            _Pragma("unroll") for (int it = 0; it < 2; ++it) { const int p = tid + NTHREADS * it, row = p >> 3, ch = p & 7; \
                pre[it] = __builtin_nontemporal_load((const u32x4*)(QR + (tk_ + row) * 512 + h_ * 64 + ch * 8)); pre[2 + it] = __builtin_nontemporal_load((const u32x4*)(KR + (tk_ + row) * 512 + h_ * 64 + ch * 8)); } \
            _Pragma("unroll") for (int it = 0; it < 4; ++it) { const int p = tid + NTHREADS * it, row = p >> 4, ch = p & 15; pre[4 + it] = __builtin_nontemporal_load((const u32x4*)(VR + (tk_ + row) * 1024 + h_ * 128 + ch * 8)); } \
            _Pragma("unroll") for (int it = 0; it < 2; ++it) { const int p = tid + NTHREADS * it, row = p >> 4, ch = p & 15; \
                pre[8 + it] = __builtin_nontemporal_load((const u32x4*)(SST + ((size_t)(bh_ * 2 + 0) * 16 + n_) * 8192 + row * 128 + ch * 8)); pre[10 + it] = __builtin_nontemporal_load((const u32x4*)(SST + ((size_t)(bh_ * 2 + 1) * 16 + n_) * 8192 + row * 128 + ch * 8)); } } while (0)
        if (vcu < 2048) P3B_LOAD(vcu);
        constexpr int DW = ROFF_OFF + 20480;
        int h_cur = -1; float lgf2 = 0.f, lgb2 = 0.f, xif = 0.f, xib = 0.f;
        for (int unit = vcu; unit < 2048; unit += G) {
            const int bh = unit >> 4, n = unit & 15, b = bh >> 3, h = bh & 7;
            if (h != h_cur) {
                h_cur = h;
                KArgP K_ = kargs(); lgf2 = log_sigmoid(K_->dec_f[h]) * LOG2E; lgb2 = log_sigmoid(K_->dec_b[h]) * LOG2E;
                const int qa_ = 16 * wave + qi;
                xif = fast_exp2(lgf2 * (float)(qa_ + 1)); xib = fast_exp2(lgb2 * (float)(128 - qa_));
                if (tid < 255) { const int dl = 127 - tid; ((LAS float*)(lds + DW))[tid] = dl > 0 ? fast_exp2(lgf2 * (float)dl) : (dl < 0 ? fast_exp2(lgb2 * (float)(-dl)) : 2.f); }
            }
            const size_t tok0 = (size_t)b * SEQ + n * 128;
#pragma unroll
            for (int it = 0; it < 2; ++it) { const int p = tid + NTHREADS * it, row = p >> 3, ch = p & 7;
                *(LAS u32x4*)(lds + QT + row * RSK + ch * 16) = pre[it]; *(LAS u32x4*)(lds + KT + row * RSK + ch * 16) = pre[2 + it]; }
#pragma unroll
            for (int it = 0; it < 4; ++it) { const int p = tid + NTHREADS * it, row = p >> 4, ch = p & 15; *(LAS u32x4*)(lds + VT + row * RSV + ch * 16) = pre[4 + it]; }
#pragma unroll
            for (int it = 0; it < 2; ++it) { const int p = tid + NTHREADS * it, row = p >> 4, ch = p & 15;
                *(LAS u32x4*)(lds + SF + row * RSV + ch * 16) = pre[8 + it]; *(LAS u32x4*)(lds + SB + row * RSV + ch * 16) = pre[10 + it]; }
            __syncthreads();
            {
                const unsigned gdst = (unsigned)(size_t)lds + (unsigned)(wave < 3 ? GT + wave * 4096 : ROFF_OFF + (wave - 3) * 4096);
#pragma unroll
                for (int j = 0; j < 4; ++j) { const int row = 4 * j + (lane >> 4), c = (lane & 15) ^ row;
                    glds16(GR + (tok0 + 16 * wave + row) * 1024 + h * 128 + c * 8, (unsigned)__builtin_amdgcn_readfirstlane((int)(gdst + j * 1024))); }
            }
            if (unit + G < 2048) P3B_LOAD(unit + G);
            {
                const int qa = 16 * wave + qi;
                const LAS unsigned char* qrow = lds + QT + qa * RSK;
                const bf16x8 qf0 = *(const LAS bf16x8*)(qrow + g4 * 16), qf1 = *(const LAS bf16x8*)(qrow + 64 + g4 * 16);
                bf16x8 pf[4];
#pragma unroll
                for (int kk = 0; kk < 4; ++kk) {
                    u32x4 pw;
#pragma unroll
                    for (int tt = 0; tt < 2; ++tt) {
                        const int kt = 2 * kk + tt;
                        const LAS unsigned char* kp = lds + KT + (16 * kt + qi) * RSK + g4 * 16;
                        const bf16x8 k0 = *(const LAS bf16x8*)kp, k1 = *(const LAS bf16x8*)(kp + 64);
                        f32x4 s = (f32x4){0.f, 0.f, 0.f, 0.f};
                        s = __builtin_amdgcn_mfma_f32_16x16x32_bf16(k0, qf0, s, 0, 0, 0);
                        s = __builtin_amdgcn_mfma_f32_16x16x32_bf16(k1, qf1, s, 0, 0, 0);
#pragma unroll
                        for (int i = 0; i < 4; ++i) s[i] *= ((const LAS float*)(lds + DW))[127 - qa + 16 * kt + 4 * g4 + i];
                        if (tt == 0) { pw.x = cvt_pk_bf16(s[0], s[1]); pw.y = cvt_pk_bf16(s[2], s[3]); } else { pw.z = cvt_pk_bf16(s[0], s[1]); pw.w = cvt_pk_bf16(s[2], s[3]); }
                    }
                    pf[kk] = __builtin_bit_cast(bf16x8, pw);
                }
                bf16x8 qxf[2], qxb[2];
#pragma unroll
                for (int kk = 0; kk < 2; ++kk) {
                    const u32x2 a = *(const LAS u32x2*)(qrow + (32 * kk + 4 * g4) * 2), c = *(const LAS u32x2*)(qrow + (32 * kk + 16 + 4 * g4) * 2);
                    u32x4 f, bq;
                    f.x = cvt_pk_bf16(bf_lo(a.x) * xif, bf_hi(a.x) * xif); f.y = cvt_pk_bf16(bf_lo(a.y) * xif, bf_hi(a.y) * xif); f.z = cvt_pk_bf16(bf_lo(c.x) * xif, bf_hi(c.x) * xif); f.w = cvt_pk_bf16(bf_lo(c.y) * xif, bf_hi(c.y) * xif);
                    bq.x = cvt_pk_bf16(bf_lo(a.x) * xib, bf_hi(a.x) * xib); bq.y = cvt_pk_bf16(bf_lo(a.y) * xib, bf_hi(a.y) * xib); bq.z = cvt_pk_bf16(bf_lo(c.x) * xib, bf_hi(c.x) * xib); bq.w = cvt_pk_bf16(bf_lo(c.y) * xib, bf_hi(c.y) * xib);
                    qxf[kk] = __builtin_bit_cast(bf16x8, f); qxb[kk] = __builtin_bit_cast(bf16x8, bq);
                }
                f32x4 o[8];
                const int trow = 4 * g4 + (qi >> 2), tcol = (qi & 3) * 8;
#pragma unroll
                for (int vt = 0; vt < 8; ++vt) {
                    f32x4 acc = (f32x4){0.f, 0.f, 0.f, 0.f};
#pragma unroll
                    for (int kk = 0; kk < 4; ++kk) {
                        const LAS unsigned char* vb = lds + VT + (32 * kk + trow) * RSV + vt * 32 + tcol;
                        const bf16x8 af = cat4(tr_read((const LAS char*)vb), tr_read((const LAS char*)(vb + 16 * RSV)));
                        acc = __builtin_amdgcn_mfma_f32_16x16x32_bf16(af, pf[kk], acc, 0, 0, 0);
                    }
#pragma unroll
                    for (int kk = 0; kk < 2; ++kk) {
                        const LAS unsigned char* sfp = lds + SF + (32 * kk + trow) * RSV + vt * 32 + tcol;
                        const bf16x8 af = cat4(tr_read((const LAS char*)sfp), tr_read((const LAS char*)(sfp + 16 * RSV)));
                        acc = __builtin_amdgcn_mfma_f32_16x16x32_bf16(af, qxf[kk], acc, 0, 0, 0);
                        const LAS unsigned char* sbp = lds + SB + (32 * kk + trow) * RSV + vt * 32 + tcol;
                        const bf16x8 ab = cat4(tr_read((const LAS char*)sbp), tr_read((const LAS char*)(sbp + 16 * RSV)));
                        acc = __builtin_amdgcn_mfma_f32_16x16x32_bf16(ab, qxb[kk], acc, 0, 0, 0);
                    }
                    o[vt] = acc;
                }
                float s = 0.f;
#pragma unroll
                for (int vt = 0; vt < 8; ++vt) s += (o[vt][0] + o[vt][1]) + (o[vt][2] + o[vt][3]);
                s += __shfl_xor(s, 16); s += __shfl_xor(s, 32);
                const float mu = s * (1.f / 128.f); float q2 = 0.f;
#pragma unroll
                for (int vt = 0; vt < 8; ++vt) { const f32x4 d = o[vt] - mu; q2 += (d[0] * d[0] + d[1] * d[1]) + (d[2] * d[2] + d[3] * d[3]); }
                q2 += __shfl_xor(q2, 16); q2 += __shfl_xor(q2, 32);
                const float rstd = 1.f / sqrtf(q2 * (1.f / 128.f) + NORM_EPS);
                const size_t tok = tok0 + qa;
                asm volatile("s_waitcnt vmcnt(0)" ::: "memory");
#pragma unroll
                for (int vt = 0; vt < 8; ++vt) {
                    const int col = h * 128 + 16 * vt + 4 * g4;
                    const f32x4 gw4 = *(const LAS f32x4*)(lds + GNW + col * 4); const u32x2 sg = *(const LAS u32x2*)(lds + (wave < 3 ? GT + wave * 4096 : ROFF_OFF + (wave - 3) * 4096) + qi * 256 + (((2 * vt + (g4 >> 1)) ^ qi) << 4) + 8 * (g4 & 1));
                    const f32x4 d = (o[vt] - mu) * rstd;
                    u32x2 w; w.x = cvt_pk_bf16(d[0] * gw4[0] * bf_lo(sg.x), d[1] * gw4[1] * bf_hi(sg.x)); w.y = cvt_pk_bf16(d[2] * gw4[2] * bf_lo(sg.y), d[3] * gw4[3] * bf_hi(sg.y));
                    *(u32x2*)(YCAT + tok * 1536 + 512 + col) = w;
                }
            }
            __syncthreads();
        }
    }
#else
    { PHASE_IDS; bf16_t* yc = (bf16_t*)kargs()->out; for (size_t i = (size_t)bx * NTHREADS + tid; i < (size_t)NTOK * 128; i += (size_t)G * NTHREADS) *(u32x4*)(yc + (i >> 7) * 1536 + 512 + (i & 127) * 8) = (u32x4){0u, 0u, 0u, 0u}; }
#endif
    GSYNC(6);

    {
        pg8::StaticOrder S; S.init(kargs()->out, ws + WS_WA, NTOK, DM, 1536, G, bx);
        EpiMerge E{(bf16_t*)(ws + WS_MERGED), (const bf16_t*)(ws + WS_GATE)};
        pg8::gemm_phase<EpiMerge, pg8::StaticOrder, true, true>(lds, 1536, S, E);
    }
    GSYNC(7);

    {
        pg8::StaticOrder S; S.init(ws + WS_MERGED, ws + WS_WO, NTOK, DM, DM, G, bx);
        EpiPlain E{(bf16_t*)(ws + WS_MIX)};
        pg8::gemm_phase<EpiPlain, pg8::StaticOrder, true, true>(lds, DM, S, E);
    }
    GSYNC(8);

#if EN_MOE
#ifndef NO_P6
    {
        PHASE_IDS;
        const bf16_t* MIX = (const bf16_t*)(ws + WS_MIX); const bf16_t* WRh = (const bf16_t*)(ws + WS_WR); unsigned char* HN = (unsigned char*)(ws + WS_HN);
        unsigned* ASG = (unsigned*)(ws + WS_ASG); float* RSTD = (float*)(ws + WS_RSTD);
        LAS float* NM = (LAS float*)(lds + 98304);
        { KArgP K0 = kargs(); const float* a_nmoe = K0->norm_moe_w; NM[tid] = a_nmoe[tid]; NM[tid + 512] = a_nmoe[tid + 512]; }
        if (tid < 2) MISC[310 + tid] = 0;
        if (tid < 64) MISC[320 + tid] = 0;
        __syncthreads();
        const int ntc = (NTOK / 16 - vcu * NWAVES + NGW - 1) / NGW * NWAVES;
        for (;;) {
            int kind = -1, widx = 0;
            if (lane == 0) {
                if (wave < 4) { widx = __hip_atomic_fetch_add(&MISC[311], 1, __ATOMIC_RELAXED, __HIP_MEMORY_SCOPE_WORKGROUP); if (widx < ntc / 2) kind = 0;
                    else { widx = __hip_atomic_fetch_add(&MISC[310], 1, __ATOMIC_RELAXED, __HIP_MEMORY_SCOPE_WORKGROUP); if (vcu + G * widx < NEXP * 192) kind = 1; } }
                else { widx = __hip_atomic_fetch_add(&MISC[310], 1, __ATOMIC_RELAXED, __HIP_MEMORY_SCOPE_WORKGROUP); if (vcu + G * widx < NEXP * 192) kind = 1;
                    else { widx = __hip_atomic_fetch_add(&MISC[311], 1, __ATOMIC_RELAXED, __HIP_MEMORY_SCOPE_WORKGROUP); if (widx < ntc / 2) kind = 0; } }
            }
            kind = __builtin_amdgcn_readfirstlane(kind); widx = __builtin_amdgcn_readfirstlane(widx);
            if (kind < 0) break;
            if (kind == 0) {
                KArgP K_ = kargs(); const float* a_bg = K_->bg; const float* a_be = K_->be;
                LAS float* LG = (LAS float*)(lds + wave * 8192);
                int lane_r = lane; asm volatile("" : "+v"(lane_r));
                const int tk = lane_r & 15, g4 = lane_r >> 4;
                const int tile = vcu * NWAVES + ((2 * widx) & 7) + ((2 * widx) >> 3) * NGW;
                const int t0 = tile * 16;
                f32x4 acc[2][5];
#pragma unroll
                for (int q = 0; q < 2; ++q)
#pragma unroll
                    for (int nt = 0; nt < 5; ++nt) acc[q][nt] = (f32x4){0.f, 0.f, 0.f, 0.f};
                float ss[2] = {0.f, 0.f};
                const bf16_t* hp = (const bf16_t*)(ws + WS_XN) + (size_t)(t0 + tk) * DM + 8 * g4; const bf16_t* mp = MIX + (size_t)(t0 + tk) * DM + 8 * g4;
                float ixr[2];
#pragma unroll
                for (int q = 0; q < 2; ++q) ixr[q] = 1.f / ((const float*)(ws + WS_RSTD0))[t0 + 16 * q + tk];
                unsigned char* hnp = HN + (size_t)(t0 + tk) * DM + 8 * g4;
                const bf16_t* whp = WRh + (size_t)tk * DM + 8 * g4;
                u32x4 hA[2], hB[2], hC[2]; bf16x8 wA[5], wB[5], wC[5]; u32x4 mA[2], mB[2], mC[2];
#define RT_LOAD(hS, wS, mS, ks_) do { _Pragma("unroll") for (int q = 0; q < 2; ++q) { hS[q] = *(const u32x4*)(hp + (size_t)q * 16 * DM + 32 * (ks_)); mS[q] = *(const u32x4*)(mp + (size_t)q * 16 * DM + 32 * (ks_)); } \
                    _Pragma("unroll") for (int nt = 0; nt < 5; ++nt) wS[nt] = *(const bf16x8*)(whp + (size_t)nt * 16 * DM + 32 * (ks_)); } while (0)
#define RT_COMP(hS, wS, mS, ks_) do { const f32x4 n0 = *(const LAS f32x4*)(NM + 32 * (ks_) + 8 * g4), n1 = *(const LAS f32x4*)(NM + 32 * (ks_) + 8 * g4 + 4); \
                    _Pragma("unroll") for (int q = 0; q < 2; ++q) { const u32x4 hq = hS[q], mq = mS[q]; \
                    const f32x4 x0 = (f32x4){bf_lo(hq.x), bf_hi(hq.x), bf_lo(hq.y), bf_hi(hq.y)} * ixr[q] + (f32x4){bf_lo(mq.x), bf_hi(mq.x), bf_lo(mq.y), bf_hi(mq.y)}, x1 = (f32x4){bf_lo(hq.z), bf_hi(hq.z), bf_lo(hq.w), bf_hi(hq.w)} * ixr[q] + (f32x4){bf_lo(mq.z), bf_hi(mq.z), bf_lo(mq.w), bf_hi(mq.w)}; \
                    ss[q] += (x0[0] * x0[0] + x0[1] * x0[1]) + (x0[2] * x0[2] + x0[3] * x0[3]) + (x1[0] * x1[0] + x1[1] * x1[1]) + (x1[2] * x1[2] + x1[3] * x1[3]); \
                    u32x2 hw; hw.x = pk_fp8x4(x0[0] * n0[0], x0[1] * n0[1], x0[2] * n0[2], x0[3] * n0[3]); hw.y = pk_fp8x4(x1[0] * n1[0], x1[1] * n1[1], x1[2] * n1[2], x1[3] * n1[3]); \
                    *(u32x2*)(hnp + (size_t)q * 16 * DM + 32 * (ks_)) = hw; \
                    u32x4 hi; hi.x = cvt_pk_bf16(x0[0], x0[1]); hi.y = cvt_pk_bf16(x0[2], x0[3]); hi.z = cvt_pk_bf16(x1[0], x1[1]); hi.w = cvt_pk_bf16(x1[2], x1[3]); \
                    u32x4 lo; lo.x = cvt_pk_bf16(x0[0] - bf_lo(hi.x), x0[1] - bf_hi(hi.x)); lo.y = cvt_pk_bf16(x0[2] - bf_lo(hi.y), x0[3] - bf_hi(hi.y)); \
                    lo.z = cvt_pk_bf16(x1[0] - bf_lo(hi.z), x1[1] - bf_hi(hi.z)); lo.w = cvt_pk_bf16(x1[2] - bf_lo(hi.w), x1[3] - bf_hi(hi.w)); \
                    const bf16x8 bh = __builtin_bit_cast(bf16x8, hi), bl = __builtin_bit_cast(bf16x8, lo); \
                    _Pragma("unroll") for (int nt = 0; nt < 5; ++nt) { acc[q][nt] = __builtin_amdgcn_mfma_f32_16x16x32_bf16(wS[nt], bh, acc[q][nt], 0, 0, 0); acc[q][nt] = __builtin_amdgcn_mfma_f32_16x16x32_bf16(wS[nt], bl, acc[q][nt], 0, 0, 0); } } } while (0)
                RT_LOAD(hA, wA, mA, 0); RT_LOAD(hB, wB, mB, 1);
#pragma unroll 1
                for (int ks = 0; ks < 30; ks += 3) {
                    RT_LOAD(hC, wC, mC, ks + 2); RT_COMP(hA, wA, mA, ks);
                    RT_LOAD(hA, wA, mA, ks + 3); RT_COMP(hB, wB, mB, ks + 1);
                    RT_LOAD(hB, wB, mB, ks + 4); RT_COMP(hC, wC, mC, ks + 2);
                }
                RT_COMP(hA, wA, mA, 30); RT_COMP(hB, wB, mB, 31);
#undef RT_LOAD
#undef RT_COMP
#pragma unroll
                for (int q = 0; q < 2; ++q) {
                    float ssq = ss[q]; ssq += __shfl_xor(ssq, 16); ssq += __shfl_xor(ssq, 32);
                    const float rstd = 1.f / sqrtf(ssq * (1.f / DM) + NORM_EPS);
#pragma unroll
                    for (int nt = 0; nt < 5; ++nt)
#pragma unroll
                        for (int i = 0; i < 4; ++i) LG[tk * 81 + 16 * nt + 4 * g4 + i] = acc[q][nt][i];
                    LDS_WAIT(); asm volatile("" ::: "memory");
                    int lane_t = lane; asm volatile("" : "+v"(lane_t));
                    if (lane_t < 16) {
                        const int lane = lane_t; const int tq = t0 + 16 * q + lane;
                        const LAS float* lr = LG + lane * 81;
                        float gl[8]; float gmax = -INFINITY; int gi = 0;
#pragma unroll
                        for (int j = 0; j < 8; ++j) { gl[j] = lr[j] * rstd + a_bg[j]; if (gl[j] > gmax) { gmax = gl[j]; gi = j; } }
                        float gs = 0.f;
#pragma unroll
                        for (int j = 0; j < 8; ++j) gs += expf(gl[j] - gmax);
                        const float g_w = 1.f / gs;
                        float l1 = -INFINITY, l2 = -INFINITY; int i1 = 0, i2 = 0;
#pragma unroll
                        for (int j = 0; j < 8; ++j) { const float v = lr[16 + 8 * gi + j] * rstd + a_be[8 * gi + j];
                            if (v > l1) { l2 = l1; i2 = i1; l1 = v; i1 = j; } else if (v > l2) { l2 = v; i2 = j; } }
                        const float e1 = 1.f / (1.f + expf(l2 - l1)), e2 = 1.f - e1;
                        const int eid1 = gi * 8 + i1, eid2 = gi * 8 + i2;
                        const unsigned p1 = (unsigned)__hip_atomic_fetch_add(&MISC[320 + eid1], 1, __ATOMIC_RELAXED, __HIP_MEMORY_SCOPE_WORKGROUP), p2 = (unsigned)__hip_atomic_fetch_add(&MISC[320 + eid2], 1, __ATOMIC_RELAXED, __HIP_MEMORY_SCOPE_WORKGROUP);
                        u32x4 r0, r1; r0.x = (unsigned)eid1; r0.y = p1; r0.z = __float_as_uint(g_w * e1); r0.w = (unsigned)eid2; r1.x = p2; r1.y = __float_as_uint(g_w * e2); r1.z = 0u; r1.w = 0u;
                        *(u32x4*)(ASG + (size_t)tq * 8) = r0; *(u32x4*)(ASG + (size_t)tq * 8 + 4) = r1;
                        RSTD[tq] = rstd;
                    }
                    LDS_WAIT(); asm volatile("" ::: "memory");
                }
            } else {
                LAS unsigned* T = (LAS unsigned*)(lds + wave * 8192);
                KArgP K2 = kargs(); const float* a_w1 = K2->w1; const float* a_w3 = K2->w3; const float* a_w2 = K2->w2;
                const int it = vcu + G * widx;
                int lane_c = lane; asm volatile("" : "+v"(lane_c));
                const int e = it / 192, r = it % 192;
                if (r < 64) transpose_tile_fp8<2, true>(a_w1 + (size_t)e * 1024 * 512, 1024, 512, (unsigned char*)(ws + WS_W13) + (size_t)e * 1024 * 1024, 0, T, r, lane_c, W8_SCALE);
                else if (r < 128) transpose_tile_fp8<2, true>(a_w3 + (size_t)e * 1024 * 512, 1024, 512, (unsigned char*)(ws + WS_W13) + (size_t)e * 1024 * 1024, 128, T, r - 64, lane_c, W8_SCALE);
                else transpose_tile_fp8<0, true>(a_w2 + (size_t)e * 512 * 1024, 512, 1024, (unsigned char*)(ws + WS_W2) + (size_t)e * 1024 * 512, 0, T, r - 128, lane_c, W8_SCALE);
                LDS_WAIT(); asm volatile("" ::: "memory");
            }
        }
        __syncthreads();
        if (tid < 64) ((int*)(ws + WS_CNTT))[vcu * 64 + tid] = MISC[320 + tid];
    }
#endif
    GSYNC(9);
    {
        PHASE_IDS;
        const int* CNTT = (const int*)(ws + WS_CNTT); LAS int* PS = (LAS int*)lds;
        {
            const int e = tid & 63; int tot = 0, bas = 0;
            for (int w = wave; w < G; w += NWAVES) { const int c = CNTT[w * 64 + e]; tot += c; bas += (w < vcu) ? c : 0; }
            PS[wave * 64 + e] = tot; PS[512 + wave * 64 + e] = bas;
        }
        __syncthreads();
        if (tid < 64) { int tot = 0, bas = 0;
#pragma unroll
            for (int q = 0; q < NWAVES; ++q) { tot += PS[q * 64 + tid]; bas += PS[512 + q * 64 + tid]; }
            l_cnt[tid] = tot; MISC[384 + tid] = bas; }
        __syncthreads();
        if (tid == 0) { int ts = 0, ss = 0; for (int e = 0; e < NEXP; ++e) { l_tstart[e] = ts; l_sstart[e] = ss; ts += (l_cnt[e] + 255) >> 8; ss += l_cnt[e]; } l_tstart[NEXP] = ts; l_sstart[NEXP] = ss; }
        __syncthreads();
        unsigned* ASG = (unsigned*)(ws + WS_ASG); int* TOKL = (int*)(ws + WS_TOKL);
        for (int tb = vcu * NWAVES; tb < NTOK / 16; tb += NGW) {
            if (tid < 256) {
                const int tok = tb * 16 + (tid >> 1), k = tid & 1;
                const unsigned eid = ASG[(size_t)tok * 8 + (k ? 3 : 0)], pos = ASG[(size_t)tok * 8 + (k ? 4 : 1)];
                const int slot = l_sstart[eid] + MISC[384 + eid] + (int)pos;
                TOKL[slot] = tok; ASG[(size_t)tok * 8 + 6 + k] = (unsigned)slot;
            }
        }
    }
    GSYNC(10);
#define MOE_LIST(i0_, nb_) do { if (opaque_tid() == 0) { const int c_ = vcu & 31, eg_ = (NEXP * 32) / G, e0_ = (vcu >> 5) * eg_; int e_ = e0_; \
            for (int q_ = 0; q_ < (nb_); ++q_) { const int P_ = l_tstart[e0_] + 8 * ((i0_) + q_) + (c_ >> 2); while (l_tstart[e_ + 1] <= P_) ++e_; \
                MISC[448 + 3 * q_] = e_; MISC[449 + 3 * q_] = c_ & 3; MISC[450 + 3 * q_] = P_ - l_tstart[e_]; } } \
        __syncthreads(); } while (0)
#define MOE_NUNITS() ({ const int c_ = vcu & 31, eg_ = (NEXP * 32) / G, e0_ = (vcu >> 5) * eg_; const int np_ = l_tstart[e0_ + eg_] - l_tstart[e0_]; (np_ > (c_ >> 2)) ? (np_ - (c_ >> 2) + 7) / 8 : 0; })
#ifndef NO_P7
    {
        const int nU = MOE_NUNITS();
        for (int i0 = 0; i0 < nU; i0 += ROFF_UNITS) {
            const int nb = (nU - i0) < ROFF_UNITS ? (nU - i0) : ROFF_UNITS;
            MOE_LIST(i0, nb);
            {
                const int tid = opaque_tid(); const int* TOKL = (const int*)(ws + WS_TOKL); const float* RSTD = (const float*)(ws + WS_RSTD); LAS int* RO = (LAS int*)(lds + ROFF_OFF); LAS float* RS = (LAS float*)(lds + RSC_OFF);
                for (int idx = tid; idx < nb * 256; idx += NTHREADS) { const int q = idx >> 8, e = MISC[448 + 3 * q], m = MISC[450 + 3 * q]; const int cnt = l_cnt[e];
                    int row = m * 256 + (idx & 255); row = row < cnt ? row : cnt - 1; const int tok = TOKL[l_sstart[e] + row]; RO[idx] = tok * DM; RS[idx] = RSTD[tok] * W8_DESCALE; }
            }
            __syncthreads();
            pg8::ListOrder S{(const char*)(ws + WS_HN), (const char*)(ws + WS_W13), DM / 2, (const LAS int*)(MISC + 448), nb, (const LAS int*)l_cnt, (const LAS int*)l_sstart};
            EpiSwiglu E{(unsigned char*)(ws + WS_HID), (const LAS float*)(lds + RSC_OFF)};
            pg8::gemm_phase<EpiSwiglu, pg8::ListOrder, true, true, true, true>(lds, DM / 2, S, E, (const LAS int*)(lds + ROFF_OFF), (const char*)(ws + WS_HN));
            __syncthreads();
        }
    }
#endif
    GSYNC(11);
#ifndef NO_P8
    {
        const int nU = MOE_NUNITS();
        for (int i0 = 0; i0 < nU; i0 += ROFF_UNITS) {
            const int nb = (nU - i0) < ROFF_UNITS ? (nU - i0) : ROFF_UNITS;
            MOE_LIST(i0, nb);
            pg8::ListOrder S{(const char*)(ws + WS_HID), (const char*)(ws + WS_W2), 256, (const LAS int*)(MISC + 448), nb, (const LAS int*)l_cnt, (const LAS int*)l_sstart};
            EpiDown E{(unsigned char*)(ws + WS_Y), W8_DESCALE * Y8_SCALE};
            pg8::gemm_phase<EpiDown, pg8::ListOrder, true, true, false, true>(lds, 256, S, E);
            __syncthreads();
        }
    }
#endif
#undef MOE_LIST
#undef MOE_NUNITS
    GSYNC(12);
#endif
    {
        PHASE_IDS;
        const unsigned* ASG = (const unsigned*)(ws + WS_ASG); const unsigned char* Y = (const unsigned char*)(ws + WS_Y); const bf16_t* MIX = (const bf16_t*)(ws + WS_MIX); const bf16_t* XNB = (const bf16_t*)(ws + WS_XN); const float* RS0 = (const float*)(ws + WS_RSTD0);
        KArgP K_ = kargs(); const float* a_nf = K_->norm_final_w; float* a_out = K_->out;
        const f32x4* wf = (const f32x4*)a_nf + lane; f32x4 wfv[4];
#pragma unroll
        for (int j = 0; j < 4; ++j) wfv[j] = wf[64 * j];
        u32x4 ra0 = (u32x4){0u, 0u, 0u, 0u}, ra1 = ra0, rb0 = ra0, rb1 = ra0;
        if (gw < NTOK) { ra0 = *(const u32x4*)(ASG + (size_t)gw * 8); ra1 = *(const u32x4*)(ASG + (size_t)gw * 8 + 4); }
        if (gw + NGW < NTOK) { rb0 = *(const u32x4*)(ASG + (size_t)(gw + NGW) * 8); rb1 = *(const u32x4*)(ASG + (size_t)(gw + NGW) * 8 + 4); }
        for (int m = gw; m < NTOK; m += 2 * NGW) {
            const int m2 = m + NGW; const bool has2 = m2 < NTOK; const int mb = has2 ? m2 : m;
            const u32x4 a0 = ra0, a1 = ra1, b0 = rb0, b1 = rb1;
            { const int n1 = m + 2 * NGW, n2 = m + 3 * NGW;
              if (n1 < NTOK) { ra0 = *(const u32x4*)(ASG + (size_t)n1 * 8); ra1 = *(const u32x4*)(ASG + (size_t)n1 * 8 + 4); }
              if (n2 < NTOK) { rb0 = *(const u32x4*)(ASG + (size_t)n2 * 8); rb1 = *(const u32x4*)(ASG + (size_t)n2 * 8 + 4); } }
            const u32x2* xrA = (const u32x2*)(XNB + (size_t)m * DM) + lane; const u32x2* mrA = (const u32x2*)(MIX + (size_t)m * DM) + lane;
            const u32x2* xrB = (const u32x2*)(XNB + (size_t)mb * DM) + lane; const u32x2* mrB = (const u32x2*)(MIX + (size_t)mb * DM) + lane;
            const float iA = 1.f / RS0[m], iB = 1.f / RS0[mb];
            f32x4 vA[4], vB[4];
#if EN_MOE
            const float gA1 = __uint_as_float(a0.z) * Y8_DESCALE, gA2 = __uint_as_float(a1.y) * Y8_DESCALE, gB1 = __uint_as_float(b0.z) * Y8_DESCALE, gB2 = __uint_as_float(b1.y) * Y8_DESCALE;
            const unsigned* yA1 = (const unsigned*)(Y + (size_t)a1.z * DM) + lane; const unsigned* yA2 = (const unsigned*)(Y + (size_t)a1.w * DM) + lane;
            const unsigned* yB1 = (const unsigned*)(Y + (size_t)(has2 ? b1.z : a1.z) * DM) + lane; const unsigned* yB2 = (const unsigned*)(Y + (size_t)(has2 ? b1.w : a1.w) * DM) + lane;
            unsigned pA1[4], pA2[4], pB1[4], pB2[4];
#pragma unroll
            for (int j = 0; j < 4; ++j) { pA1[j] = __builtin_nontemporal_load(yA1 + 64 * j); pA2[j] = __builtin_nontemporal_load(yA2 + 64 * j); pB1[j] = __builtin_nontemporal_load(yB1 + 64 * j); pB2[j] = __builtin_nontemporal_load(yB2 + 64 * j); }
#endif
#pragma unroll
            for (int j = 0; j < 4; ++j) { const u32x2 mm = __builtin_nontemporal_load(mrA + 64 * j), xa = __builtin_nontemporal_load(xrA + 64 * j); vA[j] = (f32x4){bf_lo(xa.x), bf_hi(xa.x), bf_lo(xa.y), bf_hi(xa.y)} * iA + (f32x4){bf_lo(mm.x), bf_hi(mm.x), bf_lo(mm.y), bf_hi(mm.y)};
                                          const u32x2 mn = __builtin_nontemporal_load(mrB + 64 * j), xb = __builtin_nontemporal_load(xrB + 64 * j); vB[j] = (f32x4){bf_lo(xb.x), bf_hi(xb.x), bf_lo(xb.y), bf_hi(xb.y)} * iB + (f32x4){bf_lo(mn.x), bf_hi(mn.x), bf_lo(mn.y), bf_hi(mn.y)}; }
#if EN_MOE
#pragma unroll
            for (int j = 0; j < 4; ++j) {
                const f32x2 a1l = __builtin_amdgcn_cvt_pk_f32_fp8((int)pA1[j], false), a1h = __builtin_amdgcn_cvt_pk_f32_fp8((int)pA1[j], true), a2l = __builtin_amdgcn_cvt_pk_f32_fp8((int)pA2[j], false), a2h = __builtin_amdgcn_cvt_pk_f32_fp8((int)pA2[j], true);
                const f32x2 b1l = __builtin_amdgcn_cvt_pk_f32_fp8((int)pB1[j], false), b1h = __builtin_amdgcn_cvt_pk_f32_fp8((int)pB1[j], true), b2l = __builtin_amdgcn_cvt_pk_f32_fp8((int)pB2[j], false), b2h = __builtin_amdgcn_cvt_pk_f32_fp8((int)pB2[j], true);
                vA[j].x += gA1 * a1l[0] + gA2 * a2l[0]; vA[j].y += gA1 * a1l[1] + gA2 * a2l[1]; vA[j].z += gA1 * a1h[0] + gA2 * a2h[0]; vA[j].w += gA1 * a1h[1] + gA2 * a2h[1];
                vB[j].x += gB1 * b1l[0] + gB2 * b2l[0]; vB[j].y += gB1 * b1l[1] + gB2 * b2l[1]; vB[j].z += gB1 * b1h[0] + gB2 * b2h[0]; vB[j].w += gB1 * b1h[1] + gB2 * b2h[1]; }
#endif
            float sA = 0.f, sB = 0.f;
#pragma unroll
            for (int j = 0; j < 4; ++j) { sA += (vA[j].x * vA[j].x + vA[j].y * vA[j].y) + (vA[j].z * vA[j].z + vA[j].w * vA[j].w); sB += (vB[j].x * vB[j].x + vB[j].y * vB[j].y) + (vB[j].z * vB[j].z + vB[j].w * vB[j].w); }
#pragma unroll
            for (int o_ = 1; o_ < 64; o_ <<= 1) { sA += __shfl_xor(sA, o_); sB += __shfl_xor(sB, o_); }
            const float rA = 1.f / sqrtf(sA * (1.f / DM) + NORM_EPS), rB = 1.f / sqrtf(sB * (1.f / DM) + NORM_EPS);
            float pscale = 1.f, padd = 0.f;
            if (PROBE_A >= 1) { const unsigned long long* ts = (const unsigned long long*)(ctl + CW_TS); const float us = (float)(ts[PROBE_A] - ts[PROBE_A0]) * 0.01f; pscale = 1.f + sqrtf(us * PROBE_SCALE); }
            if (PROBE_B >= 1) { const unsigned long long* ts = (const unsigned long long*)(ctl + CW_TS); const float us = (float)(ts[PROBE_B] - ts[PROBE_B0]) * 0.01f; if (m == 0 && lane == 0) padd = us * 0.01f; }
            f32x4* oA = (f32x4*)(a_out + (size_t)m * DM) + lane; f32x4* oB = (f32x4*)(a_out + (size_t)mb * DM) + lane;
#pragma unroll
            for (int j = 0; j < 4; ++j) { f32x4 r = vA[j] * (rA * pscale) * wfv[j]; if (j == 0) r.x += padd; __builtin_nontemporal_store(r, oA + 64 * j); }
            if (has2) {
#pragma unroll
                for (int j = 0; j < 4; ++j) { const f32x4 r = vB[j] * (rB * pscale) * wfv[j]; __builtin_nontemporal_store(r, oB + 64 * j); }
            }
        }
    }
}

extern "C" void kernel_launch(void* const* d_in, const int* in_sizes, int n_in, void* d_out, int out_size, void* d_ws, size_t ws_size, hipStream_t stream) {
    static int grid = 0;
    if (grid == 0) {
        if (n_in != 19 || in_sizes[0] != NTOK * DM || out_size != NTOK * DM || ws_size < WS_END) { fprintf(stderr, "kernel_launch: unexpected problem (n_in %d, ws %zu)\n", n_in, ws_size); grid = -1; return; }
        int dev = 0, cus = 0, per_cu = 0;
        (void)hipGetDevice(&dev); (void)hipDeviceGetAttribute(&cus, hipDeviceAttributeMultiprocessorCount, dev);
        (void)hipFuncSetAttribute((const void*)mega_fwd, hipFuncAttributeMaxDynamicSharedMemorySize, LDS_BYTES);
        (void)hipOccupancyMaxActiveBlocksPerMultiprocessor(&per_cu, (const void*)mega_fwd, NTHREADS, LDS_BYTES);
        (void)hipGetLastError();
        if (per_cu < 1) { fprintf(stderr, "kernel_launch: occupancy query says %d blocks per CU\n", per_cu); per_cu = 1; }
        grid = cus;
    }
    if (grid < 0) return;
    (void)hipMemsetAsync((char*)d_ws + WS_CTL, 0, CTL_ZERO_BYTES, stream);
    Args a{};
    a.x = (const float*)d_in[0]; a.norm_mix_w = (const float*)d_in[1]; a.w_in = (const float*)d_in[2]; a.b_gate = (const float*)d_in[3]; a.dec_f = (const float*)d_in[4]; a.dec_b = (const float*)d_in[5];
    a.gn_w = (const float*)d_in[6]; a.w_a = (const float*)d_in[7]; a.w_b = (const float*)d_in[8]; a.w_o = (const float*)d_in[9]; a.norm_moe_w = (const float*)d_in[10]; a.wg = (const float*)d_in[11];
    a.bg = (const float*)d_in[12]; a.we = (const float*)d_in[13]; a.be = (const float*)d_in[14]; a.w1 = (const float*)d_in[15]; a.w3 = (const float*)d_in[16]; a.w2 = (const float*)d_in[17];
    a.norm_final_w = (const float*)d_in[18]; a.out = (float*)d_out; a.ws = (unsigned char*)d_ws;
    void* args[] = {&a};
    hipError_t e = hipLaunchCooperativeKernel((const void*)mega_fwd, dim3(grid), dim3(NTHREADS), args, LDS_BYTES, stream);
    if (e != hipSuccess) fprintf(stderr, "cooperative launch failed: %s (grid %d)\n", hipGetErrorString(e), grid);
}
```
